# Optimizing an MI355X kernel written in HIP

```python
import math
import jax, jax.numpy as jnp
from jax import lax
import numpy as np

D_MODEL = 1024
BATCH = 8
SEQ = 4096
DEPTH = 2

CHUNK = 64
QBLK = 128
MIX_WIDTH = D_MODEL
A_HEADS = 8
A_HEAD_DIM = 64
A_WIDTH = A_HEADS * A_HEAD_DIM
KV_LORA = 128
IDX_HEADS = 8
IDX_DIM = 64
INDEX_TOPK_MAX = 256
B_HEADS = 4
B_QK_DIM = 64
B_V_DIM = 2 * B_QK_DIM
B_WIDTH = B_HEADS * B_V_DIM
MEM_TOKENS = 256
MEM_HEADS = 4
MEM_HEAD_DIM = D_MODEL // MEM_HEADS
N_EXPERTS = 64
TOP_K = 8
EXPERT_DIM = 256
SHARED_DIM = 256
ROUTED_SCALE = 2.5
MOE_BLOCK = 128
ALPHA = (2 * DEPTH) ** 0.25
BETA = (8 * DEPTH) ** -0.25
LN_EPS = 1e-5
RMS_EPS = 1e-6
IN_SIZES = (A_WIDTH, KV_LORA, IDX_HEADS * IDX_DIM, IDX_DIM, IDX_HEADS,
            2 * B_HEADS * B_QK_DIM, 2 * B_HEADS * B_QK_DIM, B_WIDTH)

kernel_name = "hybrid_dsa_diffattn_mem_moe_deepnorm"


def layer_norm(x, g, b):
    xf = x.astype(jnp.float32)
    mu = jnp.mean(xf, axis=-1, keepdims=True)
    var = jnp.mean(jnp.square(xf - mu), axis=-1, keepdims=True)
    return ((xf - mu) * lax.rsqrt(var + LN_EPS) * g + b).astype(x.dtype)


def rms_norm(x, g):
    xf = x.astype(jnp.float32)
    return (xf * lax.rsqrt(jnp.mean(xf * xf, axis=-1, keepdims=True) + RMS_EPS) * g).astype(x.dtype)


def alibi_slopes(n):
    return jnp.exp2(-8.0 * jnp.arange(1, n + 1, dtype=jnp.float32) / n)


def to_qblocks(a):
    b, s = a.shape[:2]
    return jnp.moveaxis(a.reshape(b, s // QBLK, QBLK, *a.shape[2:]), 1, 0)


def from_qblocks(a):
    a = jnp.moveaxis(a, 0, 1)
    return a.reshape(a.shape[0], -1, *a.shape[3:])


def dsa_attention(q, q_idx, w_idx, c_kv, k_idx, w_uk, w_uv):
    b, s = q.shape[:2]
    topk = min(INDEX_TOPK_MAX, s // 4)
    slopes = alibi_slopes(A_HEADS)
    key_chunk = jnp.arange(s) // CHUNK
    bidx = jnp.arange(b)[:, None, None]
    scale = A_HEAD_DIM ** -0.5

    def one_block(args):
        qb, qib, wib, blk = args
        tq = blk * QBLK + jnp.arange(QBLK)
        rel = jax.nn.relu(jnp.einsum('bqhd,bsd->bqhs', qib, k_idx) * IDX_DIM ** -0.5)
        iscore = jnp.einsum('bqh,bqhs->bqs', wib, rel).astype(jnp.float32)
        admissible = key_chunk[None, :] <= (tq // CHUNK)[:, None]
        iscore = jnp.where(admissible[None], iscore, -jnp.inf)
        _, sel = lax.top_k(iscore, topk)
        valid = (sel // CHUNK) <= (tq // CHUNK)[None, :, None]
        c_sel = c_kv[bidx, sel]
        q_lat = jnp.einsum('bqhd,hcd->bqhc', qb, w_uk)
        sc = jnp.einsum('bqhc,bqkc->bqhk', q_lat, c_sel).astype(jnp.float32) * scale
        dist = jnp.abs(tq[None, :, None] - sel).astype(jnp.float32)
        sc = sc - slopes[None, None, :, None] * dist[:, :, None, :]
        sc = jnp.where(valid[:, :, None, :], sc, -jnp.inf)
        p = jax.nn.softmax(sc, axis=-1).astype(c_kv.dtype)
        o_lat = jnp.einsum('bqhk,bqkc->bqhc', p, c_sel)
        return jnp.einsum('bqhc,hcd->bqhd', o_lat, w_uv)

    nb = s // QBLK
    out = lax.map(one_block, (to_qblocks(q), to_qblocks(q_idx), to_qblocks(w_idx), jnp.arange(nb)))
    return from_qblocks(out).reshape(b, s, A_WIDTH)


def diff_attention(q1, q2, k1, k2, v, lam):
    s = q1.shape[1]
    slopes = alibi_slopes(B_HEADS)
    ts = jnp.arange(s)
    scale = B_QK_DIM ** -0.5

    def one_block(args):
        q1b, q2b, blk = args
        tq = blk * QBLK + jnp.arange(QBLK)
        mask = (ts // CHUNK)[None, :] <= (tq // CHUNK)[:, None]
        dist = jnp.abs(tq[:, None] - ts[None, :]).astype(jnp.float32)
        bias = jnp.where(mask[None], -slopes[:, None, None] * dist[None], -jnp.inf)
        s1 = jnp.einsum('bqhd,bshd->bhqs', q1b, k1).astype(jnp.float32) * scale + bias
        s2 = jnp.einsum('bqhd,bshd->bhqs', q2b, k2).astype(jnp.float32) * scale + bias
        attn = (jax.nn.softmax(s1, axis=-1) - lam * jax.nn.softmax(s2, axis=-1)).astype(v.dtype)
        return jnp.einsum('bhqs,bshd->bqhd', attn, v)

    out = lax.map(one_block, (to_qblocks(q1), to_qblocks(q2), jnp.arange(s // QBLK)))
    return from_qblocks(out)


def hybrid_mixer(x, w_in, a_kv_norm, a_w_uk, a_w_uv, b_lq1, b_lk1, b_lq2, b_lk2, b_subln, w_o, lambda_init):
    b, s, _ = x.shape
    proj = x @ w_in
    splits = np.cumsum(IN_SIZES)[:-1].tolist()
    q_a, c_kv, q_idx, k_idx, w_idx, q_b, k_b, v_b = jnp.split(proj, splits, axis=-1)
    q_a = q_a.reshape(b, s, A_HEADS, A_HEAD_DIM)
    c_kv = rms_norm(c_kv, a_kv_norm)
    q_idx = q_idx.reshape(b, s, IDX_HEADS, IDX_DIM)
    w_idx = w_idx * IDX_HEADS ** -0.5
    out_a = dsa_attention(q_a, q_idx, w_idx, c_kv, k_idx, a_w_uk, a_w_uv)
    q_b = q_b.reshape(b, s, B_HEADS, 2, B_QK_DIM)
    k_b = k_b.reshape(b, s, B_HEADS, 2, B_QK_DIM)
    v_b = v_b.reshape(b, s, B_HEADS, B_V_DIM)
    lam = (jnp.exp(jnp.sum(b_lq1.astype(jnp.float32) * b_lk1.astype(jnp.float32)))
           - jnp.exp(jnp.sum(b_lq2.astype(jnp.float32) * b_lk2.astype(jnp.float32))) + lambda_init)
    o_b = diff_attention(q_b[..., 0, :], q_b[..., 1, :], k_b[..., 0, :], k_b[..., 1, :], v_b, lam)
    out_b = (rms_norm(o_b, b_subln) * (1.0 - lambda_init)).reshape(b, s, B_WIDTH)
    return jnp.concatenate([out_a, out_b], axis=-1) @ w_o


def memory_attention(x, mem, wq, wkv, wo):
    b, s, d = x.shape
    m = mem.shape[1]
    q = (x @ wq).reshape(b, s, MEM_HEADS, MEM_HEAD_DIM)
    kv = (mem @ wkv).reshape(b, m, 2, MEM_HEADS, MEM_HEAD_DIM)
    k, v = kv[:, :, 0], kv[:, :, 1]
    sc = jnp.einsum('bqhd,bmhd->bhqm', q, k).astype(jnp.float32) * MEM_HEAD_DIM ** -0.5
    p = jax.nn.softmax(sc, axis=-1).astype(v.dtype)
    o = jnp.einsum('bhqm,bmhd->bqhd', p, v).reshape(b, s, d)
    return o @ wo


def swiglu(x, wg, wu, wd):
    return (jax.nn.silu(x @ wg) * (x @ wu)) @ wd


def moe(x, router_w, router_bias, e_w_gate, e_w_up, e_w_down, s_w_gate, s_w_up, s_w_down):
    b, s, d = x.shape
    n = b * s
    xf = x.reshape(n, d)
    scores = jax.nn.sigmoid((xf @ router_w).astype(jnp.float32))
    _, top_e = lax.top_k(scores + router_bias.astype(jnp.float32), TOP_K)
    top_s = jnp.take_along_axis(scores, top_e, axis=-1)
    gates = top_s / jnp.sum(top_s, axis=-1, keepdims=True) * ROUTED_SCALE
    m = n * TOP_K
    flat_e = top_e.reshape(m)
    flat_tok = jnp.repeat(jnp.arange(n, dtype=jnp.int32), TOP_K)
    flat_g = gates.reshape(m)
    order = jnp.argsort(flat_e)
    se = flat_e[order]
    counts = jnp.bincount(flat_e, length=N_EXPERTS)
    padded = (counts + MOE_BLOCK - 1) // MOE_BLOCK * MOE_BLOCK
    start = jnp.cumsum(counts) - counts
    pend = jnp.cumsum(padded)
    pstart = pend - padded
    dest = pstart[se] + (jnp.arange(m) - start[se])
    rows_total = m + N_EXPERTS * MOE_BLOCK
    nblk = rows_total // MOE_BLOCK
    row_tok = jnp.full((rows_total,), n, dtype=jnp.int32).at[dest].set(flat_tok[order])
    row_gate = jnp.zeros((rows_total,), jnp.float32).at[dest].set(flat_g[order])
    blk_e = jnp.minimum(jnp.searchsorted(pend, jnp.arange(nblk) * MOE_BLOCK, side='right'), N_EXPERTS - 1)
    x_pad = jnp.concatenate([xf, jnp.zeros((1, d), xf.dtype)], axis=0)

    def body(acc, blk):
        rows, g, e = blk
        xb = x_pad[rows]
        yb = swiglu(xb, e_w_gate[e], e_w_up[e], e_w_down[e]) * g[:, None]
        return acc.at[rows].add(yb), None

    acc, _ = lax.scan(body, jnp.zeros((n + 1, d), x.dtype),
                      (row_tok.reshape(nblk, MOE_BLOCK),
                       row_gate.reshape(nblk, MOE_BLOCK).astype(x.dtype), blk_e))
    out = acc[:n] + swiglu(xf, s_w_gate, s_w_up, s_w_down)
    return out.reshape(b, s, d)


def setup_inputs(seed: int = 0) -> dict:
    key = jax.random.key(seed)
    keys = list(jax.random.split(key, 48))

    def nrm(shape, scale):
        return scale * jax.random.normal(keys.pop(), shape, jnp.float32)

    D = D_MODEL
    x = nrm((BATCH, SEQ, D), 1.0)
    mem = nrm((BATCH, MEM_TOKENS, D), 1.0)
    ln_in_g = 1.0 + nrm((D,), 0.02)
    ln_in_b = nrm((D,), 0.02)
    w_in = jnp.concatenate(
        [nrm((DEPTH, D, sz), D ** -0.5 * (BETA if i == len(IN_SIZES) - 1 else 1.0))
         for i, sz in enumerate(IN_SIZES)], axis=-1)
    a_kv_norm = 1.0 + nrm((DEPTH, KV_LORA), 0.02)
    a_w_uk = nrm((DEPTH, A_HEADS, KV_LORA, A_HEAD_DIM), KV_LORA ** -0.5)
    a_w_uv = nrm((DEPTH, A_HEADS, KV_LORA, A_HEAD_DIM), KV_LORA ** -0.5 * BETA)
    b_lq1 = nrm((DEPTH, B_QK_DIM), 0.1)
    b_lk1 = nrm((DEPTH, B_QK_DIM), 0.1)
    b_lq2 = nrm((DEPTH, B_QK_DIM), 0.1)
    b_lk2 = nrm((DEPTH, B_QK_DIM), 0.1)
    b_subln = 1.0 + nrm((DEPTH, B_V_DIM), 0.02)
    w_o = nrm((DEPTH, MIX_WIDTH, D), MIX_WIDTH ** -0.5 * BETA)
    ln1_g = 1.0 + nrm((DEPTH, D), 0.02)
    ln1_b = nrm((DEPTH, D), 0.02)
    m_wq = nrm((DEPTH, D, D), D ** -0.5)
    m_wkv = jnp.concatenate([nrm((DEPTH, D, D), D ** -0.5), nrm((DEPTH, D, D), D ** -0.5 * BETA)], axis=-1)
    m_wo = nrm((DEPTH, D, D), D ** -0.5 * BETA)
    ln2_g = 1.0 + nrm((DEPTH, D), 0.02)
    ln2_b = nrm((DEPTH, D), 0.02)
    router_w = nrm((DEPTH, D, N_EXPERTS), D ** -0.5)
    router_bias = nrm((DEPTH, N_EXPERTS), 0.01)
    e_w_gate = nrm((DEPTH, N_EXPERTS, D, EXPERT_DIM), D ** -0.5)
    e_w_up = nrm((DEPTH, N_EXPERTS, D, EXPERT_DIM), D ** -0.5 * BETA)
    e_w_down = nrm((DEPTH, N_EXPERTS, EXPERT_DIM, D), EXPERT_DIM ** -0.5 * BETA)
    s_w_gate = nrm((DEPTH, D, SHARED_DIM), D ** -0.5)
    s_w_up = nrm((DEPTH, D, SHARED_DIM), D ** -0.5 * BETA)
    s_w_down = nrm((DEPTH, SHARED_DIM, D), SHARED_DIM ** -0.5 * BETA)
    ln3_g = 1.0 + nrm((DEPTH, D), 0.02)
    ln3_b = nrm((DEPTH, D), 0.02)
    return {"x": x, "mem": mem, "ln_in_g": ln_in_g, "ln_in_b": ln_in_b, "w_in": w_in,
            "a_kv_norm": a_kv_norm, "a_w_uk": a_w_uk, "a_w_uv": a_w_uv,
            "b_lq1": b_lq1, "b_lk1": b_lk1, "b_lq2": b_lq2, "b_lk2": b_lk2, "b_subln": b_subln,
            "w_o": w_o, "ln1_g": ln1_g, "ln1_b": ln1_b,
            "m_wq": m_wq, "m_wkv": m_wkv, "m_wo": m_wo, "ln2_g": ln2_g, "ln2_b": ln2_b,
            "router_w": router_w, "router_bias": router_bias,
            "e_w_gate": e_w_gate, "e_w_up": e_w_up, "e_w_down": e_w_down,
            "s_w_gate": s_w_gate, "s_w_up": s_w_up, "s_w_down": s_w_down,
            "ln3_g": ln3_g, "ln3_b": ln3_b}


def reference(x, mem, ln_in_g, ln_in_b, w_in, a_kv_norm, a_w_uk, a_w_uv,
              b_lq1, b_lk1, b_lq2, b_lk2, b_subln, w_o, ln1_g, ln1_b,
              m_wq, m_wkv, m_wo, ln2_g, ln2_b,
              router_w, router_bias, e_w_gate, e_w_up, e_w_down,
              s_w_gate, s_w_up, s_w_down, ln3_g, ln3_b):
    h = layer_norm(x, ln_in_g, ln_in_b)
    for l in range(DEPTH):
        lambda_init = 0.8 - 0.6 * math.exp(-0.3 * l)
        y = hybrid_mixer(h, w_in[l], a_kv_norm[l], a_w_uk[l], a_w_uv[l],
                         b_lq1[l], b_lk1[l], b_lq2[l], b_lk2[l], b_subln[l], w_o[l], lambda_init)
        h = layer_norm(ALPHA * h + y, ln1_g[l], ln1_b[l])
        y = memory_attention(h, mem, m_wq[l], m_wkv[l], m_wo[l])
        h = layer_norm(ALPHA * h + y, ln2_g[l], ln2_b[l])
        y = moe(h, router_w[l], router_bias[l], e_w_gate[l], e_w_up[l], e_w_down[l],
                s_w_gate[l], s_w_up[l], s_w_down[l])
        h = layer_norm(ALPHA * h + y, ln3_g[l], ln3_b[l])
    return h
```

```cpp
#include <hip/hip_runtime.h>
#include <cstdio>
#include <cstdint>

typedef unsigned short bf16;
typedef float f32x4 __attribute__((ext_vector_type(4)));

constexpr int D = 1024, BATCH = 8, SEQ = 4096, NTOK = BATCH * SEQ, DEPTH = 2;
constexpr int CHUNK = 64, TOPK = 256;
constexpr int KV_LORA = 128, A_HEADS = 8, IDX_DIM = 64;
constexpr int B_HEADS = 4;
constexpr int MEM_TOK = 256, MEM_HEADS = 4, MEM_HD = 256;
constexpr int N_EXP = 64, TOP_E = 8, EXP_DIM = 256, SH_DIM = 256;
constexpr int WIN_COLS = 2760;
constexpr float ALPHA = 1.41421356237309515f;
constexpr float LN_EPS = 1e-5f, RMS_EPS = 1e-6f;
constexpr int MOE_CHUNKS = 2, MOE_TOK = NTOK / MOE_CHUNKS;

constexpr size_t MiB = 1u << 20;
constexpr size_t WS_CTL = 0;
constexpr size_t WS_WB = 1 * MiB;
constexpr size_t WS_KVM = 113 * MiB;
constexpr size_t WS_HB = 129 * MiB;
constexpr size_t WS_A = 193 * MiB;
constexpr size_t WS_PROJ5 = WS_A;
constexpr size_t WS_MISC10 = WS_A + 160 * MiB;
constexpr size_t WS_WIDX = WS_A + 176 * MiB;
constexpr size_t WS_CKV = WS_A + 177 * MiB;
constexpr size_t WS_SEL = WS_A + 185 * MiB;
constexpr size_t WS_CAT = WS_A + 217 * MiB;
constexpr size_t WS_Y = WS_A + 281 * MiB;
constexpr size_t WS_MEMB = WS_A + 345 * MiB;
constexpr size_t WS_QM = WS_A;
constexpr size_t WS_OM = WS_A + 64 * MiB;
constexpr size_t WS_ROUTE = WS_A + 336 * MiB;
constexpr int LIST_CAP = MOE_TOK;
constexpr size_t WS_SHY = WS_ROUTE + 10 * MiB;
constexpr size_t WS_LISTE = WS_ROUTE + 2 * MiB;
constexpr size_t WS_LOGIT = WS_ROUTE + 10 * MiB;
constexpr size_t WS_SLOT = WS_A;
constexpr size_t WS_HID = WS_A + 256 * MiB;
constexpr size_t WS_SHH = WS_A + 320 * MiB;
constexpr int VTD_LD = NTOK + 128, VTM_LD = 2048 + 128, KM_LD = 1024 + 128;
constexpr size_t WS_VTD = WS_A + 349 * MiB;
constexpr size_t WS_VTM = WS_A + 382 * MiB;
constexpr size_t WS_END = WS_A + 391 * MiB;
static_assert(WS_SLOT + (size_t)MOE_TOK * 8 * 1024 * 2 <= WS_HID && WS_HID + (size_t)MOE_TOK * 8 * 256 * 2 <= WS_SHH && WS_SHH + (size_t)MOE_TOK * 512 * 2 <= WS_ROUTE && WS_LISTE + (size_t)MOE_CHUNKS * N_EXP * LIST_CAP * 4 <= WS_SHY && WS_SHY + (size_t)MOE_TOK * 1024 * 2 <= WS_VTM, "MoE-stage workspace map: no two live buffers overlap");

__device__ __forceinline__ float bf2f(bf16 v) { return __uint_as_float((unsigned)v << 16); }
__device__ __forceinline__ bf16 f2bf(float f) { unsigned u = __float_as_uint(f); u += 0x7fffu + ((u >> 16) & 1u); return (bf16)(u >> 16); }
__device__ __forceinline__ float wave_sum(float v) {
#pragma unroll
    for (int o = 1; o < 64; o <<= 1) v += __shfl_xor(v, o);
    return v;
}
__device__ __forceinline__ float wave_max(float v) {
#pragma unroll
    for (int o = 1; o < 64; o <<= 1) v = fmaxf(v, __shfl_xor(v, o));
    return v;
}
__device__ __forceinline__ float block_sum(float v, float* scr) {
    v = wave_sum(v); __syncthreads();
    if ((threadIdx.x & 63) == 0) scr[threadIdx.x >> 6] = v;
    __syncthreads();
    float r = scr[0] + scr[1] + scr[2] + scr[3]; __syncthreads(); return r;
}
__device__ __forceinline__ float block_max(float v, float* scr) {
    v = wave_max(v); __syncthreads();
    if ((threadIdx.x & 63) == 0) scr[threadIdx.x >> 6] = v;
    __syncthreads();
    float r = fmaxf(fmaxf(scr[0], scr[1]), fmaxf(scr[2], scr[3])); __syncthreads(); return r;
}

#ifndef USE_MK_EXPERT
#define USE_MK_EXPERT 1
#endif
#ifndef MEMATT_V2
#define MEMATT_V2 1
#endif
#ifndef DIFF_V2
#define DIFF_V2 1
#endif
#ifndef SINGLE_LAUNCH
#define SINGLE_LAUNCH 1
#endif
#ifndef USE_MK_DIFF
#define USE_MK_DIFF 1
#endif
#ifndef USE_MK_TOPK
#define USE_MK_TOPK 1
#endif
#ifndef USE_MK_MEMATT
#define USE_MK_MEMATT 1
#endif

#define LAS __attribute__((address_space(3)))
#define GAS __attribute__((address_space(1)))
typedef short bf16x8 __attribute__((ext_vector_type(8)));
typedef unsigned u32x4 __attribute__((ext_vector_type(4)));
typedef unsigned u32x2 __attribute__((ext_vector_type(2)));
typedef int i32x4 __attribute__((ext_vector_type(4)));
typedef int i32x2 __attribute__((ext_vector_type(2)));
typedef float f32x2 __attribute__((ext_vector_type(2)));
typedef float f32x16 __attribute__((ext_vector_type(16)));

constexpr int NWAVES = 8, NTHR = 512;
constexpr int LDS_BYTES = 163840;
constexpr int LDS_STAGE = 0;
constexpr int LDS_TAB = 131072;
constexpr int LDS_CUM = 131072 + 8192;
constexpr int LDS_UT = LDS_CUM + 640;
constexpr int MOE_MAXU = 16;
constexpr int LDS_AG = LDS_UT + MOE_MAXU * 32;
constexpr int MOE_AGU = 9;
static_assert(LDS_AG + MOE_AGU * 2048 <= LDS_BYTES - 256, "MoE LDS tables");
constexpr int LDS_MISC = LDS_BYTES - 256;

constexpr size_t WB_WIN = 0, WB_WO = 6 * MiB, WB_WQ = 8 * MiB, WB_WMO = 10 * MiB, WB_SGU = 12 * MiB, WB_SD = 13 * MiB, WB_UK = 14 * MiB, WB_UV = 14 * MiB + 256 * 1024, WB_RW = 15 * MiB, WB_GU = 16 * MiB, WB_DN = 80 * MiB;
constexpr int WIN_PAD = 2304;
constexpr size_t WS_WKT = WS_Y, WS_WVT = WS_Y + 2 * MiB;
constexpr size_t WS_KM = WS_KVM, WS_VT = WS_KVM + 8 * MiB;
constexpr int CW_BAR = 4096;
constexpr int CW_MOE = 16384;

__device__ __forceinline__ unsigned pk2(float lo, float hi) { return (unsigned)f2bf(lo) | ((unsigned)f2bf(hi) << 16); }
__device__ __forceinline__ unsigned cvt_pk_bf16(float lo, float hi) { unsigned r; asm volatile("v_cvt_pk_bf16_f32 %0, %1, %2" : "=v"(r) : "v"(lo), "v"(hi)); return r; }
#define LDS_WAIT() asm volatile("s_waitcnt lgkmcnt(0)" ::: "memory")
#define VM_WAIT() asm volatile("s_waitcnt vmcnt(0)" ::: "memory")

#define XB_TMO      128
#define XB_XCNT(j)  (256  + 64 * (j))
#define XB_XSUB(j)  (1280 + 64 * (j))
#define XB_XGEN(j)  (2304 + 64 * (j))
#define XB_TOP      3328
#define XB_TOPGEN   3392
#define XCD_BAR_WORDS 3456
#define XB_SPIN_CAP (1u << 22)
__device__ __forceinline__ unsigned xb_ld(unsigned* p)              { return __hip_atomic_load(p, __ATOMIC_RELAXED, __HIP_MEMORY_SCOPE_AGENT); }
__device__ __forceinline__ unsigned xb_add(unsigned* p, unsigned v) { return __hip_atomic_fetch_add(p, v, __ATOMIC_RELAXED, __HIP_MEMORY_SCOPE_AGENT); }
__device__ __forceinline__ unsigned xb_xcc_id() { return (unsigned)__builtin_amdgcn_s_getreg((3 << 11) | 20) & 0xFu; }
#define XB_SPIN(cond, bar) do { unsigned _sp = 0; while (cond) { __builtin_amdgcn_s_sleep(1); \
    if ((++_sp & 255u) == 0u) { if (xb_ld(&(bar)[XB_TMO])) break; if (_sp > XB_SPIN_CAP) { atomicAdd(&(bar)[XB_TMO], 1u); break; } } } } while (0)
struct XcdBarrier { unsigned* bar; unsigned x; volatile LAS unsigned* st; };
__device__ __forceinline__ XcdBarrier xcd_barrier_post(unsigned* bar, volatile LAS unsigned* st) {
    XcdBarrier b; b.bar = bar; b.x = xb_xcc_id(); b.st = st;
    if (threadIdx.x == 0) (void)xb_add(&bar[XB_XCNT(b.x)], 1u);
    return b;
}
__device__ __forceinline__ void xcd_barrier_complete(unsigned* bar, unsigned x, unsigned& nloc, unsigned& nx) {
    const unsigned G = gridDim.x * gridDim.y * gridDim.z;
    unsigned sum, cnt, mine, sp = 0u;
    for (;;) {
        sum = 0u; cnt = 0u; mine = 0u;
#pragma unroll
        for (unsigned j = 0; j < 16; ++j) { const unsigned c = xb_ld(&bar[XB_XCNT(j)]); sum += c; cnt += (c > 0u) ? 1u : 0u; mine = (j == x) ? c : mine; }
        if (sum == G) break;
        __builtin_amdgcn_s_sleep(1);
        if ((++sp & 255u) == 0u) { if (xb_ld(&bar[XB_TMO])) break; if (sp > XB_SPIN_CAP) { atomicAdd(&bar[XB_TMO], 1u); break; } }
    }
    nloc = mine > 0u ? mine : 1u; nx = cnt > 0u ? cnt : 1u;
}
__device__ __forceinline__ void xcd_barrier(const XcdBarrier& b, int wave_s) {
    asm volatile("s_waitcnt vmcnt(0)" ::: "memory");
    __syncthreads();
    unsigned zb = 0u; asm volatile("" : "+s"(zb));
    if (wave_s == 0 && (int)__builtin_amdgcn_mbcnt_hi(~0u, __builtin_amdgcn_mbcnt_lo(~0u, zb)) == 0) {
        unsigned* bar = b.bar;
        __builtin_amdgcn_s_waitcnt(0);
        unsigned nloc = b.st[0], nx = b.st[1];
        if (nloc == 0u) { xcd_barrier_complete(bar, b.x, nloc, nx); b.st[0] = nloc; b.st[1] = nx; }
        const unsigned old = xb_add(&bar[XB_XSUB(b.x)], 1u);
        const unsigned gen = old / nloc;
        if (old + 1u == (gen + 1u) * nloc) {
            __builtin_amdgcn_fence(__ATOMIC_RELEASE, "agent");
            asm volatile("s_waitcnt vmcnt(0)" ::: "memory");
            const unsigned og = xb_add(&bar[XB_TOP], 1u);
            const unsigned tg = og / nx;
            if (og + 1u == (tg + 1u) * nx) xb_add(&bar[XB_TOPGEN], 1u);
            else XB_SPIN(xb_ld(&bar[XB_TOPGEN]) == tg, bar);
            __builtin_amdgcn_fence(__ATOMIC_ACQUIRE, "agent");
            xb_add(&bar[XB_XGEN(b.x)], 1u);
            asm volatile("s_waitcnt vmcnt(0)" ::: "memory");
        } else {
            XB_SPIN(xb_ld(&bar[XB_XGEN(b.x)]) == gen, bar);
            __builtin_amdgcn_fence(__ATOMIC_ACQUIRE, "agent");
            asm volatile("s_waitcnt vmcnt(0)" ::: "memory");
        }
    }
    __syncthreads();
}

namespace pg8 {
typedef unsigned short bf16_t;
constexpr int BM = 256, BK = 64, HALF = 128, HTB = HALF * BK * 2, STAGE_BYTES = 8 * HTB, NXCD = 8, WGM = 8;
__host__ __device__ __forceinline__ int lds_byte(int r, int c) { const int st = (r >> 4) * 2 + (c >> 5), rr = r & 15, cc = c & 31, ob = rr * 64 + cc * 2; return st * 1024 + (ob ^ (((ob >> 9) & 1) << 5)); }
__host__ __device__ __forceinline__ void stage_rc(int b, int& R, int& C) { const int st = b / 1024, sb = b % 1024, swz = sb ^ (((sb >> 9) & 1) << 5); R = (st >> 1) * 16 + swz / 64; C = (st & 1) * 32 + (swz % 64) / 2; }
__host__ __device__ __forceinline__ int perm32(int rho) { const int n = rho >> 4, i = rho & 15; return 8 * (i >> 2) + 4 * n + (i & 3); }

struct Unit { int g, r0, nv, pn, slot, lr0; };
struct Gemm { const bf16_t* A; const bf16_t* Bt; int K; size_t astride, bstride; };

struct DenseOrder {
    int nM, nN, nwg, ng, G, c;
    __device__ void init(int M, int N, int ngroups, int G_, int c_) { nM = M / BM; nN = N / BM; nwg = nM * nN; ng = ngroups; G = G_; c = c_; }
    __device__ __forceinline__ bool next(int i, Unit& u) const {
        const long L = (long)i * G + c; if (L >= (long)nwg * ng) return false;
        const int g = (int)(L / nwg); int wgid = (int)(L % nwg);
        { const int q = nwg / NXCD, r = nwg % NXCD, xcd = wgid % NXCD, off = wgid / NXCD; wgid = (xcd < r ? xcd * (q + 1) : r * (q + 1) + (xcd - r) * q) + off; }
        const int nig = WGM * nN, gid = wgid / nig, fm = gid * WGM, gsz = (nM - fm) < WGM ? (nM - fm) : WGM;
        u.g = g; u.r0 = (fm + ((wgid % nig) % gsz)) * BM; u.pn = (wgid % nig) / gsz; u.nv = BM; u.slot = i; u.lr0 = 0; return true;
    }
};
struct GroupedOrder {
    const LAS int* cum; const LAS int* off; int NT, G, c; const LAS int* ut;
    __device__ bool next(int i, Unit& u) const {
        if (i >= MOE_MAXU) return false;
        const i32x4 a = *(const LAS i32x4*)(ut + 8 * i); const i32x4 b = *(const LAS i32x4*)(ut + 8 * i + 4);
        if (__builtin_amdgcn_readfirstlane(b.w) == 0) return false;
        u.g = __builtin_amdgcn_readfirstlane(a.x); u.r0 = __builtin_amdgcn_readfirstlane(a.y); u.nv = __builtin_amdgcn_readfirstlane(a.z); u.pn = __builtin_amdgcn_readfirstlane(a.w);
        u.lr0 = __builtin_amdgcn_readfirstlane(b.x); u.slot = i; return true;
    }
    __device__ __forceinline__ void peek(int i, int& g, int& r0, int& nv, int& pn, int& lr0) const {
        const int L = i * G + c; const int total = cum[N_EXP] * NT; const bool ok = L < total;
        const int blk = ok ? L / NT : 0; pn = ok ? L - blk * NT : 0;
        int lo = 0, hi = N_EXP;
#pragma unroll
        for (int s = 0; s < 6; ++s) { const int mid = (lo + hi) >> 1; const bool le = cum[mid] <= blk; lo = le ? mid : lo; hi = le ? hi : mid; }
        g = lo; r0 = off[lo] + (blk - cum[lo]) * BM; const int rem = off[lo + 1] - r0; nv = ok ? (rem < BM ? rem : BM) : 0; lr0 = lo * LIST_CAP + (blk - cum[lo]) * BM;
    }
    __device__ __forceinline__ void fill_table(LAS int* utw, int lane) const {
        if (lane < MOE_MAXU) { int g, r0, nv, pn, lr0; peek(lane, g, r0, nv, pn, lr0);
            *(LAS i32x4*)(utw + 8 * lane) = (i32x4){g, r0, nv, pn}; *(LAS i32x4*)(utw + 8 * lane + 4) = (i32x4){lr0, 0, 0, nv > 0 ? 1 : 0}; }
    }
};

#define PG8_SA(b, h) (((b) * 2 + (h)) * HTB)
#define PG8_SB(b, h) ((4 + (b) * 2 + (h)) * HTB)
#define PG8_STAGE(bufoff, gbase, voff) do { _Pragma("unroll") for (int _i = 0; _i < 2; ++_i) \
        __builtin_amdgcn_global_load_lds((const unsigned*)((const char*)(gbase) + (voff)[_i]), (LAS unsigned*)(lds + (bufoff) + ldsw + _i * 8192), 16, 0, 0); } while (0)
#define PG8_LDA(dst, b, h) do { _Pragma("unroll") for (int m = 0; m < 4; ++m) _Pragma("unroll") for (int k = 0; k < 2; ++k) dst[m][k] = *(const LAS bf16x8*)(lds + PG8_SA(b, h) + aoff + m * 2048 + k * 1024); } while (0)
#define PG8_LDB(dst, b, h) do { _Pragma("unroll") for (int n = 0; n < 2; ++n) _Pragma("unroll") for (int k = 0; k < 2; ++k) dst[n][k] = *(const LAS bf16x8*)(lds + PG8_SB(b, h) + boff + n * 2048 + k * 1024); } while (0)
#define PG8_MMA(ai, bj, At, Bt) do { __builtin_amdgcn_s_setprio(1); _Pragma("unroll") for (int m = 0; m < 4; ++m) _Pragma("unroll") for (int n = 0; n < 2; ++n) _Pragma("unroll") for (int k = 0; k < 2; ++k) \
        acc[ai][bj][m][n] = __builtin_amdgcn_mfma_f32_16x16x32_bf16(Bt[n][k], At[m][k], acc[ai][bj][m][n], 0, 0, 0); __builtin_amdgcn_s_setprio(0); } while (0)
#define PG8_WAIT_V(n) asm volatile("s_waitcnt vmcnt(" #n ")" ::: "memory")
#define PG8_WAIT_L(n) asm volatile("s_waitcnt lgkmcnt(" #n ")" ::: "memory")
#define PG8_BAR __builtin_amdgcn_s_barrier()
#define PG8_SCHED __builtin_amdgcn_sched_barrier(0)

template <class Epi, class Sched, bool GATHER>
__device__ __forceinline__ void gemm_phase(LAS unsigned char* lds, const Gemm g, const Sched& S, const Epi& E, const LAS int* tab, int wave_s) {
    unsigned zz = 0u; asm volatile("" : "+s"(zz)); const int lane = (int)__builtin_amdgcn_mbcnt_hi(~0u, __builtin_amdgcn_mbcnt_lo(~0u, zz));
    const int wid = wave_s, tid = wid * 64 + lane, wr = wid >> 2, wc = wid & 3, fr = lane & 15, fq = lane >> 4;
    const int K = g.K, nt = K / BK;
    unsigned voffA[2], voffB[2]; unsigned gvA[2][2];
#pragma unroll
    for (int i = 0; i < 2; ++i) { int R, C; stage_rc(tid * 16 + i * 8192, R, C); const int Rb = Epi::PERM ? ((R & ~31) + perm32(R & 31)) : R;
        voffA[i] = (unsigned)(R * K + C) * 2u; voffB[i] = (unsigned)(Rb * K + C) * 2u; }
#define PG8_GATHER_OFFS(slot_) do { unsigned zq = 0u; asm volatile("" : "+s"(zq)); const int lq = (int)__builtin_amdgcn_mbcnt_hi(~0u, __builtin_amdgcn_mbcnt_lo(~0u, zq)); \
        _Pragma("unroll") for (int i_ = 0; i_ < 2; ++i_) { int R_, C_; stage_rc((wid * 64 + lq) * 16 + i_ * 8192, R_, C_); \
            _Pragma("unroll") for (int h_ = 0; h_ < 2; ++h_) gvA[h_][i_] = (unsigned)(tab[(slot_) * 256 + h_ * HALF + R_] * K + C_) * 2u; } } while (0)
    const size_t kstep = (size_t)(BK * 2);
    const size_t hstep = (size_t)HALF * K * 2;
    const unsigned ldsw = (unsigned)wid * 1024u;
    const int aoff = lds_byte(wr * 64 + fr, fq * 8), boff = lds_byte(wc * 32 + fr, fq * 8);
    Unit cur, nxt; int ui = 0;
    if (!S.next(0, cur)) return;
    f32x4 acc[2][2][4][2];
#pragma unroll
    for (int a = 0; a < 2; ++a)
#pragma unroll
        for (int b = 0; b < 2; ++b)
#pragma unroll
            for (int m = 0; m < 4; ++m)
#pragma unroll
                for (int n = 0; n < 2; ++n) acc[a][b][m][n] = (f32x4){0.f, 0.f, 0.f, 0.f};
    bf16x8 At[4][2], B0[2][2], B1[2][2];
    const char* cA; const char* cB;
    if (GATHER) {
        cA = (const char*)g.A;
        PG8_GATHER_OFFS(cur.slot);
    } else cA = (const char*)(g.A + (size_t)cur.g * g.astride) + (size_t)cur.r0 * K * 2;
    cB = (const char*)(g.Bt + (size_t)cur.g * g.bstride) + (size_t)cur.pn * BM * K * 2;
#define PG8_STAGE_A(bufoff, base, h, gv) do { if (GATHER) PG8_STAGE(bufoff, base, gv[h]); else PG8_STAGE(bufoff, (base) + (h) * hstep, voffA); } while (0)
    PG8_STAGE(PG8_SB(0, 0), cB, voffB); PG8_STAGE_A(PG8_SA(0, 0), cA, 0, gvA); PG8_STAGE(PG8_SB(0, 1), cB + hstep, voffB); PG8_STAGE_A(PG8_SA(0, 1), cA, 1, gvA);
    if (wr == 1) PG8_BAR;
    PG8_WAIT_V(4); PG8_BAR;
    PG8_STAGE(PG8_SB(1, 0), cB + kstep, voffB); PG8_STAGE_A(PG8_SA(1, 0), cA + kstep, 0, gvA); PG8_STAGE(PG8_SB(1, 1), cB + hstep + kstep, voffB);
    PG8_WAIT_V(6); PG8_BAR;
    for (;;) {
        const bool has_next = S.next(ui + 1, nxt);
        const char* nA; const char* nB;
        if (has_next) {
            nA = GATHER ? (const char*)g.A : (const char*)(g.A + (size_t)nxt.g * g.astride) + (size_t)nxt.r0 * K * 2;
            nB = (const char*)(g.Bt + (size_t)nxt.g * g.bstride) + (size_t)nxt.pn * BM * K * 2;
        } else { nA = cA; nB = cB; }
        for (int t = 0; t < nt; t += 2) {
            const bool last = (t == nt - 2);
            const char* a1 = cA + (size_t)(t + 1) * kstep;
            const char* a2 = last ? nA : cA + (size_t)(t + 2) * kstep; const char* b2 = last ? nB : cB + (size_t)(t + 2) * kstep;
            const char* a3 = a2 + kstep; const char* b3 = b2 + kstep;
            PG8_LDB(B0, 0, 0); PG8_SCHED; PG8_LDA(At, 0, 0); PG8_STAGE_A(PG8_SA(1, 1), a1, 1, gvA);
            PG8_WAIT_L(8); PG8_BAR; PG8_WAIT_L(0); PG8_MMA(0, 0, At, B0); PG8_BAR; PG8_SCHED;
            if (GATHER && last && has_next) PG8_GATHER_OFFS(nxt.slot);
            PG8_LDB(B1, 0, 1); PG8_STAGE(PG8_SB(0, 0), b2, voffB);
            PG8_BAR; PG8_WAIT_L(0); PG8_MMA(0, 1, At, B1); PG8_BAR;
            PG8_LDA(At, 0, 1); PG8_STAGE_A(PG8_SA(0, 0), a2, 0, gvA);
            PG8_BAR; PG8_WAIT_L(0); PG8_MMA(1, 0, At, B0); PG8_BAR; PG8_SCHED;
            PG8_STAGE(PG8_SB(0, 1), b2 + hstep, voffB);
            PG8_WAIT_V(6); PG8_BAR; PG8_MMA(1, 1, At, B1); PG8_BAR;
            PG8_LDB(B0, 1, 0); PG8_SCHED; PG8_LDA(At, 1, 0); PG8_STAGE_A(PG8_SA(0, 1), a2, 1, gvA);
            PG8_WAIT_L(8); PG8_BAR; PG8_WAIT_L(0); PG8_MMA(0, 0, At, B0); PG8_BAR; PG8_SCHED;
            PG8_LDB(B1, 1, 1); PG8_STAGE(PG8_SB(1, 0), b3, voffB);
            PG8_BAR; PG8_WAIT_L(0); PG8_MMA(0, 1, At, B1); PG8_BAR;
            PG8_LDA(At, 1, 1); PG8_STAGE_A(PG8_SA(1, 0), a3, 0, gvA);
            PG8_BAR; PG8_WAIT_L(0); PG8_MMA(1, 0, At, B0); PG8_BAR; PG8_SCHED;
            PG8_STAGE(PG8_SB(1, 1), b3 + hstep, voffB);
            PG8_WAIT_V(6); PG8_BAR; PG8_MMA(1, 1, At, B1); PG8_BAR;
        }
        { unsigned z2 = 0u; asm volatile("" : "+s"(z2)); const int lz = (int)__builtin_amdgcn_mbcnt_hi(~0u, __builtin_amdgcn_mbcnt_lo(~0u, z2));
          E(acc, cur, wr, wc, lz & 15, lz >> 4); }
        if (!has_next) break;
#pragma unroll
        for (int a = 0; a < 2; ++a)
#pragma unroll
            for (int b = 0; b < 2; ++b)
#pragma unroll
                for (int m = 0; m < 4; ++m)
#pragma unroll
                    for (int n = 0; n < 2; ++n) acc[a][b][m][n] = (f32x4){0.f, 0.f, 0.f, 0.f};
        cur = nxt; cA = nA; cB = nB; ++ui;
    }
    PG8_WAIT_V(0);
    if (wr == 0) PG8_BAR;
    PG8_BAR;
#undef PG8_STAGE_A
#undef PG8_GATHER_OFFS
}

struct EpiBf16 {
    static constexpr bool PERM = true;
    bf16_t* O; int ldc; size_t ostride; int split_cols; size_t split_stride;
    __device__ __forceinline__ void operator()(const f32x4 (&acc)[2][2][4][2], const Unit& u, int wr, int wc, int fr, int fq) const {
        const int row0 = u.r0 + wr * 64 + fr; int colt = u.pn * BM; bf16_t* base = O + (size_t)u.g * ostride;
        if (split_cols) { const int t = colt / split_cols; base += (size_t)t * split_stride; colt -= t * split_cols; }
        const int col0 = colt + wc * 32 + 8 * fq;
#pragma unroll
        for (int ai = 0; ai < 2; ++ai)
#pragma unroll
            for (int m = 0; m < 4; ++m) { bf16_t* rowp = base + (size_t)(row0 + ai * HALF + m * 16) * ldc + col0;
#pragma unroll
                for (int bj = 0; bj < 2; ++bj) { const f32x4 v0 = acc[ai][bj][m][0], v1 = acc[ai][bj][m][1];
                    u32x4 w; w.x = cvt_pk_bf16(v0[0], v0[1]); w.y = cvt_pk_bf16(v0[2], v0[3]); w.z = cvt_pk_bf16(v1[0], v1[1]); w.w = cvt_pk_bf16(v1[2], v1[3]);
                    *(u32x4*)(rowp + bj * HALF) = w; } }
    }
};
struct EpiProjMk {
    static constexpr bool PERM = true;
    bf16_t* proj5; bf16_t* misc; float* widx; bf16_t* kidxf;
    __device__ __forceinline__ void operator()(const f32x4 (&acc)[2][2][4][2], const Unit& u, int wr, int wc, int fr, int fq) const {
        const int row0 = u.r0 + wr * 64 + fr; const bool m10 = (u.pn == 8);
        bf16_t* base = m10 ? misc : proj5 + (size_t)(u.pn >> 1) * ((size_t)NTOK * 512) + (u.pn & 1) * 256;
        const int ldc = m10 ? 256 : 512; const int col0 = wc * 32 + 8 * fq;
#pragma unroll
        for (int ai = 0; ai < 2; ++ai)
#pragma unroll
            for (int m = 0; m < 4; ++m) { const int row = row0 + ai * HALF + m * 16; bf16_t* rowp = base + (size_t)row * ldc + col0;
#pragma unroll
                for (int bj = 0; bj < 2; ++bj) { const f32x4 v0 = acc[ai][bj][m][0], v1 = acc[ai][bj][m][1];
                    u32x4 w; w.x = cvt_pk_bf16(v0[0], v0[1]); w.y = cvt_pk_bf16(v0[2], v0[3]); w.z = cvt_pk_bf16(v1[0], v1[1]); w.w = cvt_pk_bf16(v1[2], v1[3]);
                    *(u32x4*)(rowp + bj * HALF) = w;
                    if (m10 && bj == 1 && col0 == 64) { const float s = 0.35355339059327373f; float* wp = widx + (size_t)row * 8;
                        *(f32x4*)wp = v0 * s; *(f32x4*)(wp + 4) = v1 * s; }
                    if (m10 && bj == 1 && col0 < 64) *(u32x4*)(kidxf + ((size_t)(row >> 5) * 4 + (col0 >> 4)) * 512 + ((col0 >> 3) & 1) * 256 + (row & 31) * 8) = w; } }
    }
};
struct EpiSwiglu {
    static constexpr bool PERM = true;
    bf16_t* O;
    __device__ __forceinline__ void operator()(const f32x4 (&acc)[2][2][4][2], const Unit& u, int wr, int wc, int fr, int fq) const {
        const int col0 = u.pn * 128 + wc * 32 + 8 * fq;
#pragma unroll
        for (int ai = 0; ai < 2; ++ai)
#pragma unroll
            for (int m = 0; m < 4; ++m) { const int r = ai * HALF + wr * 64 + m * 16 + fr;
                float h[8];
#pragma unroll
                for (int n = 0; n < 2; ++n)
#pragma unroll
                    for (int j = 0; j < 4; ++j) { const float gv = acc[ai][0][m][n][j], uv = acc[ai][1][m][n][j]; h[n * 4 + j] = gv / (1.0f + __expf(-gv)) * uv; }
                u32x4 w; w.x = cvt_pk_bf16(h[0], h[1]); w.y = cvt_pk_bf16(h[2], h[3]); w.z = cvt_pk_bf16(h[4], h[5]); w.w = cvt_pk_bf16(h[6], h[7]);
                if (r < u.nv) *(u32x4*)(O + (size_t)(u.r0 + r) * 256 + col0) = w; }
    }
};
struct EpiAxpyHMk {
    static constexpr bool PERM = false;
    float* H;
    __device__ __forceinline__ void operator()(const f32x4 (&acc)[2][2][4][2], const Unit& u, int wr, int wc, int fr, int fq) const {
        const int row0 = u.r0 + wr * 64 + fr, col0 = u.pn * BM + wc * 32 + 4 * fq;
#pragma unroll
        for (int ai = 0; ai < 2; ++ai)
#pragma unroll
            for (int m = 0; m < 4; ++m) { float* rowp = H + (size_t)(row0 + ai * HALF + m * 16) * D + col0;
#pragma unroll
                for (int bj = 0; bj < 2; ++bj)
#pragma unroll
                    for (int n = 0; n < 2; ++n) { f32x4* p = (f32x4*)(rowp + bj * HALF + n * 16); const f32x4 h = *p; *p = h * ALPHA + acc[ai][bj][m][n]; }
                asm volatile("" ::: "memory"); }
    }
};
struct EpiLogit {
    static constexpr bool PERM = false;
    float* L;
    __device__ __forceinline__ void operator()(const f32x4 (&acc)[2][2][4][2], const Unit& u, int wr, int wc, int fr, int fq) const {
        if (wc < 2) {
            const int row0 = u.r0 + wr * 64 + fr, col0 = wc * 32 + 4 * fq;
#pragma unroll
            for (int ai = 0; ai < 2; ++ai)
#pragma unroll
                for (int m = 0; m < 4; ++m) { float* rowp = L + (size_t)(row0 + ai * HALF + m * 16) * N_EXP + col0;
#pragma unroll
                    for (int n = 0; n < 2; ++n) *(f32x4*)(rowp + n * 16) = acc[ai][0][m][n]; }
        }
    }
};
struct EpiSlot {
    static constexpr bool PERM = true;
    bf16_t* slot; const int* list; const float* gate;
    const LAS int* ag;
    __device__ __forceinline__ void operator()(const f32x4 (&acc)[2][2][4][2], const Unit& u, int wr, int wc, int fr, int fq) const {
        const int col0 = u.pn * BM + wc * 32 + 8 * fq;
#pragma unroll
        for (int ai = 0; ai < 2; ++ai)
#pragma unroll
            for (int m = 0; m < 4; ++m) { const int r = ai * HALF + wr * 64 + m * 16 + fr;
                if (r < u.nv) { int aid; float gt;
                    if (u.slot < MOE_AGU) { const i32x2 t = *(const LAS i32x2*)(ag + (u.slot * 256 + r) * 2); aid = t.x; gt = __int_as_float(t.y); }
                    else { aid = list[u.lr0 + r]; gt = gate[aid]; }
                    bf16_t* rowp = slot + (size_t)aid * D + col0;
#pragma unroll
                    for (int bj = 0; bj < 2; ++bj) { const f32x4 v0 = acc[ai][bj][m][0] * gt, v1 = acc[ai][bj][m][1] * gt;
                        u32x4 w; w.x = cvt_pk_bf16(v0[0], v0[1]); w.y = cvt_pk_bf16(v0[2], v0[3]); w.z = cvt_pk_bf16(v1[0], v1[1]); w.w = cvt_pk_bf16(v1[2], v1[3]);
                        *(u32x4*)(rowp + bj * HALF) = w; } } }
    }
};
struct EpiVT {
    static constexpr bool PERM = true;
    bf16_t* O; int ldc; size_t ostride;
    __device__ __forceinline__ void operator()(const f32x4 (&acc)[2][2][4][2], const Unit& u, int wr, int wc, int fr, int fq) const {
        const int row0 = u.r0 + wr * 64 + fr; bf16_t* base = O + (size_t)u.g * ostride;
        const int c0 = wc * 32 + 8 * fq, n32 = c0 & 31, pos0 = 8 * ((n32 >> 2) & 3) + 4 * (n32 >> 4);
        const int col0 = u.pn * BM + (c0 & ~31) + pos0;
#pragma unroll
        for (int ai = 0; ai < 2; ++ai)
#pragma unroll
            for (int m = 0; m < 4; ++m) { bf16_t* rowp = base + (size_t)(row0 + ai * HALF + m * 16) * ldc + col0;
#pragma unroll
                for (int bj = 0; bj < 2; ++bj) { const f32x4 v0 = acc[ai][bj][m][0], v1 = acc[ai][bj][m][1];
                    u32x2 w0, w1; w0.x = cvt_pk_bf16(v0[0], v0[1]); w0.y = cvt_pk_bf16(v0[2], v0[3]); w1.x = cvt_pk_bf16(v1[0], v1[1]); w1.y = cvt_pk_bf16(v1[2], v1[3]);
                    *(u32x2*)(rowp + bj * HALF) = w0; *(u32x2*)(rowp + bj * HALF + 8) = w1; } }
    }
};
}

__device__ __forceinline__ f32x4 mfma16(bf16x8 a, bf16x8 b, f32x4 c) { return __builtin_amdgcn_mfma_f32_16x16x32_bf16(a, b, c, 0, 0, 0); }
__device__ __forceinline__ bf16x8 pack8(const f32x4& a, const f32x4& b) {
    u32x4 w; w.x = cvt_pk_bf16(a[0], a[1]); w.y = cvt_pk_bf16(a[2], a[3]); w.z = cvt_pk_bf16(b[0], b[1]); w.w = cvt_pk_bf16(b[2], b[3]);
    return __builtin_bit_cast(bf16x8, w);
}
__device__ __forceinline__ int lane_id() { unsigned z = 0u; asm volatile("" : "+s"(z)); return (int)__builtin_amdgcn_mbcnt_hi(~0u, __builtin_amdgcn_mbcnt_lo(~0u, z)); }
__device__ __forceinline__ float relu_f(float x) { const int b = __float_as_int(x); return __int_as_float(b > 0 ? b : 0); }
__device__ __forceinline__ float negbig() { float v; asm volatile("v_mov_b32 %0, 0xf149f2ca" : "=v"(v)); return v; }
__device__ __forceinline__ float shx(float v, int lane, int mask) { return __int_as_float(__builtin_amdgcn_ds_bpermute((lane ^ mask) << 2, __float_as_int(v))); }
__device__ __forceinline__ float xmax16_32(float v, int lane) { v = fmaxf(v, shx(v, lane, 16)); return fmaxf(v, shx(v, lane, 32)); }
__device__ __forceinline__ float xsum16_32(float v, int lane) { v += shx(v, lane, 16); return v + shx(v, lane, 32); }
__device__ __forceinline__ float wave_total(float v) {
    v += __int_as_float(__builtin_amdgcn_update_dpp(0, __float_as_int(v), 0x111, 0xf, 0xf, true));
    v += __int_as_float(__builtin_amdgcn_update_dpp(0, __float_as_int(v), 0x112, 0xf, 0xf, true));
    v += __int_as_float(__builtin_amdgcn_update_dpp(0, __float_as_int(v), 0x114, 0xf, 0xf, true));
    v += __int_as_float(__builtin_amdgcn_update_dpp(0, __float_as_int(v), 0x118, 0xf, 0xf, true));
    v += __int_as_float(__builtin_amdgcn_update_dpp(0, __float_as_int(v), 0x142, 0xa, 0xf, false));
    v += __int_as_float(__builtin_amdgcn_update_dpp(0, __float_as_int(v), 0x143, 0xc, 0xf, false));
    return __int_as_float(__builtin_amdgcn_readlane(__float_as_int(v), 63));
}
__device__ __forceinline__ float wsum(float v, int lane) { (void)lane; return wave_total(v); }
typedef __attribute__((address_space(8))) void* rsrc_t;
typedef __amdgpu_buffer_rsrc_t brsrc_t;
__device__ __forceinline__ brsrc_t make_rsrc(const void* p, unsigned bytes) { return __builtin_amdgcn_make_buffer_rsrc((void*)p, 0, (int)bytes, 0x00020000); }
__device__ __forceinline__ bf16x8 bld16(brsrc_t r, unsigned voff, unsigned soff) { return __builtin_bit_cast(bf16x8, __builtin_amdgcn_raw_buffer_load_b128(r, (int)voff, (int)soff, 0)); }
constexpr float LOG2E = 1.4426950408889634f;
constexpr float SM_THR = 8.0f;

#define MEMFENCE() asm volatile("" ::: "memory")
__device__ __forceinline__ void diff_attn_wave(const bf16* QB, brsrc_t rK, brsrc_t rV, bf16* CAT, int b, int h, int q0, float lam, float lambda_init, const float* subln, int lane) {
    const int qi = lane & 15, g = lane >> 4, tq = q0 + qi, cq = q0 >> 6;
    const float slope = exp2f(-2.0f * (float)(h + 1)), c1 = 0.125f * LOG2E, kb = slope * 8.0f;
    const bf16* qrow = QB + (size_t)(b * SEQ + tq) * 512 + h * 128;
    bf16x8 qf[2][2];
#pragma unroll
    for (int m = 0; m < 2; ++m)
#pragma unroll
        for (int s = 0; s < 2; ++s) qf[m][s] = *(const bf16x8*)(qrow + m * 64 + 32 * s + 8 * g);
    f32x4 o1[8], o2[8];
#pragma unroll
    for (int i = 0; i < 8; ++i) { o1[i] = (f32x4){0.f, 0.f, 0.f, 0.f}; o2[i] = (f32x4){0.f, 0.f, 0.f, 0.f}; }
    float m1 = negbig(), m2 = negbig(), l1 = 0.f, l2 = 0.f;
    const unsigned kvo = (unsigned)(((lane & 15) * 512 + h * 128 + 8 * g) * 2);
    const unsigned vvo = (unsigned)(((h * 128 + (lane & 15)) * VTD_LD + 8 * g) * 2);
    bf16x8 kf[2][4];
    { const int base = 32 * (2 * cq + 1);
#pragma unroll
      for (int sub = 0; sub < 2; ++sub) { const unsigned so = (unsigned)(b * SEQ + base + 16 * sub) * 1024u;
#pragma unroll
          for (int j = 0; j < 4; ++j) kf[sub][j] = bld16(rK, kvo + 64 * j, so); } }
    MEMFENCE();
#pragma unroll 1
    for (int grp = 2 * cq + 1; grp >= 0; --grp) {
        const int base = 32 * grp;
        bf16x8 vf[8];
        { const unsigned sv = (unsigned)(b * SEQ + base) * 2u;
#pragma unroll
          for (int ds = 0; ds < 8; ++ds) vf[ds] = bld16(rV, vvo, sv + (unsigned)ds * (16u * VTD_LD * 2u)); }
        MEMFENCE();
        f32x4 s1[2], s2[2];
#pragma unroll
        for (int sub = 0; sub < 2; ++sub) {
            f32x4 init;
#pragma unroll
            for (int i = 0; i < 4; ++i) { const int key = base + 16 * sub + 4 * g + i; const int kk = key < 2 * tq - key ? key : 2 * tq - key; init[i] = kb * (float)(kk - 64 * cq); }
            s1[sub] = mfma16(kf[sub][0], qf[0][0], init); s1[sub] = mfma16(kf[sub][1], qf[0][1], s1[sub]);
            s2[sub] = mfma16(kf[sub][2], qf[1][0], init); s2[sub] = mfma16(kf[sub][3], qf[1][1], s2[sub]);
        }
        { const int nb = (grp > 0) ? base - 32 : base;
#pragma unroll
          for (int sub = 0; sub < 2; ++sub) { const unsigned so = (unsigned)(b * SEQ + nb + 16 * sub) * 1024u;
#pragma unroll
              for (int j = 0; j < 4; ++j) kf[sub][j] = bld16(rK, kvo + 64 * j, so); } }
        MEMFENCE();
        float mx1 = fmaxf(fmaxf(fmaxf(s1[0][0], s1[0][1]), fmaxf(s1[0][2], s1[0][3])), fmaxf(fmaxf(s1[1][0], s1[1][1]), fmaxf(s1[1][2], s1[1][3])));
        float mx2 = fmaxf(fmaxf(fmaxf(s2[0][0], s2[0][1]), fmaxf(s2[0][2], s2[0][3])), fmaxf(fmaxf(s2[1][0], s2[1][1]), fmaxf(s2[1][2], s2[1][3])));
        const float t1 = c1 * xmax16_32(mx1, lane), t2 = c1 * xmax16_32(mx2, lane);
        if (__any((t1 > m1 + SM_THR) || (t2 > m2 + SM_THR))) {
            const float n1 = fmaxf(m1, t1), n2 = fmaxf(m2, t2), a1 = __builtin_amdgcn_exp2f(m1 - n1), a2 = __builtin_amdgcn_exp2f(m2 - n2);
            l1 *= a1; l2 *= a2; m1 = n1; m2 = n2;
#pragma unroll
            for (int i = 0; i < 8; ++i) { o1[i] *= a1; o2[i] *= a2; }
        }
#pragma unroll
        for (int sub = 0; sub < 2; ++sub)
#pragma unroll
            for (int i = 0; i < 4; ++i) { s1[sub][i] = __builtin_amdgcn_exp2f(c1 * s1[sub][i] - m1); s2[sub][i] = __builtin_amdgcn_exp2f(c1 * s2[sub][i] - m2); l1 += s1[sub][i]; l2 += s2[sub][i]; }
        const bf16x8 p1 = pack8(s1[0], s1[1]), p2 = pack8(s2[0], s2[1]);
#pragma unroll
        for (int ds = 0; ds < 8; ++ds) { o1[ds] = mfma16(vf[ds], p1, o1[ds]); o2[ds] = mfma16(vf[ds], p2, o2[ds]); }
    }
    l1 = xsum16_32(l1, lane); l2 = xsum16_32(l2, lane);
    const float i1 = 1.0f / l1, i2 = lam / l2; float ss = 0.f;
#pragma unroll
    for (int ds = 0; ds < 8; ++ds)
#pragma unroll
        for (int i = 0; i < 4; ++i) { const float v = o1[ds][i] * i1 - o2[ds][i] * i2; o1[ds][i] = v; ss += v * v; }
    ss = xsum16_32(ss, lane);
    const float r = (1.0f / sqrtf(ss * (1.0f / 128.0f) + RMS_EPS)) * (1.0f - lambda_init);
    bf16* orow = CAT + (size_t)(b * SEQ + tq) * D + 512 + h * 128 + 4 * g;
#pragma unroll
    for (int ds = 0; ds < 8; ++ds) { const f32x4 sl = *(const f32x4*)(subln + 16 * ds + 4 * g); const f32x4 y = o1[ds] * r * sl;
        u32x2 w; w.x = cvt_pk_bf16(y[0], y[1]); w.y = cvt_pk_bf16(y[2], y[3]); *(u32x2*)(orow + 16 * ds) = w; }
}

__device__ __forceinline__ void diff_attn_unit(LAS unsigned char* lds, const bf16* QB, const bf16* KB, const bf16* VT, bf16* CAT, int b, int h, int ub, int wave, float lam, float lambda_init, const float* subln) {
    const int lane = lane_id(), tid = wave * 64 + lane;
    const int qi = lane & 15, g = lane >> 4, q0 = 128 * ub + 16 * wave, tq = q0 + qi, cq = q0 >> 6;
    float c1 = 0.125f * LOG2E; asm volatile("" : "+v"(c1));
    const float kb2 = exp2f(-2.0f * (float)(h + 1)) * LOG2E;
    const bf16* qrow = QB + (size_t)(b * SEQ + tq) * 512 + h * 128;
    bf16x8 qf[2][2];
#pragma unroll
    for (int m = 0; m < 2; ++m)
#pragma unroll
        for (int s = 0; s < 2; ++s) { const u32x4 r = *(const u32x4*)(qrow + m * 64 + 32 * s + 8 * g); u32x4 w;
            w.x = cvt_pk_bf16(__uint_as_float(r.x << 16) * c1, __uint_as_float(r.x & 0xffff0000u) * c1); w.y = cvt_pk_bf16(__uint_as_float(r.y << 16) * c1, __uint_as_float(r.y & 0xffff0000u) * c1);
            w.z = cvt_pk_bf16(__uint_as_float(r.z << 16) * c1, __uint_as_float(r.z & 0xffff0000u) * c1); w.w = cvt_pk_bf16(__uint_as_float(r.w << 16) * c1, __uint_as_float(r.w & 0xffff0000u) * c1);
            qf[m][s] = __builtin_bit_cast(bf16x8, w); }
    unsigned one2 = 0x3f803f80u; asm volatile("" : "+v"(one2));
    const bf16x8 ones = __builtin_bit_cast(bf16x8, (u32x4){one2, one2, one2, one2});
    f32x4 o1[8], o2[8], ol1, ol2;
    { float z = 0.f; asm volatile("" : "+v"(z));
#pragma unroll
      for (int i = 0; i < 8; ++i) { o1[i] = (f32x4){z, z, z, z}; o2[i] = (f32x4){z, z, z, z}; }
      ol1 = (f32x4){z, z, z, z}; ol2 = (f32x4){z, z, z, z}; }
    float m1 = 0.f, m2 = 0.f; bool first = true;
    float ib[2][4];
#pragma unroll
    for (int sub = 0; sub < 2; ++sub)
#pragma unroll
        for (int i = 0; i < 4; ++i) ib[sub][i] = kb2 * (float)(16 * sub + 4 * g + i);
    const int skey = tid >> 4, sch = tid & 15, sd = tid >> 2, svc = tid & 3;
    const bf16* kg = KB + (size_t)(b * SEQ + skey) * 512 + h * 128 + sch * 8;
    const bf16* vg = VT + (size_t)(h * 128 + sd) * VTD_LD + (size_t)b * SEQ + 8 * svc;
    const unsigned kdst = (unsigned)(skey * 256 + ((sch ^ (skey & 15)) * 16)), vdst = (unsigned)(8192 + sd * 64 + (((svc + (sd >> 2)) & 3) * 16));
    unsigned ka[2][4], va[8];
#pragma unroll
    for (int sub = 0; sub < 2; ++sub)
#pragma unroll
        for (int j = 0; j < 4; ++j) { const int row = 16 * sub + qi; ka[sub][j] = (unsigned)(row * 256 + (((4 * j + g) ^ (row & 15)) * 16)); }
#pragma unroll
    for (int ds = 0; ds < 8; ++ds) { const int d = 16 * ds + qi; va[ds] = (unsigned)(8192 + d * 64 + (((g + (d >> 2)) & 3) * 16)); }
    const int gmax = 4 * ub + 3, gmine = 2 * cq + 1;
    u32x4 kregA = *(const u32x4*)(kg + (size_t)(32 * gmax) * 512), vregA = *(const u32x4*)(vg + 32 * gmax);
    u32x4 kregB = *(const u32x4*)(kg + (size_t)(32 * (gmax - 1)) * 512), vregB = *(const u32x4*)(vg + 32 * (gmax - 1));
#pragma unroll 1
    for (int gp = gmax; gp >= 1; gp -= 2) {
      LAS unsigned char* sb = lds + (((gp >> 1) & 1) ? 32768 : 0);
      *(LAS u32x4*)(sb + 16384 + kdst) = kregA; *(LAS u32x4*)(sb + 16384 + vdst) = vregA; *(LAS u32x4*)(sb + kdst) = kregB; *(LAS u32x4*)(sb + vdst) = vregB;
      { const int na = gp > 1 ? gp - 2 : 1, nb = na - 1;
        kregA = *(const u32x4*)(kg + (size_t)(32 * na) * 512); vregA = *(const u32x4*)(vg + 32 * na); kregB = *(const u32x4*)(kg + (size_t)(32 * nb) * 512); vregB = *(const u32x4*)(vg + 32 * nb); }
      MEMFENCE();
      __syncthreads();
#pragma unroll
      for (int half = 0; half < 2; ++half) {
        const int grp = gp - half;
        LAS unsigned char* buf = sb + ((grp & 1) ? 16384 : 0);
        if (grp <= gmine) {
            const int base = 32 * grp;
            bf16x8 kf[2][4];
#pragma unroll
            for (int sub = 0; sub < 2; ++sub)
#pragma unroll
                for (int j = 0; j < 4; ++j) kf[sub][j] = *(const LAS bf16x8*)(buf + ka[sub][j]);
            __builtin_amdgcn_sched_barrier(0);
            f32x4 s1[2], s2[2];
            if (base + 31 <= q0) {
                const float gb = kb2 * (float)(base - 64 * cq), g1 = gb - m1, g2 = gb - m2;
#pragma unroll
                for (int sub = 0; sub < 2; ++sub)
#pragma unroll
                    for (int i = 0; i < 4; ++i) { s1[sub][i] = ib[sub][i] + g1; s2[sub][i] = ib[sub][i] + g2; }
            } else {
#pragma unroll
                for (int sub = 0; sub < 2; ++sub)
#pragma unroll
                    for (int i = 0; i < 4; ++i) { const int key = base + 16 * sub + 4 * g + i; const int kk = key < 2 * tq - key ? key : 2 * tq - key; const float bv = kb2 * (float)(kk - 64 * cq); s1[sub][i] = bv - m1; s2[sub][i] = bv - m2; }
            }
#pragma unroll
            for (int sub = 0; sub < 2; ++sub) {
                s1[sub] = mfma16(kf[sub][0], qf[0][0], s1[sub]); s2[sub] = mfma16(kf[sub][2], qf[1][0], s2[sub]);
                s1[sub] = mfma16(kf[sub][1], qf[0][1], s1[sub]); s2[sub] = mfma16(kf[sub][3], qf[1][1], s2[sub]);
            }
            const float mx1 = fmaxf(fmaxf(fmaxf(s1[0][0], s1[0][1]), fmaxf(s1[0][2], s1[0][3])), fmaxf(fmaxf(s1[1][0], s1[1][1]), fmaxf(s1[1][2], s1[1][3])));
            const float mx2 = fmaxf(fmaxf(fmaxf(s2[0][0], s2[0][1]), fmaxf(s2[0][2], s2[0][3])), fmaxf(fmaxf(s2[1][0], s2[1][1]), fmaxf(s2[1][2], s2[1][3])));
            if (first || __any((mx1 > -30.0f) || (mx2 > -30.0f))) {
                bf16x8 vf[8];
#pragma unroll
                for (int ds = 0; ds < 8; ++ds) vf[ds] = *(const LAS bf16x8*)(buf + va[ds]);
                __builtin_amdgcn_sched_barrier(0);
                if (first || __any((mx1 > SM_THR) || (mx2 > SM_THR))) {
                    const float t1 = xmax16_32(mx1, lane), t2 = xmax16_32(mx2, lane);
                    const float d1 = first ? t1 : fmaxf(t1, 0.f), d2 = first ? t2 : fmaxf(t2, 0.f);
                    m1 += d1; m2 += d2;
                    if (!first) { const float a1 = __builtin_amdgcn_exp2f(-d1), a2 = __builtin_amdgcn_exp2f(-d2);
#pragma unroll
                        for (int i = 0; i < 8; ++i) { o1[i] *= a1; o2[i] *= a2; }
                        ol1 *= a1; ol2 *= a2; }
#pragma unroll
                    for (int sub = 0; sub < 2; ++sub)
#pragma unroll
                        for (int i = 0; i < 4; ++i) { s1[sub][i] -= d1; s2[sub][i] -= d2; }
                    first = false;
                }
#pragma unroll
                for (int sub = 0; sub < 2; ++sub)
#pragma unroll
                    for (int i = 0; i < 4; ++i) { s1[sub][i] = __builtin_amdgcn_exp2f(s1[sub][i]); s2[sub][i] = __builtin_amdgcn_exp2f(s2[sub][i]); }
                const bf16x8 p1 = pack8(s1[0], s1[1]), p2 = pack8(s2[0], s2[1]);
#pragma unroll
                for (int ds = 0; ds < 8; ++ds) { o1[ds] = mfma16(vf[ds], p1, o1[ds]); o2[ds] = mfma16(vf[ds], p2, o2[ds]); }
                ol1 = mfma16(ones, p1, ol1); ol2 = mfma16(ones, p2, ol2);
            }
        }
      }
    }
    const float i1 = 1.0f / ol1[0], i2 = lam / ol2[0]; float ss = 0.f;
    f32x4 sl[8];
#pragma unroll
    for (int ds = 0; ds < 8; ++ds) sl[ds] = *(const f32x4*)(subln + 16 * ds + 4 * g);
#pragma unroll
    for (int ds = 0; ds < 8; ++ds)
#pragma unroll
        for (int i = 0; i < 4; ++i) { const float v = o1[ds][i] * i1 - o2[ds][i] * i2; o1[ds][i] = v; ss += v * v; }
    ss = xsum16_32(ss, lane);
    const float r = (1.0f / sqrtf(ss * (1.0f / 128.0f) + RMS_EPS)) * (1.0f - lambda_init);
    bf16* orow = CAT + (size_t)(b * SEQ + tq) * D + 512 + h * 128 + 4 * g;
#pragma unroll
    for (int ds = 0; ds < 8; ++ds) { const f32x4 y = o1[ds] * r * sl[ds];
        u32x2 w; w.x = cvt_pk_bf16(y[0], y[1]); w.y = cvt_pk_bf16(y[2], y[3]); *(u32x2*)(orow + 16 * ds) = w; }
    __syncthreads();
}

__device__ __forceinline__ void mem_attn_wave(const bf16* QM, brsrc_t rK, brsrc_t rV, bf16* OM, int b, int h, int t0, int lane) {
    const int qi = lane & 15, g = lane >> 4; const float c1 = 0.0625f * LOG2E;
    const bf16* qrow = QM + (size_t)(t0 + qi) * D + h * 256 + 8 * g;
    bf16x8 qf[8];
#pragma unroll
    for (int s = 0; s < 8; ++s) qf[s] = *(const bf16x8*)(qrow + 32 * s);
    f32x4 o[16];
#pragma unroll
    for (int i = 0; i < 16; ++i) o[i] = (f32x4){0.f, 0.f, 0.f, 0.f};
    float mm = negbig(), ll = 0.f;
    const unsigned kvo = (unsigned)(((lane & 15) * KM_LD + h * 256 + 8 * g) * 2);
    const unsigned vvo = (unsigned)(((h * 256 + (lane & 15)) * VTM_LD + 8 * g) * 2);
    bf16x8 kf[8];
    { const unsigned so = (unsigned)(b * MEM_TOK) * (unsigned)(KM_LD * 2);
#pragma unroll
      for (int s = 0; s < 8; ++s) kf[s] = bld16(rK, kvo + 64 * s, so); }
    MEMFENCE();
#pragma unroll 1
    for (int grp = 0; grp < 8; ++grp) {
        const int base = 32 * grp;
        f32x4 sc[2];
#pragma unroll
        for (int sub = 0; sub < 2; ++sub) {
            f32x4 a = (f32x4){0.f, 0.f, 0.f, 0.f};
#pragma unroll
            for (int s = 0; s < 8; ++s) a = mfma16(kf[s], qf[s], a);
            sc[sub] = a;
            { const int nk = base + 16 * sub + 16; const unsigned so = (unsigned)(b * MEM_TOK + (nk < MEM_TOK ? nk : 0)) * (unsigned)(KM_LD * 2);
#pragma unroll
              for (int s = 0; s < 8; ++s) kf[s] = bld16(rK, kvo + 64 * s, so); }
            MEMFENCE();
        }
        bf16x8 vf[8];
        const unsigned sv = (unsigned)(b * MEM_TOK + base) * 2u;
#pragma unroll
        for (int ds = 0; ds < 8; ++ds) vf[ds] = bld16(rV, vvo, sv + (unsigned)ds * (16u * VTM_LD * 2u));
        MEMFENCE();
        const float mx = fmaxf(fmaxf(fmaxf(sc[0][0], sc[0][1]), fmaxf(sc[0][2], sc[0][3])), fmaxf(fmaxf(sc[1][0], sc[1][1]), fmaxf(sc[1][2], sc[1][3])));
        const float t = c1 * xmax16_32(mx, lane);
        if (__any(t > mm + SM_THR)) { const float n = fmaxf(mm, t), a = __builtin_amdgcn_exp2f(mm - n); ll *= a; mm = n;
#pragma unroll
            for (int i = 0; i < 16; ++i) o[i] *= a; }
#pragma unroll
        for (int sub = 0; sub < 2; ++sub)
#pragma unroll
            for (int i = 0; i < 4; ++i) { sc[sub][i] = __builtin_amdgcn_exp2f(c1 * sc[sub][i] - mm); ll += sc[sub][i]; }
        const bf16x8 pf = pack8(sc[0], sc[1]);
#pragma unroll
        for (int ds = 0; ds < 8; ++ds) o[ds] = mfma16(vf[ds], pf, o[ds]);
#pragma unroll
        for (int ds = 0; ds < 8; ++ds) vf[ds] = bld16(rV, vvo, sv + (unsigned)(ds + 8) * (16u * VTM_LD * 2u));
        MEMFENCE();
#pragma unroll
        for (int ds = 0; ds < 8; ++ds) o[ds + 8] = mfma16(vf[ds], pf, o[ds + 8]);
    }
    ll = xsum16_32(ll, lane); const float inv = 1.0f / ll;
    bf16* orow = OM + (size_t)(t0 + qi) * D + h * 256 + 4 * g;
#pragma unroll
    for (int ds = 0; ds < 16; ++ds) { const f32x4 y = o[ds] * inv; u32x2 w; w.x = cvt_pk_bf16(y[0], y[1]); w.y = cvt_pk_bf16(y[2], y[3]); *(u32x2*)(orow + 16 * ds) = w; }
}

__device__ __forceinline__ void mem_attn_unit(LAS unsigned char* lds, const bf16* QM, const bf16* KM, const bf16* VT, bf16* OM, int tb, int h, int wave) {
    const int lane = lane_id(), tid = wave * 64 + lane;
    const int qi = lane & 15, g = lane >> 4, t0 = 128 * tb + 16 * wave, b = (128 * tb) / SEQ;
    float c1 = 0.0625f * LOG2E; asm volatile("" : "+v"(c1));
    const bf16* qrow = QM + (size_t)(t0 + qi) * D + h * 256 + 8 * g;
    bf16x8 qf[8];
#pragma unroll
    for (int s = 0; s < 8; ++s) { const u32x4 r = *(const u32x4*)(qrow + 32 * s); u32x4 w;
        w.x = cvt_pk_bf16(__uint_as_float(r.x << 16) * c1, __uint_as_float(r.x & 0xffff0000u) * c1); w.y = cvt_pk_bf16(__uint_as_float(r.y << 16) * c1, __uint_as_float(r.y & 0xffff0000u) * c1);
        w.z = cvt_pk_bf16(__uint_as_float(r.z << 16) * c1, __uint_as_float(r.z & 0xffff0000u) * c1); w.w = cvt_pk_bf16(__uint_as_float(r.w << 16) * c1, __uint_as_float(r.w & 0xffff0000u) * c1);
        qf[s] = __builtin_bit_cast(bf16x8, w); }
    unsigned one2 = 0x3f803f80u; asm volatile("" : "+v"(one2));
    const bf16x8 ones = __builtin_bit_cast(bf16x8, (u32x4){one2, one2, one2, one2});
    f32x4 o[16], ol;
    { float z = 0.f; asm volatile("" : "+v"(z));
#pragma unroll
      for (int i = 0; i < 16; ++i) o[i] = (f32x4){z, z, z, z};
      ol = (f32x4){z, z, z, z}; }
    float mm = 0.f;
    const bf16* kg[2]; const bf16* vg[2]; unsigned kdst[2], vdst[2];
#pragma unroll
    for (int i = 0; i < 2; ++i) { const int n = tid + 512 * i, key = n >> 5, ch = n & 31, d = n >> 2, c = n & 3;
        kg[i] = KM + (size_t)(b * MEM_TOK + key) * KM_LD + h * 256 + ch * 8; kdst[i] = (unsigned)(key * 512 + (((ch & 16) | ((ch ^ key) & 15)) * 16));
        vg[i] = VT + (size_t)(h * 256 + d) * VTM_LD + b * MEM_TOK + 8 * c; vdst[i] = (unsigned)(16384 + d * 64 + (((c + (d >> 2)) & 3) * 16)); }
    unsigned ka[2][8], va[16];
#pragma unroll
    for (int sub = 0; sub < 2; ++sub)
#pragma unroll
        for (int s = 0; s < 8; ++s) { const int row = 16 * sub + qi, ch = 4 * s + g; ka[sub][s] = (unsigned)(row * 512 + (((ch & 16) | ((ch ^ row) & 15)) * 16)); }
#pragma unroll
    for (int ds = 0; ds < 16; ++ds) { const int d = 16 * ds + qi; va[ds] = (unsigned)(16384 + d * 64 + (((g + (d >> 2)) & 3) * 16)); }
    u32x4 kreg[2], vreg[2];
#pragma unroll
    for (int i = 0; i < 2; ++i) { kreg[i] = *(const u32x4*)(kg[i]); vreg[i] = *(const u32x4*)(vg[i]); }
#pragma unroll 1
    for (int grp = 0; grp < 8; ++grp) {
        LAS unsigned char* buf = lds + ((grp & 1) ? 32768 : 0);
#pragma unroll
        for (int i = 0; i < 2; ++i) { *(LAS u32x4*)(buf + kdst[i]) = kreg[i]; *(LAS u32x4*)(buf + vdst[i]) = vreg[i]; }
        { const int ng = grp < 7 ? grp + 1 : 7;
#pragma unroll
          for (int i = 0; i < 2; ++i) { kreg[i] = *(const u32x4*)(kg[i] + (size_t)(32 * ng) * KM_LD); vreg[i] = *(const u32x4*)(vg[i] + 32 * ng); } }
        MEMFENCE();
        __syncthreads();
        bf16x8 kf[2][8];
#pragma unroll
        for (int sub = 0; sub < 2; ++sub)
#pragma unroll
            for (int s = 0; s < 8; ++s) kf[sub][s] = *(const LAS bf16x8*)(buf + ka[sub][s]);
        __builtin_amdgcn_sched_barrier(0);
        f32x4 sc[2];
        { const float nm = -mm; sc[0] = (f32x4){nm, nm, nm, nm}; sc[1] = (f32x4){nm, nm, nm, nm}; }
#pragma unroll
        for (int s = 0; s < 8; ++s) { sc[0] = mfma16(kf[0][s], qf[s], sc[0]); sc[1] = mfma16(kf[1][s], qf[s], sc[1]); }
        bf16x8 vf[16];
#pragma unroll
        for (int ds = 0; ds < 16; ++ds) vf[ds] = *(const LAS bf16x8*)(buf + va[ds]);
        __builtin_amdgcn_sched_barrier(0);
        const float mx = fmaxf(fmaxf(fmaxf(sc[0][0], sc[0][1]), fmaxf(sc[0][2], sc[0][3])), fmaxf(fmaxf(sc[1][0], sc[1][1]), fmaxf(sc[1][2], sc[1][3])));
        if (grp == 0 || __any(mx > SM_THR)) {
            const float t = xmax16_32(mx, lane), d = grp == 0 ? t : fmaxf(t, 0.f); mm += d;
            if (grp != 0) { const float a = __builtin_amdgcn_exp2f(-d);
#pragma unroll
                for (int i = 0; i < 16; ++i) o[i] *= a;
                ol *= a; }
#pragma unroll
            for (int sub = 0; sub < 2; ++sub)
#pragma unroll
                for (int i = 0; i < 4; ++i) sc[sub][i] -= d;
        }
#pragma unroll
        for (int sub = 0; sub < 2; ++sub)
#pragma unroll
            for (int i = 0; i < 4; ++i) sc[sub][i] = __builtin_amdgcn_exp2f(sc[sub][i]);
        const bf16x8 pf = pack8(sc[0], sc[1]);
#pragma unroll
        for (int ds = 0; ds < 16; ++ds) o[ds] = mfma16(vf[ds], pf, o[ds]);
        ol = mfma16(ones, pf, ol);
    }
    const float inv = 1.0f / ol[0];
    bf16* orow = OM + (size_t)(t0 + qi) * D + h * 256 + 4 * g;
#pragma unroll
    for (int ds = 0; ds < 16; ++ds) { const f32x4 y = o[ds] * inv; u32x2 w; w.x = cvt_pk_bf16(y[0], y[1]); w.y = cvt_pk_bf16(y[2], y[3]); *(u32x2*)(orow + 16 * ds) = w; }
    __syncthreads();
}

constexpr int TK_SC = 0;
constexpr int TK_QL = 131072;
constexpr int TK_SEL = TK_QL + 16384;
constexpr int TK_HIST = TK_SEL + 4096;
constexpr int TK_CAND = TK_HIST + 8192;
constexpr int TK_MM = TK_CAND + 2048;
constexpr int TK_CAP = 32;
static_assert(TK_MM + 128 <= LDS_MISC, "sparse-attention LDS map");
#ifndef REP_S2X
#define REP_S2X 1
#endif
#ifndef REP_S3
#define REP_S3 1
#endif
#ifndef TOPK_SLOW
#define TOPK_SLOW 1
#endif
#ifndef TOPK_MODE
#define TOPK_MODE 0
#endif
typedef float f32x16v __attribute__((ext_vector_type(16)));
__device__ __forceinline__ unsigned f2ord(float f) { const unsigned u = __float_as_uint(f); return (u & 0x80000000u) ? ~u : (u | 0x80000000u); }
__device__ __forceinline__ float ord2f(unsigned k) { return __uint_as_float((k & 0x80000000u) ? (k & 0x7fffffffu) : ~k); }
__device__ __forceinline__ unsigned offb(unsigned row, unsigned ch) { return 256u * row + 16u * (ch ^ (((row & 3u) << 2) | ((row >> 2) & 3u))); }
__device__ __forceinline__ int wave_incl_scan(int v, int lane) {
    (void)lane;
    v += __builtin_amdgcn_update_dpp(0, v, 0x111, 0xf, 0xf, true);
    v += __builtin_amdgcn_update_dpp(0, v, 0x112, 0xf, 0xf, true);
    v += __builtin_amdgcn_update_dpp(0, v, 0x114, 0xf, 0xf, true);
    v += __builtin_amdgcn_update_dpp(0, v, 0x118, 0xf, 0xf, true);
    v += __builtin_amdgcn_update_dpp(0, v, 0x142, 0xa, 0xf, false);
    v += __builtin_amdgcn_update_dpp(0, v, 0x143, 0xc, 0xf, false);
    return v;
}
__device__ __forceinline__ void hist_cross(const LAS unsigned* hist, int target, int lane, int& tb, int& cabove, int& cnt) {
    const u32x4 c = *(const LAS u32x4*)(hist + 4 * lane);
    const int s4 = (int)(c.x + c.y + c.z + c.w), incl = wave_incl_scan(s4, lane), excl = incl - s4;
    const bool has = (excl < target) && (incl >= target);
    int cum = excl, b = 0, ca = excl, cn = (int)c.x;
    { const int c0 = (int)c.x, c1 = (int)c.y, c2 = (int)c.z, c3 = (int)c.w;
      if (cum + c0 >= target) { b = 0; ca = cum; cn = c0; }
      else if (cum + c0 + c1 >= target) { b = 1; ca = cum + c0; cn = c1; }
      else if (cum + c0 + c1 + c2 >= target) { b = 2; ca = cum + c0 + c1; cn = c2; }
      else { b = 3; ca = cum + c0 + c1 + c2; cn = c3; } }
    const unsigned long long m = __ballot(has);
    const int src = m ? (int)__builtin_ctzll(m) : 0;
    tb = __builtin_amdgcn_readlane(4 * lane + b, src); cabove = __builtin_amdgcn_readlane(ca, src); cnt = __builtin_amdgcn_readlane(cn, src);
}
#define TR_READ(dst, addr) asm volatile("ds_read_b64_tr_b16 %0, %1" : "=v"(dst) : "v"(addr) : "memory")
#define TR_READ_O(dst, addr, off) asm volatile("ds_read_b64_tr_b16 %0, %1 offset:%2" : "=v"(dst) : "v"(addr), "n"(off) : "memory")

__device__ __forceinline__ float tk_coord(float mx, float x, float scale) { return __fmul_rn(__fsub_rn(mx, x), scale); }
__device__ __forceinline__ int tk_sub(float t, int bin) { int sub = (int)__fmul_rn(__fsub_rn(t, (float)bin), 256.0f); return sub > 255 ? 255 : sub; }
__device__ __forceinline__ void topk_select(const LAS float* sc, LAS unsigned short* sel, LAS unsigned* hist, LAS float* cv, LAS unsigned* ci, float mx, float mn, int n, int lane) {
    const int nj = n >> 6;
    if (!(mx > mn)) {
        for (int i = lane; i < TOPK; i += 64) sel[i] = (unsigned short)i;
        return;
    }
    const float scale = 250.0f / (mx - mn);
    const unsigned long long ltmask = (1ull << lane) - 1ull;
    { unsigned zr; asm volatile("v_mov_b32 %0, 0" : "=v"(zr)); *(LAS u32x4*)(hist + 4 * lane) = (u32x4){zr, zr, zr, zr}; }
    LDS_WAIT();
    for (int j = 0; j < nj; j += 4) {
        float x4[4];
#pragma unroll
        for (int u = 0; u < 4; ++u) x4[u] = sc[lane + 64 * ((j + u) < nj ? (j + u) : j)];
#pragma unroll
        for (int u = 0; u < 4; ++u) { const int bin = (int)tk_coord(mx, x4[u], scale); if (j + u < nj) atomicAdd((unsigned*)(hist + bin), 1u); }
    }
    LDS_WAIT();
    int tb, cabove, cnt; hist_cross(hist, TOPK, lane, tb, cabove, cnt);
    int tcode = tb * 256; const bool l1 = cnt > TK_CAP;
    if (l1) {
        { unsigned zr; asm volatile("v_mov_b32 %0, 0" : "=v"(zr)); *(LAS u32x4*)(hist + 4 * lane) = (u32x4){zr, zr, zr, zr}; }
        LDS_WAIT();
#pragma unroll 4
        for (int j = 0; j < nj; ++j) { const float x = sc[lane + 64 * j]; const float t = tk_coord(mx, x, scale); const int bin = (int)t;
            if (bin == tb) { const int sub = tk_sub(t, bin); atomicAdd((unsigned*)(hist + sub), 1u); } }
        LDS_WAIT();
        int tb2, ca2, cnt2; hist_cross(hist, TOPK - cabove, lane, tb2, ca2, cnt2);
        tcode += tb2; cnt = cnt2;
    }
    int base = 0, cb = 0;
    for (int j0 = 0; j0 < nj; j0 += 4) {
        float x4[4];
#pragma unroll
        for (int u = 0; u < 4; ++u) x4[u] = sc[lane + 64 * ((j0 + u) < nj ? (j0 + u) : j0)];
#pragma unroll
        for (int u = 0; u < 4; ++u) {
            const int idx = lane + 64 * (j0 + u); const float x = x4[u]; const float t = tk_coord(mx, x, scale); const int bin = (int)t;
            int sub = 0; if (l1) sub = tk_sub(t, bin);
            const int code = (j0 + u < nj) ? bin * 256 + sub : 0x7fffffff;
            const unsigned long long sm = __ballot(code < tcode), cm = __ballot(code == tcode);
            if (code < tcode) sel[base + __popcll(sm & ltmask)] = (unsigned short)idx;
            if (code == tcode) { const int pos = cb + __popcll(cm & ltmask); if (pos < TK_CAP) { cv[pos] = x; ci[pos] = (unsigned)idx; } }
            base += __popcll(sm); cb += __popcll(cm);
        }
    }
    LDS_WAIT();
    const int r = TOPK - base;
    if (cb <= TK_CAP) {
        const float v = lane < cb ? cv[lane] : 0.f; int rank = 0;
        for (int j = 0; j < cb; ++j) { const float u = cv[j]; rank += (u > v || (u == v && j < lane)) ? 1 : 0; }
        const bool take = lane < cb && rank < r;
        const unsigned long long tm = __ballot(take);
        if (take) sel[base + __popcll(tm & ltmask)] = (unsigned short)ci[lane];
    } else {
        unsigned prefix = 0u; int rem = r;
#pragma unroll 1
        for (int pb = 3; pb >= 0; --pb) {
            { unsigned zr; asm volatile("v_mov_b32 %0, 0" : "=v"(zr)); *(LAS u32x4*)(hist + 4 * lane) = (u32x4){zr, zr, zr, zr}; }
            LDS_WAIT();
            for (int j = 0; j < nj; ++j) { const float x = sc[lane + 64 * j]; const float t = tk_coord(mx, x, scale); const int bin = (int)t;
                int sub = 0; if (l1) sub = tk_sub(t, bin);
                const unsigned k = f2ord(x);
                if ((bin * 256 + sub) == tcode && (pb == 3 || (k >> (8 * (pb + 1))) == prefix)) atomicAdd((unsigned*)(hist + (255 - (int)((k >> (8 * pb)) & 255u))), 1u); }
            LDS_WAIT();
            int tbp, cab, cn; hist_cross(hist, rem, lane, tbp, cab, cn);
            rem -= cab; prefix = (prefix << 8) | (unsigned)(255 - tbp);
        }
        int outp = base, eqtaken = 0;
        for (int j = 0; j < nj; ++j) {
            const int idx = lane + 64 * j; const float x = sc[idx]; const float t = tk_coord(mx, x, scale); const int bin = (int)t;
            int sub = 0; if (l1) sub = tk_sub(t, bin);
            const bool isc = (bin * 256 + sub) == tcode; const unsigned k = f2ord(x);
            const unsigned long long em = __ballot(isc && k == prefix);
            const bool takeeq = isc && k == prefix && (eqtaken + __popcll(em & ltmask)) < rem;
            const bool take = (isc && k > prefix) || takeeq;
            const unsigned long long tm = __ballot(take);
            if (take) sel[outp + __popcll(tm & ltmask)] = (unsigned short)idx;
            outp += __popcll(tm); eqtaken += __popcll(em);
        }
    }
}

__device__ __forceinline__ void dsa_attn_query(brsrc_t rC, const LAS unsigned short* sel, LAS unsigned char* tile, bf16* ql  , int b, int tq) {
    const int lane = lane_id();
    const int g = lane >> 4, hd = lane & 15, h8 = hd & 7;
    float c1 = 0.125f * LOG2E; asm volatile("" : "+v"(c1));
    const float nsl2 = -__builtin_amdgcn_exp2f(-(float)(h8 + 1)) * LOG2E;
    bf16x8 qb[4];
#pragma unroll
    for (int s = 0; s < 4; ++s) { const u32x4 r = *(const u32x4*)(ql + h8 * 128 + 32 * s + 8 * g); u32x4 w;
        w.x = cvt_pk_bf16(__uint_as_float(r.x << 16) * c1, __uint_as_float(r.x & 0xffff0000u) * c1); w.y = cvt_pk_bf16(__uint_as_float(r.y << 16) * c1, __uint_as_float(r.y & 0xffff0000u) * c1);
        w.z = cvt_pk_bf16(__uint_as_float(r.z << 16) * c1, __uint_as_float(r.z & 0xffff0000u) * c1); w.w = cvt_pk_bf16(__uint_as_float(r.w << 16) * c1, __uint_as_float(r.w & 0xffff0000u) * c1);
        qb[s] = __builtin_bit_cast(bf16x8, w); }
    unsigned one2 = 0x3f803f80u; asm volatile("" : "+v"(one2));
    const bf16x8 ones = __builtin_bit_cast(bf16x8, (u32x4){one2, one2, one2, one2});
    f32x4 o[8], ol;
    { float z = 0.f; asm volatile("" : "+v"(z));
#pragma unroll
      for (int c = 0; c < 8; ++c) o[c] = (f32x4){z, z, z, z};
      ol = (f32x4){z, z, z, z}; }
    float mm = 0.f; bool first = true;
    unsigned ra[4], ta[8];
#pragma unroll
    for (int s = 0; s < 4; ++s) ra[s] = offb((unsigned)hd, (unsigned)(4 * s + g));
    { const unsigned q = (unsigned)(hd >> 2), p = (unsigned)(lane & 3);
#pragma unroll
      for (int c = 0; c < 8; ++c) ta[c] = offb(4u * g + q, 2u * c + (p >> 1)) + 8u * (p & 1u); }
    u32x4 grA[8], grB[8];
#define DSA_GATHER(GR, t_) do { _Pragma("unroll") for (int i = 0; i < 8; ++i) { const unsigned key = sel[32 * (t_) + 4 * i + g]; \
        GR[i] = __builtin_amdgcn_raw_buffer_load_b128(rC, (int)(((unsigned)(b * SEQ) + key) * 256u + (unsigned)hd * 16u), 0, 0); } } while (0)
#define DSA_TILE(tl, GR) do { \
        LAS unsigned char* img = tile + ((tl) & 1) * 8192; \
        _Pragma("unroll") for (int i = 0; i < 8; ++i) *(LAS u32x4*)(img + offb((unsigned)(4 * i + g), (unsigned)hd)) = GR[i]; \
        { const int nt_ = (tl) < 6 ? (tl) + 2 : 7; DSA_GATHER(GR, nt_); } \
        MEMFENCE(); \
        bf16x8 af[2][4]; \
        _Pragma("unroll") for (int rb = 0; rb < 2; ++rb) _Pragma("unroll") for (int s = 0; s < 4; ++s) af[rb][s] = *(const LAS bf16x8*)(img + ra[s] + 4096 * rb); \
        u32x2 tr[2][8]; const unsigned ib = (unsigned)(size_t)img; \
        _Pragma("unroll") for (int c = 0; c < 8; ++c) { const unsigned ad = ib + ta[c]; TR_READ(tr[0][c], ad); TR_READ_O(tr[1][c], ad, 4096); } \
        f32x4 sc[2]; \
        _Pragma("unroll") for (int rb = 0; rb < 2; ++rb) { const u32x2 kk = *(const LAS u32x2*)(sel + 32 * (tl) + 16 * rb + 4 * g); \
            const unsigned k4[4] = {kk.x & 0xffffu, kk.x >> 16, kk.y & 0xffffu, kk.y >> 16}; \
            _Pragma("unroll") for (int i = 0; i < 4; ++i) sc[rb][i] = __builtin_fmaf(nsl2, fabsf((float)(tq - (int)k4[i])), -mm); } \
        _Pragma("unroll") for (int s = 0; s < 4; ++s) { sc[0] = mfma16(af[0][s], qb[s], sc[0]); sc[1] = mfma16(af[1][s], qb[s], sc[1]); } \
        const float mx = fmaxf(fmaxf(fmaxf(sc[0][0], sc[0][1]), fmaxf(sc[0][2], sc[0][3])), fmaxf(fmaxf(sc[1][0], sc[1][1]), fmaxf(sc[1][2], sc[1][3]))); \
        if (first || __any(mx > SM_THR)) { \
            const float t = xmax16_32(mx, lane), d = first ? t : fmaxf(t, 0.f); mm += d; \
            if (!first) { const float alpha = __builtin_amdgcn_exp2f(-d); f32x4 ar; \
                _Pragma("unroll") for (int i = 0; i < 4; ++i) ar[i] = __int_as_float(__builtin_amdgcn_ds_bpermute((4 * g + i) << 2, __float_as_int(alpha))); \
                _Pragma("unroll") for (int c = 0; c < 8; ++c) o[c] *= ar; \
                ol *= ar; } \
            _Pragma("unroll") for (int rb = 0; rb < 2; ++rb) _Pragma("unroll") for (int i = 0; i < 4; ++i) sc[rb][i] -= d; \
            first = false; } \
        _Pragma("unroll") for (int rb = 0; rb < 2; ++rb) _Pragma("unroll") for (int i = 0; i < 4; ++i) sc[rb][i] = __builtin_amdgcn_exp2f(sc[rb][i]); \
        const bf16x8 pf = pack8(sc[0], sc[1]); \
        asm volatile("s_waitcnt lgkmcnt(0)" : "+v"(tr[0][0]), "+v"(tr[0][1]), "+v"(tr[0][2]), "+v"(tr[0][3]), "+v"(tr[0][4]), "+v"(tr[0][5]), "+v"(tr[0][6]), "+v"(tr[0][7]), \
                                              "+v"(tr[1][0]), "+v"(tr[1][1]), "+v"(tr[1][2]), "+v"(tr[1][3]), "+v"(tr[1][4]), "+v"(tr[1][5]), "+v"(tr[1][6]), "+v"(tr[1][7]) :: "memory"); \
        _Pragma("unroll") for (int c = 0; c < 8; ++c) { u32x4 bw; bw.x = tr[0][c].x; bw.y = tr[0][c].y; bw.z = tr[1][c].x; bw.w = tr[1][c].y; \
            o[c] = mfma16(pf, __builtin_bit_cast(bf16x8, bw), o[c]); } \
        ol = mfma16(pf, ones, ol); \
    } while (0)
    DSA_GATHER(grA, 0); DSA_GATHER(grB, 1);
    MEMFENCE();
    const int ntp = (tq >> 6) < 3 ? (tq >> 6) + 1 : 4;
#pragma unroll 1
    for (int tp = 0; tp < ntp; ++tp) { DSA_TILE(2 * tp, grA); DSA_TILE(2 * tp + 1, grB); }
#undef DSA_TILE
#undef DSA_GATHER
    if (g < 2) {
        bf16* olat = ql;
        f32x4 ir;
#pragma unroll
        for (int i = 0; i < 4; ++i) ir[i] = 1.0f / ol[i];
#pragma unroll
        for (int c = 0; c < 8; ++c) { const f32x4 y = o[c] * ir;
#pragma unroll
            for (int i = 0; i < 4; ++i) olat[(4 * g + i) * 128 + 16 * c + hd] = f2bf(y[i]); }
    }
}

__device__ const unsigned short c_diff_tab[1024] = {
    995,999,1003,1007,1011,1015,1019,1023,963,967,971,975,979,983,987,991,931,935,939,943,947,951,955,959,899,903,907,911,915,919,923,927,
    867,871,875,879,883,887,891,895,835,839,843,847,851,855,859,863,803,807,811,815,819,823,827,831,771,775,779,783,787,791,795,799,
    739,743,747,751,755,759,763,767,707,711,715,719,723,727,731,735,675,679,683,687,691,695,699,703,643,647,651,655,659,663,667,671,
    611,615,619,623,627,631,635,639,579,583,587,591,595,599,603,607,994,998,1002,1006,1010,1014,1018,1022,962,966,970,974,978,982,986,990,
    930,934,938,942,946,950,954,958,547,551,555,559,563,567,571,575,898,902,906,910,914,918,922,926,866,870,874,878,882,886,890,894,
    834,838,842,846,850,854,858,862,802,806,810,814,818,822,826,830,515,519,523,527,531,535,539,543,770,774,778,782,786,790,794,798,
    738,742,746,750,754,758,762,766,706,710,714,718,722,726,730,734,674,678,682,686,690,694,698,702,483,487,491,495,499,503,507,511,
    642,646,650,654,658,662,666,670,610,614,618,622,626,630,634,638,578,582,586,590,594,598,602,606,546,550,554,558,562,566,570,574,
    479,475,471,467,463,459,455,451,542,538,534,530,526,522,518,514,510,506,502,498,494,490,486,482,478,474,470,466,462,458,454,450,
    431,430,427,426,423,422,419,418,447,446,443,442,439,438,435,434,399,398,395,394,391,390,387,386,415,414,411,410,407,406,403,402,
    367,366,363,362,359,358,355,354,383,382,379,378,375,374,371,370,335,334,331,330,327,326,323,322,351,350,347,346,343,342,339,338,
    1021,1017,1013,1009,1005,1001,997,993,989,985,981,977,973,969,965,961,957,953,949,945,941,937,933,929,925,921,917,913,909,905,901,897,
    303,302,299,298,295,294,291,290,319,318,315,314,311,310,307,306,893,889,885,881,877,873,869,865,861,857,853,849,845,841,837,833,
    829,825,821,817,813,809,805,801,797,793,789,785,781,777,773,769,271,270,267,266,263,262,259,258,287,286,283,282,279,278,275,274,
    1020,1016,1012,1008,1004,1000,996,992,765,761,757,753,749,745,741,737,988,984,980,976,972,968,964,960,733,729,725,721,717,713,709,705,
    828,824,820,816,812,808,804,800,223,222,219,218,215,214,211,210,413,409,405,401,397,393,389,385,191,190,187,186,183,182,179,178,
    33,34,35,37,38,39,41,42,192,196,200,204,208,212,216,220,86,87,89,90,91,93,94,95,512,516,520,524,528,532,536,540,
    161,165,169,173,177,181,185,189,544,548,552,556,560,564,568,572,321,325,329,333,337,341,345,349,576,580,584,588,592,596,600,604,
    353,357,361,365,369,373,377,381,608,612,616,620,624,628,632,636,162,163,166,167,170,171,174,175,449,453,457,461,465,469,473,477,
    513,517,521,525,529,533,537,541,832,836,840,844,848,852,856,860,609,613,617,621,625,629,633,637,641,645,649,653,657,661,665,669,
    673,677,681,685,689,693,697,701,896,900,904,908,912,916,920,924,242,243,246,247,250,251,254,255,864,868,872,876,880,884,888,892,
    226,227,230,231,234,235,238,239,928,932,936,940,944,948,952,956,545,549,553,557,561,565,569,573,577,581,585,589,593,597,601,605,
    194,195,198,199,202,203,206,207,768,772,776,780,784,788,792,796,481,485,489,493,497,501,505,509,736,740,744,748,752,756,760,764,
    672,676,680,684,688,692,696,700,417,421,425,429,433,437,441,445,640,644,648,652,656,660,664,668,704,708,712,716,720,724,728,732,
    74,73,71,70,69,67,66,65,157,153,149,145,141,137,133,129,348,344,340,336,332,328,324,320,316,312,308,304,300,296,292,288,
    85,83,82,81,79,78,77,75,252,248,244,240,236,232,228,224,380,376,372,368,364,360,356,352,125,121,117,113,109,105,101,97,
    444,440,436,432,428,424,420,416,317,313,309,305,301,297,293,289,127,126,123,122,119,118,115,114,143,142,139,138,135,134,131,130,
    285,281,277,273,269,265,261,257,221,217,213,209,205,201,197,193,476,472,468,464,460,456,452,448,412,408,404,400,396,392,388,384,
    253,249,245,241,237,233,229,225,508,504,500,496,492,488,484,480,159,158,155,154,151,150,147,146,111,110,107,106,103,102,99,98,
    284,280,276,272,268,264,260,256,188,184,180,176,172,168,164,160,156,152,148,144,140,136,132,128,53,51,50,49,47,46,45,43,
    63,62,61,59,58,57,55,54,7,6,5,4,3,2,1,0,23,22,21,20,19,18,17,16,15,14,13,12,11,10,9,8,
    31,30,29,28,27,26,25,24,60,56,52,48,44,40,36,32,124,120,116,112,108,104,100,96,92,88,84,80,76,72,68,64,
};

__device__ const unsigned char c_diff_ub[128] = {
    31,30,29,28,27,26,25,24,23,22,21,20,19,18,17,16,15,14,13,12,11,10,9,8,7,6,5,4,3,2,1,0,
    0,1,2,3,4,5,6,7,8,9,10,11,12,13,14,15,16,17,18,19,20,21,22,23,24,25,26,27,28,29,30,31,
    13,12,11,10,9,8,7,6,5,4,3,2,1,0,14,15,16,17,18,19,20,21,22,23,24,25,26,27,28,29,30,31,
    0,1,3,4,6,7,9,10,12,13,15,18,21,24,2,5,8,11,14,16,17,19,20,22,23,25,26,27,28,29,30,31,
};

struct Args { const float* in[31]; float* out; unsigned char* ws; int ph_lo, ph_hi, l_lo, l_hi, c_lo, c_hi, use_bar, pad; };
enum Phase { P_PRO0 = 0, P_PRO1, P_CVT, P_WIN, P_CKVN, P_ATTN, P_DIFF, P_WO, P_LN1, P_WQ, P_MEMATT, P_WMO, P_LN2, P_RGEMM, P_ROUTE, P_GU, P_DN, P_COMB, P_NUM };

struct Frame {
    LAS unsigned char* lds;
    int wave, G, vcu;
};


constexpr int CVT_SCR_BYTES = 64 * 65 * 4;
__device__ __forceinline__ void transpose_item(const float* W, int ldw, int K, int nvalid, bf16* WT, LAS float* scr, int kb, int nb, int lane) {
    const int k0 = 64 * kb, n0 = 64 * nb, r4 = lane >> 4, c4 = lane & 15;
    const bool ok = (n0 + 4 * c4) < nvalid;
    f32x4 v[16];
    const float* src = W + (size_t)(k0 + r4) * ldw + n0 + 4 * c4;
#pragma unroll
    for (int i = 0; i < 16; ++i) v[i] = ok ? *(const f32x4*)(src + (size_t)(4 * i) * ldw) : (f32x4){0.f, 0.f, 0.f, 0.f};
#pragma unroll
    for (int i = 0; i < 16; ++i) { LAS float* d = scr + (4 * i + r4) * 65 + 4 * c4; d[0] = v[i][0]; d[1] = v[i][1]; d[2] = v[i][2]; d[3] = v[i][3]; }
    LDS_WAIT(); asm volatile("" ::: "memory");
    const int c = lane & 7;
#pragma unroll
    for (int j = 0; j < 8; ++j) { const int n = (lane >> 3) + 8 * j; const LAS float* sp = scr + (8 * c) * 65 + n;
        u32x4 o; o.x = cvt_pk_bf16(sp[0 * 65], sp[1 * 65]); o.y = cvt_pk_bf16(sp[2 * 65], sp[3 * 65]); o.z = cvt_pk_bf16(sp[4 * 65], sp[5 * 65]); o.w = cvt_pk_bf16(sp[6 * 65], sp[7 * 65]);
        *(u32x4*)(WT + (size_t)(n0 + n) * K + k0 + 8 * c) = o; }
    LDS_WAIT(); asm volatile("" ::: "memory");
}
__device__ __forceinline__ void cvt_job(const float* W, int ldw, int K, int ncols, int nvalid, bf16* WT, LAS float* scr, int item, int lane) {
    const int nblk = ncols / 64; transpose_item(W, ldw, K, nvalid, WT, scr, item / nblk, item % nblk, lane);
}

__device__ __forceinline__ void cvt_layer_item(const Args& a, int l, unsigned char* wb, LAS float* scr, int it, int lane) {
    const float* src; int ldw, K = D, ncols, nvalid; size_t dst;
    if (it < 640) { const int seg = it >> 7; const int srcc = (seg == 0) ? 0 : (seg == 1) ? 640 : (seg == 2) ? 1224 : (seg == 3) ? 1736 : 2248;
        src = a.in[4] + (size_t)l * D * WIN_COLS + srcc; ldw = WIN_COLS; ncols = 512; nvalid = 512; dst = WB_WIN + (size_t)(seg < 4 ? seg * 512 : 2304) * D * 2; it &= 127; }
    else if (it < 672) { src = a.in[4] + (size_t)l * D * WIN_COLS + 512; ldw = WIN_COLS; ncols = 128; nvalid = 128; dst = WB_WIN + (size_t)2048 * D * 2; it -= 640; }
    else if (it < 688) { src = a.in[4] + (size_t)l * D * WIN_COLS + 1152; ldw = WIN_COLS; ncols = 64; nvalid = 64; dst = WB_WIN + (size_t)2176 * D * 2; it -= 672; }
    else if (it < 704) { src = a.in[4] + (size_t)l * D * WIN_COLS + 1216; ldw = WIN_COLS; ncols = 64; nvalid = 8; dst = WB_WIN + (size_t)2240 * D * 2; it -= 688; }
    else if (it < 960) { src = a.in[13] + (size_t)l * D * D; ldw = D; ncols = D; nvalid = D; dst = WB_WO; it -= 704; }
    else if (it < 1216) { src = a.in[16] + (size_t)l * D * D; ldw = D; ncols = D; nvalid = D; dst = WB_WQ; it -= 960; }
    else if (it < 1472) { src = a.in[18] + (size_t)l * D * D; ldw = D; ncols = D; nvalid = D; dst = WB_WMO; it -= 1216; }
    else if (it < 1600) { it -= 1472; const int sub = it >> 5, up = sub & 1, t = sub >> 1;
        src = (up ? a.in[27] : a.in[26]) + (size_t)l * D * SH_DIM + 128 * t; ldw = SH_DIM; ncols = 128; nvalid = 128; dst = WB_SGU + (size_t)(256 * t + 128 * up) * D * 2; it &= 31; }
    else if (it < 1664) { src = a.in[28] + (size_t)l * SH_DIM * D; ldw = D; K = SH_DIM; ncols = D; nvalid = D; dst = WB_SD; it -= 1600; }
    else if (it < 1664 + 8192) { it -= 1664; const int e = it >> 7, sub = (it >> 5) & 3, up = sub & 1, t = sub >> 1;
        src = (up ? a.in[24] : a.in[23]) + ((size_t)l * N_EXP + e) * D * EXP_DIM + 128 * t; ldw = EXP_DIM; ncols = 128; nvalid = 128; dst = WB_GU + ((size_t)e * 512 + 256 * t + 128 * up) * D * 2; it &= 31; }
    else if (it < 1664 + 8192 + 4096) { it -= 1664 + 8192; const int e = it >> 6;
        src = a.in[25] + ((size_t)l * N_EXP + e) * EXP_DIM * D; ldw = D; K = EXP_DIM; ncols = D; nvalid = D; dst = WB_DN + (size_t)e * D * EXP_DIM * 2; it &= 63; }
    else if (it < 1664 + 8192 + 4096 + 16) { it -= 1664 + 8192 + 4096; const int hh = it >> 1;
        src = a.in[7] + ((size_t)l * A_HEADS + hh) * KV_LORA * 64; ldw = 64; K = KV_LORA; ncols = 64; nvalid = 64; dst = WB_UV + (size_t)hh * 64 * KV_LORA * 2; it &= 1; }
    else { it -= 1664 + 8192 + 4096 + 16;
        src = a.in[21] + (size_t)l * D * N_EXP; ldw = N_EXP; ncols = 256; nvalid = N_EXP; dst = WB_RW; }
    cvt_job(src, ldw, K, ncols, nvalid, (bf16*)(wb + dst), scr, it, lane);
}
constexpr int CVT_LAYER_ITEMS = 1664 + 8192 + 4096 + 16 + 64;

__device__ __forceinline__ void ln_row(const float* xrow, const float* g, const float* b, float* hrow, bf16* orow, int lane) {
    f32x4 v[4]; float s = 0.f;
#pragma unroll
    for (int j = 0; j < 4; ++j) { v[j] = *((const f32x4*)xrow + lane + 64 * j); s += (v[j][0] + v[j][1]) + (v[j][2] + v[j][3]); }
    const float mean = wsum(s, lane) * (1.f / D); float s2 = 0.f;
#pragma unroll
    for (int j = 0; j < 4; ++j) { v[j] = v[j] - mean; s2 += (v[j][0] * v[j][0] + v[j][1] * v[j][1]) + (v[j][2] * v[j][2] + v[j][3] * v[j][3]); }
    const float rstd = 1.f / sqrtf(wsum(s2, lane) * (1.f / D) + LN_EPS);
#pragma unroll
    for (int j = 0; j < 4; ++j) { const f32x4 gg = *((const f32x4*)g + lane + 64 * j), bb = *((const f32x4*)b + lane + 64 * j);
        const f32x4 o = v[j] * rstd * gg + bb; if (hrow) *((f32x4*)hrow + lane + 64 * j) = o;
        u32x2 w; w.x = pk2(o[0], o[1]); w.y = pk2(o[2], o[3]); *((u32x2*)orow + lane + 64 * j) = w; }
}


__device__ __forceinline__ void add_bf16x4(f32x4& v, const u32x2 y) { v[0] += __uint_as_float(y.x << 16); v[1] += __uint_as_float(y.x & 0xffff0000u); v[2] += __uint_as_float(y.y << 16); v[3] += __uint_as_float(y.y & 0xffff0000u); }
__device__ __forceinline__ void acc_bf16x8(float (&v)[8], const u32x4 y, float sc) {
    v[0] += sc * __uint_as_float(y.x << 16); v[1] += sc * __uint_as_float(y.x & 0xffff0000u); v[2] += sc * __uint_as_float(y.y << 16); v[3] += sc * __uint_as_float(y.y & 0xffff0000u);
    v[4] += sc * __uint_as_float(y.z << 16); v[5] += sc * __uint_as_float(y.z & 0xffff0000u); v[6] += sc * __uint_as_float(y.w << 16); v[7] += sc * __uint_as_float(y.w & 0xffff0000u);
}
template <int NR, bool HAS_Y, bool HAS_X, bool HAS_SLOTS>
__device__ __forceinline__ void ln_res_rows(const bf16* hrow, size_t hstride, const bf16* yrow, size_t ystride, const bf16* xrow, size_t xstride, const bf16* slots, size_t sstride,
                                            float alpha, const float* g, const float* b, bf16* orow, size_t ostride, float* fout, size_t fstride, int lane) {
    u32x4 hv[NR][2], yv[NR][2], xv[NR][2], sv[NR][HAS_SLOTS ? 8 : 1][2];
#pragma unroll
    for (int r = 0; r < NR; ++r)
#pragma unroll
        for (int c = 0; c < 2; ++c) { const int e = 8 * lane + 512 * c;
            hv[r][c] = *(const u32x4*)(hrow + r * hstride + e);
            if (HAS_Y) yv[r][c] = *(const u32x4*)(yrow + r * ystride + e);
            if (HAS_X) xv[r][c] = *(const u32x4*)(xrow + r * xstride + e);
            if (HAS_SLOTS) {
#pragma unroll
                for (int k = 0; k < 8; ++k) sv[r][k][c] = *(const u32x4*)(slots + r * sstride + (size_t)k * D + e); } }
    MEMFENCE();
    float v[NR][2][8], mean[NR], rstd[NR];
#pragma unroll
    for (int r = 0; r < NR; ++r) { float s = 0.f;
#pragma unroll
        for (int c = 0; c < 2; ++c) {
#pragma unroll
            for (int i = 0; i < 8; ++i) v[r][c][i] = 0.f;
            acc_bf16x8(v[r][c], hv[r][c], alpha);
            if (HAS_Y) acc_bf16x8(v[r][c], yv[r][c], 1.0f);
            if (HAS_X) acc_bf16x8(v[r][c], xv[r][c], 1.0f);
            if (HAS_SLOTS) {
#pragma unroll
                for (int k = 0; k < 8; ++k) acc_bf16x8(v[r][c], sv[r][k][c], 1.0f); }
#pragma unroll
            for (int i = 0; i < 8; ++i) s += v[r][c][i]; }
        mean[r] = s; }
#pragma unroll
    for (int r = 0; r < NR; ++r) mean[r] = wave_total(mean[r]);
#pragma unroll
    for (int r = 0; r < NR; ++r) { mean[r] *= (1.f / D); float q = 0.f;
#pragma unroll
        for (int c = 0; c < 2; ++c)
#pragma unroll
            for (int i = 0; i < 8; ++i) { v[r][c][i] -= mean[r]; q += v[r][c][i] * v[r][c][i]; }
        rstd[r] = q; }
#pragma unroll
    for (int r = 0; r < NR; ++r) rstd[r] = wave_total(rstd[r]);
#pragma unroll
    for (int c = 0; c < 2; ++c) { const int e = 8 * lane + 512 * c;
        const f32x4 g0 = *(const f32x4*)(g + e), g1 = *(const f32x4*)(g + e + 4), b0 = *(const f32x4*)(b + e), b1 = *(const f32x4*)(b + e + 4);
#pragma unroll
        for (int r = 0; r < NR; ++r) { const float rs = 1.f / sqrtf(rstd[r] * (1.f / D) + LN_EPS);
            f32x4 o0, o1;
#pragma unroll
            for (int i = 0; i < 4; ++i) { o0[i] = v[r][c][i] * rs * g0[i] + b0[i]; o1[i] = v[r][c][4 + i] * rs * g1[i] + b1[i]; }
            if (fout) { *(f32x4*)(fout + r * fstride + e) = o0; *(f32x4*)(fout + r * fstride + e + 4) = o1; }
            else { u32x4 w; w.x = cvt_pk_bf16(o0[0], o0[1]); w.y = cvt_pk_bf16(o0[2], o0[3]); w.z = cvt_pk_bf16(o1[0], o1[1]); w.w = cvt_pk_bf16(o1[2], o1[3]);
                *(u32x4*)(orow + r * ostride + e) = w; } } }
}

__global__ void __launch_bounds__(NTHR, 2) mk_fwd(Args a) {
    extern __shared__ __attribute__((aligned(16))) unsigned char lds_raw[];
    Frame F;
    F.lds = (LAS unsigned char*)lds_raw;
    F.wave = __builtin_amdgcn_readfirstlane(threadIdx.x >> 6);
    F.G = gridDim.x; { const int bx = blockIdx.x; F.vcu = (F.G % 8 == 0) ? (bx % 8) * (F.G / 8) + bx / 8 : bx; }
    volatile LAS unsigned* MISC = (volatile LAS unsigned*)(F.lds + LDS_MISC);
    if (threadIdx.x < 32) MISC[threadIdx.x] = 0u;
    __syncthreads();
    XcdBarrier bar; bar.bar = (unsigned*)(a.ws + WS_CTL) + CW_BAR; bar.x = 0; bar.st = MISC + 8;
    if (a.use_bar) bar = xcd_barrier_post((unsigned*)(a.ws + WS_CTL) + CW_BAR, MISC + 8);
#define GRID_BAR() do { if (a.use_bar) xcd_barrier(bar, F.wave); } while (0)
#define IN(k) (a.ph_lo <= (k) && (k) < a.ph_hi)
#define PHASE_BASES() GAS unsigned char* wsg_ = (GAS unsigned char*)a.ws; asm volatile("" : "+s"(wsg_)); unsigned char* ws = (unsigned char*)wsg_; GAS float* hg_ = (GAS float*)a.out; asm volatile("" : "+s"(hg_)); float* H = (float*)hg_; bf16* HB = (bf16*)(ws + WS_HB); (void)H; (void)HB
    const int gw = F.vcu * NWAVES + F.wave, NGW = F.G * NWAVES;
    LAS float* scr = (LAS float*)(F.lds + LDS_STAGE + F.wave * CVT_SCR_BYTES);

    if (IN(P_PRO0)) {
        PHASE_BASES();
        { const int lane = lane_id();
          f32x4 gg[4], bb[4];
#pragma unroll
          for (int j = 0; j < 4; ++j) { gg[j] = *((const f32x4*)a.in[2] + lane + 64 * j); bb[j] = *((const f32x4*)a.in[3] + lane + 64 * j); }
          for (int m = gw; m < NTOK; m += 2 * NGW) {
              f32x4 v[2][4]; float s[2];
#pragma unroll
              for (int u = 0; u < 2; ++u) { const int row = m + u * NGW < NTOK ? m + u * NGW : m; s[u] = 0.f;
#pragma unroll
                  for (int j = 0; j < 4; ++j) { v[u][j] = *((const f32x4*)(a.in[0] + (size_t)row * D) + lane + 64 * j); s[u] += (v[u][j][0] + v[u][j][1]) + (v[u][j][2] + v[u][j][3]); } }
#pragma unroll
              for (int u = 0; u < 2; ++u) { const float mean = wave_total(s[u]) * (1.f / D); float s2 = 0.f;
#pragma unroll
                  for (int j = 0; j < 4; ++j) { v[u][j] = v[u][j] - mean; s2 += (v[u][j][0] * v[u][j][0] + v[u][j][1] * v[u][j][1]) + (v[u][j][2] * v[u][j][2] + v[u][j][3] * v[u][j][3]); }
                  s[u] = s2; }
#pragma unroll
              for (int u = 0; u < 2; ++u) { const int row = m + u * NGW; const float rstd = 1.f / sqrtf(wave_total(s[u]) * (1.f / D) + LN_EPS);
                  if (row < NTOK) {
#pragma unroll
                      for (int j = 0; j < 4; ++j) { const f32x4 o = v[u][j] * rstd * gg[j] + bb[j]; u32x2 w; w.x = pk2(o[0], o[1]); w.y = pk2(o[2], o[3]); *((u32x2*)(HB + (size_t)row * D) + lane + 64 * j) = w; } } }
          } }
        { bf16* MEMB = (bf16*)(ws + WS_MEMB); const float* mem = a.in[1];
          for (size_t i = ((size_t)blockIdx.x * NTHR + F.wave * 64 + lane_id()) * 4; i < (size_t)BATCH * MEM_TOK * D; i += (size_t)F.G * NTHR * 4) { const f32x4 v = *(const f32x4*)(mem + i); u32x2 w; w.x = pk2(v[0], v[1]); w.y = pk2(v[2], v[3]); *(u32x2*)(MEMB + i) = w; } }
        for (int it = gw; it < 1024; it += NGW) { const int l = it >> 9, v = (it >> 8) & 1, r = it & 255;
            cvt_job(a.in[17] + (size_t)l * D * 2048 + 1024 * v, 2048, D, D, D, (bf16*)(ws + (v ? WS_WVT : WS_WKT) + (size_t)l * 4 * MiB), scr, r, lane_id()); }
        GRID_BAR();
    }
#pragma unroll
    for (int l = 0; l < DEPTH; ++l) { if (l < a.l_lo || l >= a.l_hi) continue;
        if (IN(P_CVT)) {
            PHASE_BASES(); unsigned char* wb = ws + WS_WB;
            for (int it = gw; it < CVT_LAYER_ITEMS; it += NGW) cvt_layer_item(a, l, wb, scr, it, lane_id());
            { const float* wuk = a.in[6] + (size_t)l * A_HEADS * KV_LORA * 64; bf16* o = (bf16*)(wb + WB_UK);
              for (int i = (gw * 64 + lane_id()) * 4; i < A_HEADS * KV_LORA * 64; i += NGW * 64 * 4) { const f32x4 v = *(const f32x4*)(wuk + i); u32x2 w; w.x = pk2(v[0], v[1]); w.y = pk2(v[2], v[3]); *(u32x2*)(o + i) = w; } }
            GRID_BAR();
        }
        if (IN(P_WIN)) {
            PHASE_BASES(); unsigned char* wb = ws + WS_WB;
            pg8::Gemm g{HB, (const bf16*)(wb + WB_WIN), D, 0, 0}; pg8::DenseOrder S; S.init(NTOK, WIN_PAD, 1, F.G, (int)blockIdx.x);
            pg8::EpiProjMk E{(bf16*)(ws + WS_PROJ5), (bf16*)(ws + WS_MISC10), (float*)(ws + WS_WIDX), (bf16*)(ws + WS_SEL)};
            pg8::gemm_phase<pg8::EpiProjMk, pg8::DenseOrder, false>(F.lds + LDS_STAGE, g, S, E, nullptr, F.wave);
            { pg8::Gemm g2{(const bf16*)(wb + WB_WIN) + (size_t)2304 * D, HB, D, 0, 0}; pg8::DenseOrder S2; S2.init(512, NTOK, 1, F.G, (int)((blockIdx.x + 128) % F.G));
              pg8::EpiVT E2{(bf16*)(ws + WS_VTD), VTD_LD, 0};
              pg8::gemm_phase<pg8::EpiVT, pg8::DenseOrder, false>(F.lds + LDS_STAGE, g2, S2, E2, nullptr, F.wave); }
            if (l == 0) {
                { pg8::Gemm g3{(const bf16*)(ws + WS_MEMB), (const bf16*)(ws + WS_WKT), D, 0, (size_t)2 * MiB}; pg8::DenseOrder S3; S3.init(2048, 1024, DEPTH, F.G, (int)((blockIdx.x + F.G / 2) % F.G));
                  pg8::EpiBf16 E3{(bf16*)(ws + WS_KM), KM_LD, (size_t)2048 * KM_LD, 0, 0};
                  pg8::gemm_phase<pg8::EpiBf16, pg8::DenseOrder, false>(F.lds + LDS_STAGE, g3, S3, E3, nullptr, F.wave); }
                { pg8::Gemm g4{(const bf16*)(ws + WS_WVT), (const bf16*)(ws + WS_MEMB), D, (size_t)2 * MiB, 0}; pg8::DenseOrder S4; S4.init(1024, 2048, DEPTH, F.G, (int)((blockIdx.x + F.G / 4) % F.G));
                  pg8::EpiVT E4{(bf16*)(ws + WS_VTM), VTM_LD, (size_t)1024 * VTM_LD};
                  pg8::gemm_phase<pg8::EpiVT, pg8::DenseOrder, false>(F.lds + LDS_STAGE, g4, S4, E4, nullptr, F.wave); }
            }
            asm volatile("s_waitcnt vmcnt(0)" ::: "memory");
            __syncthreads();
            { const int lane = lane_id();
              const bf16* MISCp = (const bf16*)(ws + WS_MISC10); bf16* CKVp = (bf16*)(ws + WS_CKV); const float* gn = a.in[5] + l * KV_LORA;
              const float g0 = gn[lane], g1 = gn[64 + lane];
#pragma unroll 1
              for (int i = 0; ; ++i) { pg8::Unit u; if (!S.next(i, u)) break;
                  if (u.pn != 8) continue;
#pragma unroll 1
                  for (int row0 = u.r0 + F.wave; row0 < u.r0 + 256; row0 += 4 * NWAVES) {
                      float x0[4], x1[4];
#pragma unroll
                      for (int q = 0; q < 4; ++q) { const int row = row0 + q * NWAVES; x0[q] = bf2f(MISCp[(size_t)row * 256 + lane]); x1[q] = bf2f(MISCp[(size_t)row * 256 + 64 + lane]); }
#pragma unroll
                      for (int q = 0; q < 4; ++q) { const int row = row0 + q * NWAVES;
                          const float r = 1.0f / sqrtf(wsum(x0[q] * x0[q] + x1[q] * x1[q], lane) * (1.f / KV_LORA) + RMS_EPS);
                          CKVp[(size_t)row * 128 + lane] = f2bf(x0[q] * r * g0); CKVp[(size_t)row * 128 + 64 + lane] = f2bf(x1[q] * r * g1); } } } }
            GRID_BAR();
        }
#pragma unroll 1
        for (int apass = 0; apass < 2; ++apass) { const int awhich = apass ^ (((int)blockIdx.x >> 3) & 1);
        if (awhich == 0 && IN(P_ATTN)) {
            PHASE_BASES(); unsigned char* wb = ws + WS_WB;
            const int w = F.wave;
            LAS float* SC = (LAS float*)(F.lds + TK_SC); LAS bf16* QL = (LAS bf16*)(F.lds + TK_QL); LAS unsigned short* SEL = (LAS unsigned short*)(F.lds + TK_SEL);
            LAS unsigned* HIST = (LAS unsigned*)(F.lds + TK_HIST); LAS unsigned* MM = (LAS unsigned*)(F.lds + TK_MM);
            const size_t PS = (size_t)NTOK * 512;
            const bf16* QA = (const bf16*)(ws + WS_PROJ5); const bf16* QIDX = QA + PS; const float* WIDXp = (const float*)(ws + WS_WIDX);
            const bf16* WUK = (const bf16*)(wb + WB_UK); const bf16* WUVT = (const bf16*)(wb + WB_UV);
            bf16* CATp = (bf16*)(ws + WS_CAT);
            const brsrc_t rM = make_rsrc(ws + WS_SEL, (unsigned)((size_t)NTOK * 128)), rC = make_rsrc(ws + WS_CKV, (unsigned)((size_t)NTOK * 256));
            const int NIT = (4096 + F.G - 1) / F.G;
            bf16* QLAT = (bf16*)(ws + WS_Y);
#define ATTN_UNIT_IDX(it_) ((it_) * F.G + (((it_) & 1) ? (F.G - 1 - (int)blockIdx.x) : (int)blockIdx.x))
            { const int lane = lane_id(), hd = lane & 15, g = lane >> 4;
              bf16x8 wkn[16];
#pragma unroll
              for (int nt = 0; nt < 8; ++nt) { const bf16* wr = WUK + (size_t)(w * 128 + 16 * nt + hd) * 64 + 8 * g; wkn[2 * nt] = *(const bf16x8*)wr; wkn[2 * nt + 1] = *(const bf16x8*)(wr + 32); }
#pragma unroll 1
              for (int ib = 0; ib < NIT; ib += 8) {
                  bf16x8 qa[8][2];
#pragma unroll
                  for (int u = 0; u < 8; ++u) { const int idxu = (ib + u) < NIT ? ATTN_UNIT_IDX(ib + u) : 4096; const int idc = idxu < 4096 ? idxu : 0;
                      const bf16* qrow = QA + (size_t)((idc & 7) * SEQ + 8 * (511 - (idc >> 3)) + (hd & 7)) * 512 + w * 64 + 8 * g; qa[u][0] = *(const bf16x8*)qrow; qa[u][1] = *(const bf16x8*)(qrow + 32); }
#pragma unroll
                  for (int u = 0; u < 8; ++u) { const int idxu = (ib + u) < NIT ? ATTN_UNIT_IDX(ib + u) : 4096;
                      if (idxu < 4096) { bf16* qo = QLAT + (size_t)((idxu & 7) * SEQ + 8 * (511 - (idxu >> 3)) + (hd & 7)) * D + w * 128 + 4 * g;
#pragma unroll
                          for (int nt = 0; nt < 8; ++nt) { f32x4 acc = mfma16(wkn[2 * nt], qa[u][0], (f32x4){0.f, 0.f, 0.f, 0.f}); acc = mfma16(wkn[2 * nt + 1], qa[u][1], acc);
                              if (hd < 8) { u32x2 pk; pk.x = pk2(acc[0], acc[1]); pk.y = pk2(acc[2], acc[3]); *(u32x2*)(qo + 16 * nt) = pk; } } } } }
              const int tidp = w * 64 + lane; if (tidp < 8) MM[tidp] = 0u; else if (tidp < 16) MM[tidp] = 0xFFFFFFFFu; }
            __syncthreads();
#pragma unroll 1
            for (int it = 0; it < NIT; ++it) {
                LAS unsigned* MMt = MM + 16 * (it & 1);
                const int idx = ATTN_UNIT_IDX(it);
                const bool do4 = idx < 4096;
                const int qt = 511 - (idx >> 3), bb = idx & 7, tq0 = 8 * qt, tok0 = bb * SEQ + tq0, n = ((tq0 >> 6) + 1) * 64;
                if (do4) {
#ifndef REP_S1
#define REP_S1 1
#endif
#pragma unroll 1
                for (int rep1 = 0; rep1 < REP_S1; ++rep1)
                if (n > TOPK) {
                    const int lane = lane_id();
                    const int r = lane & 31, hi = lane >> 5, qq = 2 * ((r >> 2) & 1) + (r >> 4), hh = 4 * ((r >> 3) & 1) + (r & 3);
                    bf16x8 af[2][4]; float wq[2][16];
#pragma unroll
                    for (int rt = 0; rt < 2; ++rt) { const bf16* ar = QIDX + (size_t)(tok0 + 4 * rt + qq) * 512 + hh * 64 + 8 * hi;
#pragma unroll
                        for (int s4 = 0; s4 < 4; ++s4) af[rt][s4] = *(const bf16x8*)(ar + 16 * s4);
#pragma unroll
                        for (int i = 0; i < 16; ++i) wq[rt][i] = WIDXp[(size_t)(tok0 + 4 * rt + 2 * hi + (i >> 3)) * 8 + 4 * ((i >> 2) & 1) + (i & 3)] * 0.125f; }
                    float vmax[2][2], vmin[2][2];
#pragma unroll
                    for (int rt = 0; rt < 2; ++rt)
#pragma unroll
                        for (int u = 0; u < 2; ++u) { vmax[rt][u] = -3.0e38f; vmin[rt][u] = 3.0e38f; }
                    const unsigned kvo = (unsigned)(lane * 16);
                    const int ntile = n >> 5;
                    bf16x8 bqA[4], bqB[4];
#define IDX_LOAD(BQ, kt_) do { const int nk_ = (kt_) < ntile ? (kt_) : w; const unsigned so_ = (unsigned)(bb * 128 + nk_) * 4096u; \
                        _Pragma("unroll") for (int s4 = 0; s4 < 4; ++s4) BQ[s4] = bld16(rM, kvo + 1024 * s4, so_); } while (0)
#define IDX_TILE(BQ, kt_) do { \
                        f32x16v acc0, acc1; \
                        _Pragma("unroll") for (int i = 0; i < 16; ++i) { acc0[i] = 0.f; acc1[i] = 0.f; } \
                        _Pragma("unroll") for (int s4 = 0; s4 < 4; ++s4) { acc0 = __builtin_amdgcn_mfma_f32_32x32x16_bf16(af[0][s4], BQ[s4], acc0, 0, 0, 0); acc1 = __builtin_amdgcn_mfma_f32_32x32x16_bf16(af[1][s4], BQ[s4], acc1, 0, 0, 0); } \
                        asm volatile("" : "+v"(acc0), "+v"(acc1) :: "memory");     \
                        IDX_LOAD(BQ, (kt_) + 2 * NWAVES); \
                        MEMFENCE(); \
                        float sc4[2][2] = {{0.f, 0.f}, {0.f, 0.f}}; \
                        _Pragma("unroll") for (int i = 0; i < 16; ++i) { sc4[0][i >> 3] = __builtin_fmaf(wq[0][i], relu_f(acc0[i]), sc4[0][i >> 3]); sc4[1][i >> 3] = __builtin_fmaf(wq[1][i], relu_f(acc1[i]), sc4[1][i >> 3]); } \
                        _Pragma("unroll") for (int rt = 0; rt < 2; ++rt) _Pragma("unroll") for (int u = 0; u < 2; ++u) { const float v = sc4[rt][u]; SC[(4 * rt + 2 * hi + u) * 4096 + 32 * (kt_) + r] = v; vmax[rt][u] = fmaxf(vmax[rt][u], v); vmin[rt][u] = fminf(vmin[rt][u], v); } \
                    } while (0)
                    IDX_LOAD(bqA, w); IDX_LOAD(bqB, w + NWAVES);
                    MEMFENCE();
                    int kt = w;
#pragma unroll 1
                    for (; kt + NWAVES < ntile; kt += 2 * NWAVES) { IDX_TILE(bqA, kt); IDX_TILE(bqB, kt + NWAVES); }
                    if (kt < ntile) IDX_TILE(bqA, kt);
#undef IDX_TILE
#undef IDX_LOAD
#pragma unroll
                    for (int rt = 0; rt < 2; ++rt)
#pragma unroll
                        for (int u = 0; u < 2; ++u) { float a = vmax[rt][u], c = vmin[rt][u];
#define DPX(x, ctrl) __int_as_float(__builtin_amdgcn_update_dpp(__float_as_int(x), __float_as_int(x), ctrl, 0xf, 0xf, false))
                            a = fmaxf(a, DPX(a, 0xB1)); c = fminf(c, DPX(c, 0xB1)); a = fmaxf(a, DPX(a, 0x4E)); c = fminf(c, DPX(c, 0x4E));
                            a = fmaxf(a, DPX(a, 0x141)); c = fminf(c, DPX(c, 0x141)); a = fmaxf(a, DPX(a, 0x140)); c = fminf(c, DPX(c, 0x140));
#undef DPX
                            if ((r & 15) == 0) { atomicMax((unsigned*)(MMt + 4 * rt + 2 * hi + u), f2ord(a)); atomicMin((unsigned*)(MMt + 8 + 4 * rt + 2 * hi + u), f2ord(c)); } }
                }
                __syncthreads();
                { const int lane = lane_id();
                if (n <= TOPK) { for (int i = lane; i < TOPK; i += 64) SEL[w * 256 + i] = i < n ? (unsigned short)i : (unsigned short)0xFFFFu; }
                else { topk_select(SC + w * 4096, SEL + w * 256, HIST + w * 256, (LAS float*)(F.lds + TK_CAND + w * 256), (LAS unsigned*)(F.lds + TK_CAND + w * 256 + 128), ord2f(MMt[w]), ord2f(MMt[8 + w]), n, lane);
#if REP_S2X > 1
                    topk_select(SC + w * 4096, SEL + w * 256, HIST + w * 256, (LAS float*)(F.lds + TK_CAND + w * 256), (LAS unsigned*)(F.lds + TK_CAND + w * 256 + 128), ord2f(MMt[w]), ord2f(MMt[8 + w]), n, lane);
                    topk_select(SC + w * 4096, SEL + w * 256, HIST + w * 256, (LAS float*)(F.lds + TK_CAND + w * 256), (LAS unsigned*)(F.lds + TK_CAND + w * 256 + 128), ord2f(MMt[w]), ord2f(MMt[8 + w]), n, lane);
#endif
                }
                }
                dsa_attn_query(rC, SEL + w * 256, F.lds + TK_SC + w * 16384, QLAT + (size_t)(tok0 + w) * D, bb, tq0 + w);
#if REP_S3 > 1
                dsa_attn_query(rC, SEL + w * 256, F.lds + TK_SC + w * 16384, QLAT + (size_t)(tok0 + w) * D, bb, tq0 + w);
#endif
                }
                { const int tidp = w * 64 + lane_id(); LAS unsigned* MMn = MM + 16 * ((it + 1) & 1); if (tidp < 8) MMn[tidp] = 0u; else if (tidp < 16) MMn[tidp] = 0xFFFFFFFFu; }
                __syncthreads();
            }
            { const int lane = lane_id(), hd = lane & 15, g = lane >> 4;
              const brsrc_t rQ = make_rsrc(ws + WS_Y, (unsigned)((size_t)NTOK * D * 2));
              bf16x8 wv[4][4];
#pragma unroll
              for (int nt = 0; nt < 4; ++nt) { const bf16* wr = WUVT + (size_t)(w * 64 + 16 * nt + hd) * 128 + 8 * g;
#pragma unroll
                  for (int s4 = 0; s4 < 4; ++s4) wv[nt][s4] = *(const bf16x8*)(wr + 32 * s4); }
#pragma unroll 1
              for (int ib = 0; ib < NIT; ib += 4) {
                  bf16x8 ol[4][4];
#pragma unroll
                  for (int u = 0; u < 4; ++u) { const int idxu = (ib + u) < NIT ? ATTN_UNIT_IDX(ib + u) : 4096; const int idc = idxu < 4096 ? idxu : 0;
                      const unsigned oo = (unsigned)(((idc & 7) * SEQ + 8 * (511 - (idc >> 3)) + (hd & 7)) * D + w * 128 + 8 * g) * 2u;
#pragma unroll
                      for (int s4 = 0; s4 < 4; ++s4) ol[u][s4] = __builtin_bit_cast(bf16x8, __builtin_amdgcn_raw_buffer_load_b128(rQ, (int)(oo + 64u * s4), 0, 17)); }
#pragma unroll
                  for (int u = 0; u < 4; ++u) { const int idxu = (ib + u) < NIT ? ATTN_UNIT_IDX(ib + u) : 4096;
                      if (idxu < 4096) { bf16* co = CATp + (size_t)((idxu & 7) * SEQ + 8 * (511 - (idxu >> 3)) + (hd & 7)) * D + w * 64 + 4 * g;
#pragma unroll
                          for (int nt = 0; nt < 4; ++nt) { f32x4 acc = (f32x4){0.f, 0.f, 0.f, 0.f};
#pragma unroll
                              for (int s4 = 0; s4 < 4; ++s4) acc = mfma16(wv[nt][s4], ol[u][s4], acc);
                              if (hd < 8) { u32x2 pk; pk.x = pk2(acc[0], acc[1]); pk.y = pk2(acc[2], acc[3]); *(u32x2*)(co + 16 * nt) = pk; } } } } } }
#undef ATTN_UNIT_IDX
            __syncthreads();
        }
        if (awhich == 1 && IN(P_DIFF)) {
            PHASE_BASES();
            const int lane = lane_id();
            const float lambda_init = 0.8f - 0.6f * __expf(-0.3f * (float)l);
            const float d1 = wsum(a.in[8][l * 64 + lane] * a.in[9][l * 64 + lane], lane), d2 = wsum(a.in[10][l * 64 + lane] * a.in[11][l * 64 + lane], lane);
            const float lam = __expf(d1) - __expf(d2) + lambda_init;
            const size_t PS = (size_t)NTOK * 512;
            const bf16* PROJ5 = (const bf16*)(ws + WS_PROJ5);
            const brsrc_t rK = make_rsrc(PROJ5 + 3 * PS, (unsigned)(PS * 2)), rV = make_rsrc(ws + WS_VTD, (unsigned)(512u * VTD_LD * 2u));
#pragma unroll 1
            for (int i = 0; i < (1024 + F.G - 1) / F.G; ++i) {
                const int idx = i * F.G + ((i & 1) ? (F.G - 1 - (int)blockIdx.x) : (int)blockIdx.x);
                if (idx < 1024) { const int uid = c_diff_tab[idx]; int ub = uid >> 5, bb = (uid & 31) >> 2, hh = uid & 3;
                    if (F.G == 256) { bb = (int)blockIdx.x & 7; hh = 3 - i; ub = c_diff_ub[i * 32 + ((int)blockIdx.x >> 3)]; }
#if DIFF_V2
                    diff_attn_unit(F.lds + LDS_STAGE, PROJ5 + 2 * PS, PROJ5 + 3 * PS, (const bf16*)(ws + WS_VTD), (bf16*)(ws + WS_CAT), bb, hh, ub, F.wave, lam, lambda_init, a.in[12] + l * 128);
#else
                    diff_attn_wave(PROJ5 + 2 * PS, rK, rV, (bf16*)(ws + WS_CAT), bb, hh, 128 * ub + 16 * F.wave, lam, lambda_init, a.in[12] + l * 128, lane);
#endif
                }
            }
            __syncthreads();
        }
        }
        if (IN(P_ATTN) || IN(P_DIFF)) GRID_BAR();
        if (IN(P_WO)) {
            PHASE_BASES(); unsigned char* wb = ws + WS_WB;
            pg8::Gemm g{(const bf16*)(ws + WS_CAT), (const bf16*)(wb + WB_WO), D, 0, 0}; pg8::DenseOrder S; S.init(NTOK, D, 1, F.G, (int)blockIdx.x);
            pg8::EpiBf16 E{(bf16*)(ws + WS_Y), D, 0, 0, 0};
            pg8::gemm_phase<pg8::EpiBf16, pg8::DenseOrder, false>(F.lds + LDS_STAGE, g, S, E, nullptr, F.wave);
            GRID_BAR();
        }
        if (IN(P_LN1)) {
            PHASE_BASES();
            const int lane = lane_id(); const bf16* Y = (const bf16*)(ws + WS_Y);
            for (int row = gw; row < NTOK; row += 2 * NGW) ln_res_rows<2, true, false, false>(HB + (size_t)row * D, (size_t)NGW * D, Y + (size_t)row * D, (size_t)NGW * D, nullptr, 0, nullptr, 0, ALPHA, a.in[14] + l * D, a.in[15] + l * D, HB + (size_t)row * D, (size_t)NGW * D, nullptr, 0, lane);
            GRID_BAR();
        }
        if (IN(P_WQ)) {
            PHASE_BASES(); unsigned char* wb = ws + WS_WB;
            pg8::Gemm g{HB, (const bf16*)(wb + WB_WQ), D, 0, 0}; pg8::DenseOrder S; S.init(NTOK, D, 1, F.G, (int)blockIdx.x);
            pg8::EpiBf16 E{(bf16*)(ws + WS_QM), D, 0, 0, 0};
            pg8::gemm_phase<pg8::EpiBf16, pg8::DenseOrder, false>(F.lds + LDS_STAGE, g, S, E, nullptr, F.wave);
            asm volatile("s_waitcnt vmcnt(0)" ::: "memory");
            __syncthreads();
#pragma unroll 1
            for (int i = 0; ; ++i) { pg8::Unit u; if (!S.next(i, u)) break;
#pragma unroll 1
                for (int hb = 0; hb < 2; ++hb)
                    mem_attn_unit(F.lds + LDS_STAGE, (const bf16*)(ws + WS_QM), (const bf16*)(ws + WS_KM) + (size_t)l * 2048 * KM_LD, (const bf16*)(ws + WS_VTM) + (size_t)l * 1024 * VTM_LD, (bf16*)(ws + WS_OM), (u.r0 >> 7) + hb, u.pn, F.wave); }
            GRID_BAR();
        }
        if (IN(P_WMO)) {
            PHASE_BASES(); unsigned char* wb = ws + WS_WB;
            pg8::Gemm g{(const bf16*)(ws + WS_OM), (const bf16*)(wb + WB_WMO), D, 0, 0}; pg8::DenseOrder S; S.init(NTOK, D, 1, F.G, (int)blockIdx.x);
            pg8::EpiBf16 E{(bf16*)(ws + WS_Y), D, 0, 0, 0};
            pg8::gemm_phase<pg8::EpiBf16, pg8::DenseOrder, false>(F.lds + LDS_STAGE, g, S, E, nullptr, F.wave);
            GRID_BAR();
        }
        if (IN(P_LN2)) {
            PHASE_BASES();
            const int lane = lane_id(); const bf16* Y = (const bf16*)(ws + WS_Y);
            for (int row = gw; row < NTOK; row += 2 * NGW) ln_res_rows<2, true, false, false>(HB + (size_t)row * D, (size_t)NGW * D, Y + (size_t)row * D, (size_t)NGW * D, nullptr, 0, nullptr, 0, ALPHA, a.in[19] + l * D, a.in[20] + l * D, HB + (size_t)row * D, (size_t)NGW * D, nullptr, 0, lane);
            GRID_BAR();
        }
        if (IN(P_RGEMM) && NTOK / F.G != 128) {
            PHASE_BASES(); unsigned char* wb = ws + WS_WB;
            pg8::Gemm g{HB, (const bf16*)(wb + WB_RW), D, 0, 0}; pg8::DenseOrder S; S.init(NTOK, 256, 1, F.G, (int)blockIdx.x);
            pg8::EpiLogit E{(float*)(ws + WS_LOGIT)};
            pg8::gemm_phase<pg8::EpiLogit, pg8::DenseOrder, false>(F.lds + LDS_STAGE, g, S, E, nullptr, F.wave);
            GRID_BAR();
        }
        if (IN(P_ROUTE)) {
            PHASE_BASES(); unsigned char* wb = ws + WS_WB;
            const int lane = lane_id(), w = F.wave, tidp = w * 64 + lane;
            const float* LOGIT = (const float*)(ws + WS_LOGIT); float* GATEw = (float*)(ws + WS_ROUTE + 1 * MiB); int* LISTE = (int*)(ws + WS_LISTE);
            LAS int* lcnt = (LAS int*)(F.lds + LDS_TAB);
            LAS int* lsel = lcnt + 64;
            const int T = NTOK / F.G, t0 = (int)blockIdx.x * T, chunk = t0 / MOE_TOK;
            int* gcnt = (int*)(ws + WS_CTL) + CW_MOE + (l * MOE_CHUNKS + chunk) * 256;
            LAS float* LG = (LAS float*)(F.lds + LDS_STAGE);
            const bool fusedlg = (T == 128);
            if (fusedlg) {
                LAS unsigned char* wl = F.lds + LDS_STAGE;
                { const bf16* RW = (const bf16*)(wb + WB_RW); u32x4 st[16];
#pragma unroll
                  for (int i = 0; i < 16; ++i) { const int p = tidp + 512 * i; st[i] = *(const u32x4*)(RW + (size_t)(p >> 7) * D + (p & 127) * 8); }
#pragma unroll
                  for (int i = 0; i < 16; ++i) { const int p = tidp + 512 * i, e = p >> 7, c = p & 127; *(LAS u32x4*)(wl + e * 2048 + ((c ^ (e & 15)) * 16)) = st[i]; } }
                const int n = lane & 15, kq = lane >> 4;
                const bf16* arow = HB + (size_t)(t0 + 16 * w + n) * D + 8 * kq;
                f32x4 acc[4];
#pragma unroll
                for (int nt = 0; nt < 4; ++nt) acc[nt] = (f32x4){0.f, 0.f, 0.f, 0.f};
                __syncthreads();
#pragma unroll 1
                for (int kb = 0; kb < 4; ++kb) { bf16x8 af[8];
#pragma unroll
                    for (int j = 0; j < 8; ++j) af[j] = *(const bf16x8*)(arow + 32 * (8 * kb + j));
#pragma unroll
                    for (int j = 0; j < 8; ++j) { const int c = 4 * (8 * kb + j) + kq;
#pragma unroll
                        for (int nt = 0; nt < 4; ++nt) acc[nt] = mfma16(af[j], *(const LAS bf16x8*)(wl + (16 * nt + n) * 2048 + ((c ^ n) * 16)), acc[nt]); } }
                __syncthreads();
#pragma unroll
                for (int nt = 0; nt < 4; ++nt)
#pragma unroll
                    for (int i = 0; i < 4; ++i) LG[(16 * w + 4 * kq + i) * 64 + 16 * nt + n] = acc[nt][i];
            }
            if (tidp < 64) lcnt[tidp] = 0;
            __syncthreads();
            const float bias = a.in[22][l * N_EXP + lane];
            for (int tt0 = w; tt0 < T; tt0 += 8 * NWAVES) {
                float sc[8], key[8], ssum[8], mys[8]; int mye[8];
#pragma unroll
                for (int u = 0; u < 8; ++u) { const int tt = tt0 + u * NWAVES, t = t0 + (tt < T ? tt : tt0);
                    const float lg = fusedlg ? LG[(tt < T ? tt : tt0) * 64 + lane] : LOGIT[(size_t)t * N_EXP + lane];
                    sc[u] = 1.0f / (1.0f + __expf(-lg)); key[u] = sc[u] + bias; ssum[u] = 0.f; mys[u] = 0.f; mye[u] = 0; }
#pragma unroll 1
                for (int j = 0; j < TOP_E; ++j) {
                    float best[8]; int bi[8];
#pragma unroll
                    for (int u = 0; u < 8; ++u) { best[u] = key[u]; bi[u] = lane; }
#define ROUTE_STEP(GETF, GETI) do { float ob[8]; int oi[8]; \
                        _Pragma("unroll") for (int u = 0; u < 8; ++u) { ob[u] = GETF(best[u]); oi[u] = GETI(bi[u]); } \
                        _Pragma("unroll") for (int u = 0; u < 8; ++u) if (ob[u] > best[u] || (ob[u] == best[u] && oi[u] < bi[u])) { best[u] = ob[u]; bi[u] = oi[u]; } } while (0)
#define DPPF(ctrl) [&](float x) { return __int_as_float(__builtin_amdgcn_update_dpp(__float_as_int(x), __float_as_int(x), ctrl, 0xf, 0xf, false)); }
#define DPPI(ctrl) [&](int x) { return __builtin_amdgcn_update_dpp(x, x, ctrl, 0xf, 0xf, false); }
                    ROUTE_STEP(DPPF(0xB1), DPPI(0xB1));
                    ROUTE_STEP(DPPF(0x4E), DPPI(0x4E));
                    ROUTE_STEP(DPPF(0x141), DPPI(0x141));
                    ROUTE_STEP(DPPF(0x140), DPPI(0x140));
#pragma unroll
                    for (int o = 16; o < 64; o <<= 1) {
                        float ob[8]; int oi[8];
#pragma unroll
                        for (int u = 0; u < 8; ++u) { ob[u] = shx(best[u], lane, o); oi[u] = __builtin_amdgcn_ds_bpermute((lane ^ o) << 2, bi[u]); }
#pragma unroll
                        for (int u = 0; u < 8; ++u) if (ob[u] > best[u] || (ob[u] == best[u] && oi[u] < bi[u])) { best[u] = ob[u]; bi[u] = oi[u]; }
                    }
#undef ROUTE_STEP
#undef DPPF
#undef DPPI
#pragma unroll
                    for (int u = 0; u < 8; ++u) { const float ssel = __int_as_float(__builtin_amdgcn_ds_bpermute(bi[u] << 2, __float_as_int(sc[u])));
                        ssum[u] += ssel; if (lane == j) { mye[u] = bi[u]; mys[u] = ssel; } if (lane == bi[u]) key[u] = -INFINITY; }
                }
#pragma unroll
                for (int u = 0; u < 8; ++u) { const int tt = tt0 + u * NWAVES, t = t0 + tt;
                    if (tt < T && lane < TOP_E) { GATEw[(size_t)t * 8 + lane] = mys[u] / ssum[u] * 2.5f; const int lp = atomicAdd((int*)(lcnt + mye[u]), 1); lsel[tt * 8 + lane] = (mye[u] << 16) | lp; } }
            }
            __syncthreads();
            if (tidp < 64) { const int nloc = lcnt[tidp]; lcnt[tidp] = nloc ? atomicAdd(gcnt + tidp, nloc) : 0; }
            __syncthreads();
            for (int i = tidp; i < T * 8; i += NTHR) { const int v = lsel[i], e = v >> 16, lp = v & 0xffff; const int aid = ((t0 - chunk * MOE_TOK) + (i >> 3)) * 8 + (i & 7);
                LISTE[((size_t)chunk * N_EXP + e) * LIST_CAP + lcnt[e] + lp] = aid; }
            GRID_BAR();
        }
#pragma unroll 1
        for (int c = a.c_lo; c < a.c_hi; ++c) {
            const int tok0 = c * MOE_TOK;
#define MOE_BASES() PHASE_BASES(); unsigned char* wb = ws + WS_WB; const int* rec = (const int*)(ws + WS_CTL) + CW_MOE + (l * MOE_CHUNKS + c) * 256; \
            const int* LIST = (const int*)(ws + WS_LISTE) + (size_t)c * N_EXP * LIST_CAP; const float* GATE = (const float*)(ws + WS_ROUTE + 1 * MiB) + (size_t)tok0 * 8; (void)rec; (void)LIST; (void)GATE; (void)wb
            if (IN(P_GU)) {
                MOE_BASES();
#if USE_MK_EXPERT
                LAS int* cum = (LAS int*)(F.lds + LDS_CUM); LAS int* offl = cum + 80; LAS int* tab = (LAS int*)(F.lds + LDS_TAB);
                const int tidm = F.wave * 64 + lane_id();
                if (F.wave == 0) { const int ln = tidm & 63, ce = rec[ln], nb = (ce + 255) >> 8;
                    const int ib = wave_incl_scan(nb, ln), io = wave_incl_scan(ce, ln);
                    cum[ln] = ib - nb; offl[ln] = io - ce; if (ln == 63) { cum[N_EXP] = ib; offl[N_EXP] = io; } }
                __syncthreads();
                LAS int* ut = (LAS int*)(F.lds + LDS_UT);
                pg8::GroupedOrder S{cum, offl, 2, F.G, (int)blockIdx.x, ut};
                if (F.wave == 0) S.fill_table(ut, tidm);
                __syncthreads();
                for (int i = F.wave; i < 8; i += NWAVES) { const int nvv = ut[8 * i + 2], lr = ut[8 * i + 4]; const int ln = tidm & 63;
#pragma unroll
                    for (int k = 0; k < 4; ++k) { const int r = ln + 64 * k; tab[i * 256 + r] = tok0 + ((r < nvv) ? (LIST[lr + r] >> 3) : 0); } }
                __syncthreads();
                { pg8::Gemm g{HB, (const bf16*)(wb + WB_GU), D, 0, (size_t)512 * D};
                  pg8::EpiSwiglu E{(bf16*)(ws + WS_HID)};
                  pg8::gemm_phase<pg8::EpiSwiglu, pg8::GroupedOrder, true>(F.lds + LDS_STAGE, g, S, E, tab, F.wave); }
#endif
                { pg8::Gemm g{HB + (size_t)tok0 * D, (const bf16*)(wb + WB_SGU), D, 0, 0}; pg8::DenseOrder S2; S2.init(MOE_TOK, 512, 1, F.G, (int)((blockIdx.x + 64) % F.G));
                  pg8::EpiSwiglu E{(bf16*)(ws + WS_SHH)};
                  pg8::gemm_phase<pg8::EpiSwiglu, pg8::DenseOrder, false>(F.lds + LDS_STAGE, g, S2, E, nullptr, F.wave); }
                GRID_BAR();
            }
            if (IN(P_DN)) {
                MOE_BASES();
#if USE_MK_EXPERT
                LAS int* cum = (LAS int*)(F.lds + LDS_CUM); LAS int* offl = cum + 80;
                const int tidm = F.wave * 64 + lane_id();
                if (F.wave == 0) { const int ln = tidm & 63, ce = rec[ln], nb = (ce + 255) >> 8;
                    const int ib = wave_incl_scan(nb, ln), io = wave_incl_scan(ce, ln);
                    cum[ln] = ib - nb; offl[ln] = io - ce; if (ln == 63) { cum[N_EXP] = ib; offl[N_EXP] = io; } }
                __syncthreads();
                { LAS int* ut = (LAS int*)(F.lds + LDS_UT); LAS int* ag = (LAS int*)(F.lds + LDS_AG);
                  pg8::GroupedOrder S{cum, offl, 4, F.G, (int)blockIdx.x, ut};
                  if (F.wave == 0) S.fill_table(ut, tidm);
                  __syncthreads();
                  for (int i = F.wave; i < MOE_AGU; i += NWAVES) { const int nvv = ut[8 * i + 2], lr = ut[8 * i + 4]; const int ln = tidm & 63;
#pragma unroll
                      for (int k = 0; k < 4; ++k) { const int r = ln + 64 * k; if (r < nvv) { const int aid = LIST[lr + r]; *(LAS i32x2*)(ag + (i * 256 + r) * 2) = (i32x2){aid, __float_as_int(GATE[aid])}; } } }
                  __syncthreads();
                  pg8::Gemm g{(const bf16*)(ws + WS_HID), (const bf16*)(wb + WB_DN), EXP_DIM, 0, (size_t)D * EXP_DIM};
                  pg8::EpiSlot E{(bf16*)(ws + WS_SLOT), LIST, GATE, ag};
                  pg8::gemm_phase<pg8::EpiSlot, pg8::GroupedOrder, false>(F.lds + LDS_STAGE, g, S, E, nullptr, F.wave); }
#endif
                { pg8::Gemm g{(const bf16*)(ws + WS_SHH), (const bf16*)(wb + WB_SD), SH_DIM, 0, 0}; pg8::DenseOrder S2; S2.init(MOE_TOK, D, 1, F.G, (int)blockIdx.x);
                  pg8::EpiBf16 E{(bf16*)(ws + WS_SHY), D, 0, 0, 0};
                  pg8::gemm_phase<pg8::EpiBf16, pg8::DenseOrder, false>(F.lds + LDS_STAGE, g, S2, E, nullptr, F.wave); }
                GRID_BAR();
            }
            if (IN(P_COMB)) {
                PHASE_BASES();
                const int lane = lane_id(); const bf16* SLOTp = (const bf16*)(ws + WS_SLOT);
                for (int tl = gw; tl < MOE_TOK; tl += NGW) { const int row = tok0 + tl;
                    ln_res_rows<1, false, true, true>(HB + (size_t)row * D, 0, nullptr, 0, (const bf16*)(ws + WS_SHY) + (size_t)tl * D, 0, SLOTp + (size_t)tl * 8 * D, 0, ALPHA, a.in[29] + l * D, a.in[30] + l * D, HB + (size_t)row * D, 0, (l == DEPTH - 1) ? H + (size_t)row * D : nullptr, 0, lane); }
            }
        }
    }
#undef IN
#undef GRID_BAR
}

static Args g_args;
static int g_grid = 0;
#ifndef PROBE_MASK
#define PROBE_MASK 0u
#endif
static void launch_mk(hipStream_t stream, int ph, int l, int c) {
    const int reps = ((PROBE_MASK >> ph) & 1u) ? 3 : 1;
    for (int rr = 0; rr < reps; ++rr) {
    Args a = g_args; a.ph_lo = ph; a.ph_hi = ph + 1; a.l_lo = l; a.l_hi = l + 1; a.c_lo = c; a.c_hi = c + 1; a.use_bar = 0; a.pad = 0;
    hipLaunchKernelGGL(mk_fwd, dim3(g_grid), dim3(NTHR), LDS_BYTES, stream, a);
    }
}
extern "C" void kernel_launch(void* const* d_in, const int* in_sizes, int n_in, void* d_out, int out_size, void* d_ws, size_t ws_size, hipStream_t stream) {
    static int inited = 0;
    if (!inited) {
        inited = 1;
        if (n_in != 31 || out_size != NTOK * D || ws_size < WS_END) { fprintf(stderr, "kernel_launch: unexpected sizes n_in %d out %d ws %zu (need %zu)\n", n_in, out_size, ws_size, (size_t)WS_END); inited = -1; }
        if (hipFuncSetAttribute((const void*)mk_fwd, hipFuncAttributeMaxDynamicSharedMemorySize, LDS_BYTES) != hipSuccess) { fprintf(stderr, "kernel_launch: hipFuncSetAttribute(mk_fwd) failed\n"); inited = -1; }
        int dev = 0, cus = 0, per_cu = 0;
        (void)hipGetDevice(&dev); (void)hipDeviceGetAttribute(&cus, hipDeviceAttributeMultiprocessorCount, dev);
        (void)hipOccupancyMaxActiveBlocksPerMultiprocessor(&per_cu, (const void*)mk_fwd, NTHR, LDS_BYTES);
        if (per_cu < 1) fprintf(stderr, "kernel_launch: occupancy query says %d blocks per CU for mk_fwd\n", per_cu);
        (void)hipGetLastError();
        g_grid = cus > 0 ? cus : 256;
    }
    if (inited < 0) return;
    const float* ln1_g = (const float*)d_in[14]; const float* ln1_b = (const float*)d_in[15];
    const float* ln2_g = (const float*)d_in[19]; const float* ln2_b = (const float*)d_in[20];
    const float* ln3_g = (const float*)d_in[29]; const float* ln3_b = (const float*)d_in[30];
    const float* a_kv_norm = (const float*)d_in[5]; const float* a_w_uk = (const float*)d_in[6]; const float* a_w_uv = (const float*)d_in[7];
    const float* b_lq1 = (const float*)d_in[8]; const float* b_lk1 = (const float*)d_in[9]; const float* b_lq2 = (const float*)d_in[10]; const float* b_lk2 = (const float*)d_in[11];
    const float* b_subln = (const float*)d_in[12];
    const float* router_w = (const float*)d_in[21]; const float* router_bias = (const float*)d_in[22];
    const float* e_w_gate = (const float*)d_in[23]; const float* e_w_up = (const float*)d_in[24]; const float* e_w_down = (const float*)d_in[25];
    unsigned char* ws = (unsigned char*)d_ws;
    float* H = (float*)d_out;
    bf16* HB = (bf16*)(ws + WS_HB);
    bf16* PROJ5 = (bf16*)(ws + WS_PROJ5); bf16* MISC = (bf16*)(ws + WS_MISC10); float* WIDX = (float*)(ws + WS_WIDX); bf16* CKV = (bf16*)(ws + WS_CKV);
    int* SEL = (int*)(ws + WS_SEL); bf16* CAT = (bf16*)(ws + WS_CAT); bf16* Y = (bf16*)(ws + WS_Y);
    bf16* QM = (bf16*)(ws + WS_QM); bf16* OM = (bf16*)(ws + WS_OM);
    int* TOPE = (int*)(ws + WS_ROUTE); float* GATE = (float*)(ws + WS_ROUTE + 1 * MiB); int* LIST = (int*)(ws + WS_ROUTE + 2 * MiB);
    bf16* SLOT = (bf16*)(ws + WS_SLOT);
    int* CNT = (int*)(ws + WS_CTL) + CW_MOE;
    const size_t PS = (size_t)NTOK * 512;
    Args a{};
    for (int i = 0; i < 31; ++i) a.in[i] = (const float*)d_in[i];
    a.out = (float*)d_out; a.ws = ws;
    g_args = a;

    (void)hipMemsetAsync(ws + WS_CTL, 0, 128 * 1024, stream);
#if SINGLE_LAUNCH
    { Args b = g_args; b.ph_lo = 0; b.ph_hi = P_NUM; b.l_lo = 0; b.l_hi = DEPTH; b.c_lo = 0; b.c_hi = MOE_CHUNKS; b.use_bar = 1; b.pad = 0;
      hipLaunchKernelGGL(mk_fwd, dim3(g_grid), dim3(NTHR), LDS_BYTES, stream, b); }
#else
    launch_mk(stream, P_PRO0, 0, 0);
    launch_mk(stream, P_PRO1, 0, 0);
    for (int l = 0; l < DEPTH; ++l) {
        launch_mk(stream, P_CVT, l, 0);
        launch_mk(stream, P_WIN, l, 0);
        launch_mk(stream, P_CKVN, l, 0);
        launch_mk(stream, P_ATTN, l, 0);
        launch_mk(stream, P_DIFF, l, 0);
        launch_mk(stream, P_WO, l, 0);
        launch_mk(stream, P_LN1, l, 0);
        launch_mk(stream, P_WQ, l, 0);
        launch_mk(stream, P_MEMATT, l, 0);
        launch_mk(stream, P_WMO, l, 0);
        launch_mk(stream, P_LN2, l, 0);
        launch_mk(stream, P_RGEMM, l, 0);
        launch_mk(stream, P_ROUTE, l, 0);
        for (int c = 0; c < MOE_CHUNKS; ++c) {
            launch_mk(stream, P_GU, l, c);
            launch_mk(stream, P_DN, l, c);
            launch_mk(stream, P_COMB, l, c);
        }
    }
#endif
}
```

```cpp
#include <hip/hip_runtime.h>
#include <cstdio>
#include <cstdint>

typedef unsigned short bf16;
typedef float f32x4 __attribute__((ext_vector_type(4)));

constexpr int D = 1024, BATCH = 8, SEQ = 4096, NTOK = BATCH * SEQ, DEPTH = 2;
constexpr int CHUNK = 64, TOPK = 256;
constexpr int KV_LORA = 128, A_HEADS = 8, IDX_DIM = 64;
constexpr int B_HEADS = 4;
constexpr int MEM_TOK = 256, MEM_HEADS = 4, MEM_HD = 256;
constexpr int N_EXP = 64, TOP_E = 8, EXP_DIM = 256, SH_DIM = 256;
constexpr int WIN_COLS = 2760;
constexpr float ALPHA = 1.41421356237309515f;
constexpr float LN_EPS = 1e-5f, RMS_EPS = 1e-6f;
constexpr int MOE_CHUNKS = 2, MOE_TOK = NTOK / MOE_CHUNKS;

constexpr size_t MiB = 1u << 20;
constexpr size_t WS_CTL = 0;
constexpr size_t WS_WB = 1 * MiB;
constexpr size_t WS_KVM = 113 * MiB;
constexpr size_t WS_HB = 129 * MiB;
constexpr size_t WS_A = 193 * MiB;
constexpr size_t WS_PROJ5 = WS_A;
constexpr size_t WS_MISC10 = WS_A + 160 * MiB;
constexpr size_t WS_WIDX = WS_A + 176 * MiB;
constexpr size_t WS_CKV = WS_A + 177 * MiB;
constexpr size_t WS_SEL = WS_A + 185 * MiB;
constexpr size_t WS_CAT = WS_A + 217 * MiB;
constexpr size_t WS_Y = WS_A + 281 * MiB;
constexpr size_t WS_MEMB = WS_A + 345 * MiB;
constexpr size_t WS_QM = WS_A;
constexpr size_t WS_OM = WS_A + 64 * MiB;
constexpr size_t WS_ROUTE = WS_A + 336 * MiB;
constexpr int LIST_CAP = MOE_TOK;
constexpr size_t WS_SHY = WS_ROUTE + 10 * MiB;
constexpr size_t WS_LISTE = WS_ROUTE + 2 * MiB;
constexpr size_t WS_LOGIT = WS_ROUTE + 10 * MiB;
constexpr size_t WS_SLOT = WS_A;
constexpr size_t WS_HID = WS_A + 256 * MiB;
constexpr size_t WS_SHH = WS_A + 320 * MiB;
constexpr int VTD_LD = NTOK + 128, VTM_LD = 2048 + 128, KM_LD = 1024 + 128;
constexpr size_t WS_VTD = WS_A + 349 * MiB;
constexpr size_t WS_VTM = WS_A + 382 * MiB;
constexpr size_t WS_END = WS_A + 391 * MiB;
static_assert(WS_SLOT + (size_t)MOE_TOK * 8 * 1024 * 2 <= WS_HID && WS_HID + (size_t)MOE_TOK * 8 * 256 * 2 <= WS_SHH && WS_SHH + (size_t)MOE_TOK * 512 * 2 <= WS_ROUTE && WS_LISTE + (size_t)MOE_CHUNKS * N_EXP * LIST_CAP * 4 <= WS_SHY && WS_SHY + (size_t)MOE_TOK * 1024 * 2 <= WS_VTM, "MoE-stage workspace map: no two live buffers overlap");

__device__ __forceinline__ float bf2f(bf16 v) { return __uint_as_float((unsigned)v << 16); }
__device__ __forceinline__ bf16 f2bf(float f) { unsigned u = __float_as_uint(f); u += 0x7fffu + ((u >> 16) & 1u); return (bf16)(u >> 16); }
__device__ __forceinline__ float wave_sum(float v) {
#pragma unroll
    for (int o = 1; o < 64; o <<= 1) v += __shfl_xor(v, o);
    return v;
}
__device__ __forceinline__ float wave_max(float v) {
#pragma unroll
    for (int o = 1; o < 64; o <<= 1) v = fmaxf(v, __shfl_xor(v, o));
    return v;
}
__device__ __forceinline__ float block_sum(float v, float* scr) {
    v = wave_sum(v); __syncthreads();
    if ((threadIdx.x & 63) == 0) scr[threadIdx.x >> 6] = v;
    __syncthreads();
    float r = scr[0] + scr[1] + scr[2] + scr[3]; __syncthreads(); return r;
}
__device__ __forceinline__ float block_max(float v, float* scr) {
    v = wave_max(v); __syncthreads();
    if ((threadIdx.x & 63) == 0) scr[threadIdx.x >> 6] = v;
    __syncthreads();
    float r = fmaxf(fmaxf(scr[0], scr[1]), fmaxf(scr[2], scr[3])); __syncthreads(); return r;
}

#ifndef USE_MK_EXPERT
#define USE_MK_EXPERT 1
#endif
#ifndef MEMATT_V2
#define MEMATT_V2 1
#endif
#ifndef DIFF_V2
#define DIFF_V2 1
#endif
#ifndef SINGLE_LAUNCH
#define SINGLE_LAUNCH 1
#endif
#ifndef USE_MK_DIFF
#define USE_MK_DIFF 1
#endif
#ifndef USE_MK_TOPK
#define USE_MK_TOPK 1
#endif
#ifndef USE_MK_MEMATT
#define USE_MK_MEMATT 1
#endif

#define LAS __attribute__((address_space(3)))
#define GAS __attribute__((address_space(1)))
typedef short bf16x8 __attribute__((ext_vector_type(8)));
typedef unsigned u32x4 __attribute__((ext_vector_type(4)));
typedef unsigned u32x2 __attribute__((ext_vector_type(2)));
typedef int i32x4 __attribute__((ext_vector_type(4)));
typedef int i32x2 __attribute__((ext_vector_type(2)));
typedef float f32x2 __attribute__((ext_vector_type(2)));
typedef float f32x16 __attribute__((ext_vector_type(16)));

constexpr int NWAVES = 8, NTHR = 512;
constexpr int LDS_BYTES = 163840;
constexpr int LDS_STAGE = 0;
constexpr int LDS_TAB = 131072;
constexpr int LDS_CUM = 131072 + 8192;
constexpr int LDS_UT = LDS_CUM + 640;
constexpr int MOE_MAXU = 16;
constexpr int LDS_AG = LDS_UT + MOE_MAXU * 32;
constexpr int MOE_AGU = 9;
static_assert(LDS_AG + MOE_AGU * 2048 <= LDS_BYTES - 256, "MoE LDS tables");
constexpr int LDS_MISC = LDS_BYTES - 256;

constexpr size_t WB_WIN = 0, WB_WO = 6 * MiB, WB_WQ = 8 * MiB, WB_WMO = 10 * MiB, WB_SGU = 12 * MiB, WB_SD = 13 * MiB, WB_UK = 14 * MiB, WB_UV = 14 * MiB + 256 * 1024, WB_RW = 15 * MiB, WB_GU = 16 * MiB, WB_DN = 80 * MiB;
constexpr int WIN_PAD = 2304;
constexpr size_t WS_WKT = WS_Y, WS_WVT = WS_Y + 2 * MiB;
constexpr size_t WS_KM = WS_KVM, WS_VT = WS_KVM + 8 * MiB;
constexpr int CW_BAR = 4096;
constexpr int CW_MOE = 16384;

__device__ __forceinline__ unsigned pk2(float lo, float hi) { return (unsigned)f2bf(lo) | ((unsigned)f2bf(hi) << 16); }
__device__ __forceinline__ unsigned cvt_pk_bf16(float lo, float hi) { unsigned r; asm volatile("v_cvt_pk_bf16_f32 %0, %1, %2" : "=v"(r) : "v"(lo), "v"(hi)); return r; }
#define LDS_WAIT() asm volatile("s_waitcnt lgkmcnt(0)" ::: "memory")
#define VM_WAIT() asm volatile("s_waitcnt vmcnt(0)" ::: "memory")

#define XB_TMO      128
#define XB_XCNT(j)  (256  + 64 * (j))
#define XB_XSUB(j)  (1280 + 64 * (j))
#define XB_XGEN(j)  (2304 + 64 * (j))
#define XB_TOP      3328
#define XB_TOPGEN   3392
#define XCD_BAR_WORDS 3456
#define XB_SPIN_CAP (1u << 22)
__device__ __forceinline__ unsigned xb_ld(unsigned* p)              { return __hip_atomic_load(p, __ATOMIC_RELAXED, __HIP_MEMORY_SCOPE_AGENT); }
__device__ __forceinline__ unsigned xb_add(unsigned* p, unsigned v) { return __hip_atomic_fetch_add(p, v, __ATOMIC_RELAXED, __HIP_MEMORY_SCOPE_AGENT); }
__device__ __forceinline__ unsigned xb_xcc_id() { return (unsigned)__builtin_amdgcn_s_getreg((3 << 11) | 20) & 0xFu; }
#define XB_SPIN(cond, bar) do { unsigned _sp = 0; while (cond) { __builtin_amdgcn_s_sleep(1); \
    if ((++_sp & 255u) == 0u) { if (xb_ld(&(bar)[XB_TMO])) break; if (_sp > XB_SPIN_CAP) { atomicAdd(&(bar)[XB_TMO], 1u); break; } } } } while (0)
struct XcdBarrier { unsigned* bar; unsigned x; volatile LAS unsigned* st; };
__device__ __forceinline__ XcdBarrier xcd_barrier_post(unsigned* bar, volatile LAS unsigned* st) {
    XcdBarrier b; b.bar = bar; b.x = xb_xcc_id(); b.st = st;
    if (threadIdx.x == 0) (void)xb_add(&bar[XB_XCNT(b.x)], 1u);
    return b;
}
__device__ __forceinline__ void xcd_barrier_complete(unsigned* bar, unsigned x, unsigned& nloc, unsigned& nx) {
    const unsigned G = gridDim.x * gridDim.y * gridDim.z;
    unsigned sum, cnt, mine, sp = 0u;
    for (;;) {
        sum = 0u; cnt = 0u; mine = 0u;
#pragma unroll
        for (unsigned j = 0; j < 16; ++j) { const unsigned c = xb_ld(&bar[XB_XCNT(j)]); sum += c; cnt += (c > 0u) ? 1u : 0u; mine = (j == x) ? c : mine; }
        if (sum == G) break;
        __builtin_amdgcn_s_sleep(1);
        if ((++sp & 255u) == 0u) { if (xb_ld(&bar[XB_TMO])) break; if (sp > XB_SPIN_CAP) { atomicAdd(&bar[XB_TMO], 1u); break; } }
    }
    nloc = mine > 0u ? mine : 1u; nx = cnt > 0u ? cnt : 1u;
}
__device__ __forceinline__ void xcd_barrier(const XcdBarrier& b, int wave_s) {
    asm volatile("s_waitcnt vmcnt(0)" ::: "memory");
    __syncthreads();
    unsigned zb = 0u; asm volatile("" : "+s"(zb));
    if (wave_s == 0 && (int)__builtin_amdgcn_mbcnt_hi(~0u, __builtin_amdgcn_mbcnt_lo(~0u, zb)) == 0) {
        unsigned* bar = b.bar;
        __builtin_amdgcn_s_waitcnt(0);
        unsigned nloc = b.st[0], nx = b.st[1];
        if (nloc == 0u) { xcd_barrier_complete(bar, b.x, nloc, nx); b.st[0] = nloc; b.st[1] = nx; }
        const unsigned old = xb_add(&bar[XB_XSUB(b.x)], 1u);
        const unsigned gen = old / nloc;
        if (old + 1u == (gen + 1u) * nloc) {
            __builtin_amdgcn_fence(__ATOMIC_RELEASE, "agent");
            asm volatile("s_waitcnt vmcnt(0)" ::: "memory");
            const unsigned og = xb_add(&bar[XB_TOP], 1u);
            const unsigned tg = og / nx;
            if (og + 1u == (tg + 1u) * nx) xb_add(&bar[XB_TOPGEN], 1u);
            else XB_SPIN(xb_ld(&bar[XB_TOPGEN]) == tg, bar);
            __builtin_amdgcn_fence(__ATOMIC_ACQUIRE, "agent");
            xb_add(&bar[XB_XGEN(b.x)], 1u);
            asm volatile("s_waitcnt vmcnt(0)" ::: "memory");
        } else {
            XB_SPIN(xb_ld(&bar[XB_XGEN(b.x)]) == gen, bar);
            __builtin_amdgcn_fence(__ATOMIC_ACQUIRE, "agent");
            asm volatile("s_waitcnt vmcnt(0)" ::: "memory");
        }
    }
    __syncthreads();
}

namespace pg8 {
typedef unsigned short bf16_t;
constexpr int BM = 256, BK = 64, HALF = 128, HTB = HALF * BK * 2, STAGE_BYTES = 8 * HTB, NXCD = 8, WGM = 8;
__host__ __device__ __forceinline__ int lds_byte(int r, int c) { const int st = (r >> 4) * 2 + (c >> 5), rr = r & 15, cc = c & 31, ob = rr * 64 + cc * 2; return st * 1024 + (ob ^ (((ob >> 9) & 1) << 5)); }
__host__ __device__ __forceinline__ void stage_rc(int b, int& R, int& C) { const int st = b / 1024, sb = b % 1024, swz = sb ^ (((sb >> 9) & 1) << 5); R = (st >> 1) * 16 + swz / 64; C = (st & 1) * 32 + (swz % 64) / 2; }
__host__ __device__ __forceinline__ int perm32(int rho) { const int n = rho >> 4, i = rho & 15; return 8 * (i >> 2) + 4 * n + (i & 3); }

struct Unit { int g, r0, nv, pn, slot, lr0; };
struct Gemm { const bf16_t* A; const bf16_t* Bt; int K; size_t astride, bstride; };

struct DenseOrder {
    int nM, nN, nwg, ng, G, c;
    __device__ void init(int M, int N, int ngroups, int G_, int c_) { nM = M / BM; nN = N / BM; nwg = nM * nN; ng = ngroups; G = G_; c = c_; }
    __device__ __forceinline__ bool next(int i, Unit& u) const {
        const long L = (long)i * G + c; if (L >= (long)nwg * ng) return false;
        const int g = (int)(L / nwg); int wgid = (int)(L % nwg);
        { const int q = nwg / NXCD, r = nwg % NXCD, xcd = wgid % NXCD, off = wgid / NXCD; wgid = (xcd < r ? xcd * (q + 1) : r * (q + 1) + (xcd - r) * q) + off; }
        const int nig = WGM * nN, gid = wgid / nig, fm = gid * WGM, gsz = (nM - fm) < WGM ? (nM - fm) : WGM;
        u.g = g; u.r0 = (fm + ((wgid % nig) % gsz)) * BM; u.pn = (wgid % nig) / gsz; u.nv = BM; u.slot = i; u.lr0 = 0; return true;
    }
};
struct GroupedOrder {
    const LAS int* cum; const LAS int* off; int NT, G, c; const LAS int* ut;
    __device__ bool next(int i, Unit& u) const {
        if (i >= MOE_MAXU) return false;
        const i32x4 a = *(const LAS i32x4*)(ut + 8 * i); const i32x4 b = *(const LAS i32x4*)(ut + 8 * i + 4);
        if (__builtin_amdgcn_readfirstlane(b.w) == 0) return false;
        u.g = __builtin_amdgcn_readfirstlane(a.x); u.r0 = __builtin_amdgcn_readfirstlane(a.y); u.nv = __builtin_amdgcn_readfirstlane(a.z); u.pn = __builtin_amdgcn_readfirstlane(a.w);
        u.lr0 = __builtin_amdgcn_readfirstlane(b.x); u.slot = i; return true;
    }
    __device__ __forceinline__ void peek(int i, int& g, int& r0, int& nv, int& pn, int& lr0) const {
        const int L = i * G + c; const int total = cum[N_EXP] * NT; const bool ok = L < total;
        const int blk = ok ? L / NT : 0; pn = ok ? L - blk * NT : 0;
        int lo = 0, hi = N_EXP;
#pragma unroll
        for (int s = 0; s < 6; ++s) { const int mid = (lo + hi) >> 1; const bool le = cum[mid] <= blk; lo = le ? mid : lo; hi = le ? hi : mid; }
        g = lo; r0 = off[lo] + (blk - cum[lo]) * BM; const int rem = off[lo + 1] - r0; nv = ok ? (rem < BM ? rem : BM) : 0; lr0 = lo * LIST_CAP + (blk - cum[lo]) * BM;
    }
    __device__ __forceinline__ void fill_table(LAS int* utw, int lane) const {
        if (lane < MOE_MAXU) { int g, r0, nv, pn, lr0; peek(lane, g, r0, nv, pn, lr0);
            *(LAS i32x4*)(utw + 8 * lane) = (i32x4){g, r0, nv, pn}; *(LAS i32x4*)(utw + 8 * lane + 4) = (i32x4){lr0, 0, 0, nv > 0 ? 1 : 0}; }
    }
};

#define PG8_SA(b, h) (((b) * 2 + (h)) * HTB)
#define PG8_SB(b, h) ((4 + (b) * 2 + (h)) * HTB)
#define PG8_STAGE(bufoff, gbase, voff) do { _Pragma("unroll") for (int _i = 0; _i < 2; ++_i) \
        __builtin_amdgcn_global_load_lds((const unsigned*)((const char*)(gbase) + (voff)[_i]), (LAS unsigned*)(lds + (bufoff) + ldsw + _i * 8192), 16, 0, 0); } while (0)
#define PG8_LDA(dst, b, h) do { _Pragma("unroll") for (int m = 0; m < 4; ++m) _Pragma("unroll") for (int k = 0; k < 2; ++k) dst[m][k] = *(const LAS bf16x8*)(lds + PG8_SA(b, h) + aoff + m * 2048 + k * 1024); } while (0)
#define PG8_LDB(dst, b, h) do { _Pragma("unroll") for (int n = 0; n < 2; ++n) _Pragma("unroll") for (int k = 0; k < 2; ++k) dst[n][k] = *(const LAS bf16x8*)(lds + PG8_SB(b, h) + boff + n * 2048 + k * 1024); } while (0)
#define PG8_MMA(ai, bj, At, Bt) do { __builtin_amdgcn_s_setprio(1); _Pragma("unroll") for (int m = 0; m < 4; ++m) _Pragma("unroll") for (int n = 0; n < 2; ++n) _Pragma("unroll") for (int k = 0; k < 2; ++k) \
        acc[ai][bj][m][n] = __builtin_amdgcn_mfma_f32_16x16x32_bf16(Bt[n][k], At[m][k], acc[ai][bj][m][n], 0, 0, 0); __builtin_amdgcn_s_setprio(0); } while (0)
#define PG8_WAIT_V(n) asm volatile("s_waitcnt vmcnt(" #n ")" ::: "memory")
#define PG8_WAIT_L(n) asm volatile("s_waitcnt lgkmcnt(" #n ")" ::: "memory")
#define PG8_BAR __builtin_amdgcn_s_barrier()
#define PG8_SCHED __builtin_amdgcn_sched_barrier(0)

template <class Epi, class Sched, bool GATHER>
__device__ __forceinline__ void gemm_phase(LAS unsigned char* lds, const Gemm g, const Sched& S, const Epi& E, const LAS int* tab, int wave_s) {
    unsigned zz = 0u; asm volatile("" : "+s"(zz)); const int lane = (int)__builtin_amdgcn_mbcnt_hi(~0u, __builtin_amdgcn_mbcnt_lo(~0u, zz));
    const int wid = wave_s, tid = wid * 64 + lane, wr = wid >> 2, wc = wid & 3, fr = lane & 15, fq = lane >> 4;
    const int K = g.K, nt = K / BK;
    unsigned voffA[2], voffB[2]; unsigned gvA[2][2];
#pragma unroll
    for (int i = 0; i < 2; ++i) { int R, C; stage_rc(tid * 16 + i * 8192, R, C); const int Rb = Epi::PERM ? ((R & ~31) + perm32(R & 31)) : R;
        voffA[i] = (unsigned)(R * K + C) * 2u; voffB[i] = (unsigned)(Rb * K + C) * 2u; }
#define PG8_GATHER_OFFS(slot_) do { unsigned zq = 0u; asm volatile("" : "+s"(zq)); const int lq = (int)__builtin_amdgcn_mbcnt_hi(~0u, __builtin_amdgcn_mbcnt_lo(~0u, zq)); \
        _Pragma("unroll") for (int i_ = 0; i_ < 2; ++i_) { int R_, C_; stage_rc((wid * 64 + lq) * 16 + i_ * 8192, R_, C_); \
            _Pragma("unroll") for (int h_ = 0; h_ < 2; ++h_) gvA[h_][i_] = (unsigned)(tab[(slot_) * 256 + h_ * HALF + R_] * K + C_) * 2u; } } while (0)
    const size_t kstep = (size_t)(BK * 2);
    const size_t hstep = (size_t)HALF * K * 2;
    const unsigned ldsw = (unsigned)wid * 1024u;
    const int aoff = lds_byte(wr * 64 + fr, fq * 8), boff = lds_byte(wc * 32 + fr, fq * 8);
    Unit cur, nxt; int ui = 0;
    if (!S.next(0, cur)) return;
    f32x4 acc[2][2][4][2];
#pragma unroll
    for (int a = 0; a < 2; ++a)
#pragma unroll
        for (int b = 0; b < 2; ++b)
#pragma unroll
            for (int m = 0; m < 4; ++m)
#pragma unroll
                for (int n = 0; n < 2; ++n) acc[a][b][m][n] = (f32x4){0.f, 0.f, 0.f, 0.f};
    bf16x8 At[4][2], B0[2][2], B1[2][2];
    const char* cA; const char* cB;
    if (GATHER) {
        cA = (const char*)g.A;
        PG8_GATHER_OFFS(cur.slot);
    } else cA = (const char*)(g.A + (size_t)cur.g * g.astride) + (size_t)cur.r0 * K * 2;
    cB = (const char*)(g.Bt + (size_t)cur.g * g.bstride) + (size_t)cur.pn * BM * K * 2;
#define PG8_STAGE_A(bufoff, base, h, gv) do { if (GATHER) PG8_STAGE(bufoff, base, gv[h]); else PG8_STAGE(bufoff, (base) + (h) * hstep, voffA); } while (0)
    PG8_STAGE(PG8_SB(0, 0), cB, voffB); PG8_STAGE_A(PG8_SA(0, 0), cA, 0, gvA); PG8_STAGE(PG8_SB(0, 1), cB + hstep, voffB); PG8_STAGE_A(PG8_SA(0, 1), cA, 1, gvA);
    if (wr == 1) PG8_BAR;
    PG8_WAIT_V(4); PG8_BAR;
    PG8_STAGE(PG8_SB(1, 0), cB + kstep, voffB); PG8_STAGE_A(PG8_SA(1, 0), cA + kstep, 0, gvA); PG8_STAGE(PG8_SB(1, 1), cB + hstep + kstep, voffB);
    PG8_WAIT_V(6); PG8_BAR;
    for (;;) {
        const bool has_next = S.next(ui + 1, nxt);
        const char* nA; const char* nB;
        if (has_next) {
            nA = GATHER ? (const char*)g.A : (const char*)(g.A + (size_t)nxt.g * g.astride) + (size_t)nxt.r0 * K * 2;
            nB = (const char*)(g.Bt + (size_t)nxt.g * g.bstride) + (size_t)nxt.pn * BM * K * 2;
        } else { nA = cA; nB = cB; }
        for (int t = 0; t < nt; t += 2) {
            const bool last = (t == nt - 2);
            const char* a1 = cA + (size_t)(t + 1) * kstep;
            const char* a2 = last ? nA : cA + (size_t)(t + 2) * kstep; const char* b2 = last ? nB : cB + (size_t)(t + 2) * kstep;
            const char* a3 = a2 + kstep; const char* b3 = b2 + kstep;
            PG8_LDB(B0, 0, 0); PG8_SCHED; PG8_LDA(At, 0, 0); PG8_STAGE_A(PG8_SA(1, 1), a1, 1, gvA);
            PG8_WAIT_L(8); PG8_BAR; PG8_WAIT_L(0); PG8_MMA(0, 0, At, B0); PG8_BAR; PG8_SCHED;
            if (GATHER && last && has_next) PG8_GATHER_OFFS(nxt.slot);
            PG8_LDB(B1, 0, 1); PG8_STAGE(PG8_SB(0, 0), b2, voffB);
            PG8_BAR; PG8_WAIT_L(0); PG8_MMA(0, 1, At, B1); PG8_BAR;
            PG8_LDA(At, 0, 1); PG8_STAGE_A(PG8_SA(0, 0), a2, 0, gvA);
            PG8_BAR; PG8_WAIT_L(0); PG8_MMA(1, 0, At, B0); PG8_BAR; PG8_SCHED;
            PG8_STAGE(PG8_SB(0, 1), b2 + hstep, voffB);
            PG8_WAIT_V(6); PG8_BAR; PG8_MMA(1, 1, At, B1); PG8_BAR;
            PG8_LDB(B0, 1, 0); PG8_SCHED; PG8_LDA(At, 1, 0); PG8_STAGE_A(PG8_SA(0, 1), a2, 1, gvA);
            PG8_WAIT_L(8); PG8_BAR; PG8_WAIT_L(0); PG8_MMA(0, 0, At, B0); PG8_BAR; PG8_SCHED;
            PG8_LDB(B1, 1, 1); PG8_STAGE(PG8_SB(1, 0), b3, voffB);
            PG8_BAR; PG8_WAIT_L(0); PG8_MMA(0, 1, At, B1); PG8_BAR;
            PG8_LDA(At, 1, 1); PG8_STAGE_A(PG8_SA(1, 0), a3, 0, gvA);
            PG8_BAR; PG8_WAIT_L(0); PG8_MMA(1, 0, At, B0); PG8_BAR; PG8_SCHED;
            PG8_STAGE(PG8_SB(1, 1), b3 + hstep, voffB);
            PG8_WAIT_V(6); PG8_BAR; PG8_MMA(1, 1, At, B1); PG8_BAR;
        }
        { unsigned z2 = 0u; asm volatile("" : "+s"(z2)); const int lz = (int)__builtin_amdgcn_mbcnt_hi(~0u, __builtin_amdgcn_mbcnt_lo(~0u, z2));
          E(acc, cur, wr, wc, lz & 15, lz >> 4); }
        if (!has_next) break;
#pragma unroll
        for (int a = 0; a < 2; ++a)
#pragma unroll
            for (int b = 0; b < 2; ++b)
#pragma unroll
                for (int m = 0; m < 4; ++m)
#pragma unroll
                    for (int n = 0; n < 2; ++n) acc[a][b][m][n] = (f32x4){0.f, 0.f, 0.f, 0.f};
        cur = nxt; cA = nA; cB = nB; ++ui;
    }
    PG8_WAIT_V(0);
    if (wr == 0) PG8_BAR;
    PG8_BAR;
#undef PG8_STAGE_A
#undef PG8_GATHER_OFFS
}

struct EpiBf16 {
    static constexpr bool PERM = true;
    bf16_t* O; int ldc; size_t ostride; int split_cols; size_t split_stride;
    __device__ __forceinline__ void operator()(const f32x4 (&acc)[2][2][4][2], const Unit& u, int wr, int wc, int fr, int fq) const {
        const int row0 = u.r0 + wr * 64 + fr; int colt = u.pn * BM; bf16_t* base = O + (size_t)u.g * ostride;
        if (split_cols) { const int t = colt / split_cols; base += (size_t)t * split_stride; colt -= t * split_cols; }
        const int col0 = colt + wc * 32 + 8 * fq;
#pragma unroll
        for (int ai = 0; ai < 2; ++ai)
#pragma unroll
            for (int m = 0; m < 4; ++m) { bf16_t* rowp = base + (size_t)(row0 + ai * HALF + m * 16) * ldc + col0;
#pragma unroll
                for (int bj = 0; bj < 2; ++bj) { const f32x4 v0 = acc[ai][bj][m][0], v1 = acc[ai][bj][m][1];
                    u32x4 w; w.x = cvt_pk_bf16(v0[0], v0[1]); w.y = cvt_pk_bf16(v0[2], v0[3]); w.z = cvt_pk_bf16(v1[0], v1[1]); w.w = cvt_pk_bf16(v1[2], v1[3]);
                    *(u32x4*)(rowp + bj * HALF) = w; } }
    }
};
struct EpiProjMk {
    static constexpr bool PERM = true;
    bf16_t* proj5; bf16_t* misc; float* widx; bf16_t* kidxf;
    __device__ __forceinline__ void operator()(const f32x4 (&acc)[2][2][4][2], const Unit& u, int wr, int wc, int fr, int fq) const {
        const int row0 = u.r0 + wr * 64 + fr; const bool m10 = (u.pn == 8);
        bf16_t* base = m10 ? misc : proj5 + (size_t)(u.pn >> 1) * ((size_t)NTOK * 512) + (u.pn & 1) * 256;
        const int ldc = m10 ? 256 : 512; const int col0 = wc * 32 + 8 * fq;
#pragma unroll
        for (int ai = 0; ai < 2; ++ai)
#pragma unroll
            for (int m = 0; m < 4; ++m) { const int row = row0 + ai * HALF + m * 16; bf16_t* rowp = base + (size_t)row * ldc + col0;
#pragma unroll
                for (int bj = 0; bj < 2; ++bj) { const f32x4 v0 = acc[ai][bj][m][0], v1 = acc[ai][bj][m][1];
                    u32x4 w; w.x = cvt_pk_bf16(v0[0], v0[1]); w.y = cvt_pk_bf16(v0[2], v0[3]); w.z = cvt_pk_bf16(v1[0], v1[1]); w.w = cvt_pk_bf16(v1[2], v1[3]);
                    *(u32x4*)(rowp + bj * HALF) = w;
                    if (m10 && bj == 1 && col0 == 64) { const float s = 0.35355339059327373f; float* wp = widx + (size_t)row * 8;
                        *(f32x4*)wp = v0 * s; *(f32x4*)(wp + 4) = v1 * s; }
                    if (m10 && bj == 1 && col0 < 64) *(u32x4*)(kidxf + ((size_t)(row >> 5) * 4 + (col0 >> 4)) * 512 + ((col0 >> 3) & 1) * 256 + (row & 31) * 8) = w; } }
    }
};
struct EpiSwiglu {
    static constexpr bool PERM = true;
    bf16_t* O;
    __device__ __forceinline__ void operator()(const f32x4 (&acc)[2][2][4][2], const Unit& u, int wr, int wc, int fr, int fq) const {
        const int col0 = u.pn * 128 + wc * 32 + 8 * fq;
#pragma unroll
        for (int ai = 0; ai < 2; ++ai)
#pragma unroll
            for (int m = 0; m < 4; ++m) { const int r = ai * HALF + wr * 64 + m * 16 + fr;
                float h[8];
#pragma unroll
                for (int n = 0; n < 2; ++n)
#pragma unroll
                    for (int j = 0; j < 4; ++j) { const float gv = acc[ai][0][m][n][j], uv = acc[ai][1][m][n][j]; h[n * 4 + j] = gv / (1.0f + __expf(-gv)) * uv; }
                u32x4 w; w.x = cvt_pk_bf16(h[0], h[1]); w.y = cvt_pk_bf16(h[2], h[3]); w.z = cvt_pk_bf16(h[4], h[5]); w.w = cvt_pk_bf16(h[6], h[7]);
                if (r < u.nv) *(u32x4*)(O + (size_t)(u.r0 + r) * 256 + col0) = w; }
    }
};
struct EpiAxpyHMk {
    static constexpr bool PERM = false;
    float* H;
    __device__ __forceinline__ void operator()(const f32x4 (&acc)[2][2][4][2], const Unit& u, int wr, int wc, int fr, int fq) const {
        const int row0 = u.r0 + wr * 64 + fr, col0 = u.pn * BM + wc * 32 + 4 * fq;
#pragma unroll
        for (int ai = 0; ai < 2; ++ai)
#pragma unroll
            for (int m = 0; m < 4; ++m) { float* rowp = H + (size_t)(row0 + ai * HALF + m * 16) * D + col0;
#pragma unroll
                for (int bj = 0; bj < 2; ++bj)
#pragma unroll
                    for (int n = 0; n < 2; ++n) { f32x4* p = (f32x4*)(rowp + bj * HALF + n * 16); const f32x4 h = *p; *p = h * ALPHA + acc[ai][bj][m][n]; }
                asm volatile("" ::: "memory"); }
    }
};
struct EpiLogit {
    static constexpr bool PERM = false;
    float* L;
    __device__ __forceinline__ void operator()(const f32x4 (&acc)[2][2][4][2], const Unit& u, int wr, int wc, int fr, int fq) const {
        if (wc < 2) {
            const int row0 = u.r0 + wr * 64 + fr, col0 = wc * 32 + 4 * fq;
#pragma unroll
            for (int ai = 0; ai < 2; ++ai)
#pragma unroll
                for (int m = 0; m < 4; ++m) { float* rowp = L + (size_t)(row0 + ai * HALF + m * 16) * N_EXP + col0;
#pragma unroll
                    for (int n = 0; n < 2; ++n) *(f32x4*)(rowp + n * 16) = acc[ai][0][m][n]; }
        }
    }
};
struct EpiSlot {
    static constexpr bool PERM = true;
    bf16_t* slot; const int* list; const float* gate;
    const LAS int* ag;
    __device__ __forceinline__ void operator()(const f32x4 (&acc)[2][2][4][2], const Unit& u, int wr, int wc, int fr, int fq) const {
        const int col0 = u.pn * BM + wc * 32 + 8 * fq;
#pragma unroll
        for (int ai = 0; ai < 2; ++ai)
#pragma unroll
            for (int m = 0; m < 4; ++m) { const int r = ai * HALF + wr * 64 + m * 16 + fr;
                if (r < u.nv) { int aid; float gt;
                    if (u.slot < MOE_AGU) { const i32x2 t = *(const LAS i32x2*)(ag + (u.slot * 256 + r) * 2); aid = t.x; gt = __int_as_float(t.y); }
                    else { aid = list[u.lr0 + r]; gt = gate[aid]; }
                    bf16_t* rowp = slot + (size_t)aid * D + col0;
#pragma unroll
                    for (int bj = 0; bj < 2; ++bj) { const f32x4 v0 = acc[ai][bj][m][0] * gt, v1 = acc[ai][bj][m][1] * gt;
                        u32x4 w; w.x = cvt_pk_bf16(v0[0], v0[1]); w.y = cvt_pk_bf16(v0[2], v0[3]); w.z = cvt_pk_bf16(v1[0], v1[1]); w.w = cvt_pk_bf16(v1[2], v1[3]);
                        *(u32x4*)(rowp + bj * HALF) = w; } } }
    }
};
struct EpiVT {
    static constexpr bool PERM = true;
    bf16_t* O; int ldc; size_t ostride;
    __device__ __forceinline__ void operator()(const f32x4 (&acc)[2][2][4][2], const Unit& u, int wr, int wc, int fr, int fq) const {
        const int row0 = u.r0 + wr * 64 + fr; bf16_t* base = O + (size_t)u.g * ostride;
        const int c0 = wc * 32 + 8 * fq, n32 = c0 & 31, pos0 = 8 * ((n32 >> 2) & 3) + 4 * (n32 >> 4);
        const int col0 = u.pn * BM + (c0 & ~31) + pos0;
#pragma unroll
        for (int ai = 0; ai < 2; ++ai)
#pragma unroll
            for (int m = 0; m < 4; ++m) { bf16_t* rowp = base + (size_t)(row0 + ai * HALF + m * 16) * ldc + col0;
#pragma unroll
                for (int bj = 0; bj < 2; ++bj) { const f32x4 v0 = acc[ai][bj][m][0], v1 = acc[ai][bj][m][1];
                    u32x2 w0, w1; w0.x = cvt_pk_bf16(v0[0], v0[1]); w0.y = cvt_pk_bf16(v0[2], v0[3]); w1.x = cvt_pk_bf16(v1[0], v1[1]); w1.y = cvt_pk_bf16(v1[2], v1[3]);
                    *(u32x2*)(rowp + bj * HALF) = w0; *(u32x2*)(rowp + bj * HALF + 8) = w1; } }
    }
};
}

__device__ __forceinline__ f32x4 mfma16(bf16x8 a, bf16x8 b, f32x4 c) { return __builtin_amdgcn_mfma_f32_16x16x32_bf16(a, b, c, 0, 0, 0); }
__device__ __forceinline__ bf16x8 pack8(const f32x4& a, const f32x4& b) {
    u32x4 w; w.x = cvt_pk_bf16(a[0], a[1]); w.y = cvt_pk_bf16(a[2], a[3]); w.z = cvt_pk_bf16(b[0], b[1]); w.w = cvt_pk_bf16(b[2], b[3]);
    return __builtin_bit_cast(bf16x8, w);
}
__device__ __forceinline__ int lane_id() { unsigned z = 0u; asm volatile("" : "+s"(z)); return (int)__builtin_amdgcn_mbcnt_hi(~0u, __builtin_amdgcn_mbcnt_lo(~0u, z)); }
__device__ __forceinline__ float relu_f(float x) { const int b = __float_as_int(x); return __int_as_float(b > 0 ? b : 0); }
__device__ __forceinline__ float negbig() { float v; asm volatile("v_mov_b32 %0, 0xf149f2ca" : "=v"(v)); return v; }
__device__ __forceinline__ float shx(float v, int lane, int mask) { return __int_as_float(__builtin_amdgcn_ds_bpermute((lane ^ mask) << 2, __float_as_int(v))); }
__device__ __forceinline__ float xmax16_32(float v, int lane) { v = fmaxf(v, shx(v, lane, 16)); return fmaxf(v, shx(v, lane, 32)); }
__device__ __forceinline__ float xsum16_32(float v, int lane) { v += shx(v, lane, 16); return v + shx(v, lane, 32); }
__device__ __forceinline__ float wave_total(float v) {
    v += __int_as_float(__builtin_amdgcn_update_dpp(0, __float_as_int(v), 0x111, 0xf, 0xf, true));
    v += __int_as_float(__builtin_amdgcn_update_dpp(0, __float_as_int(v), 0x112, 0xf, 0xf, true));
    v += __int_as_float(__builtin_amdgcn_update_dpp(0, __float_as_int(v), 0x114, 0xf, 0xf, true));
    v += __int_as_float(__builtin_amdgcn_update_dpp(0, __float_as_int(v), 0x118, 0xf, 0xf, true));
    v += __int_as_float(__builtin_amdgcn_update_dpp(0, __float_as_int(v), 0x142, 0xa, 0xf, false));
    v += __int_as_float(__builtin_amdgcn_update_dpp(0, __float_as_int(v), 0x143, 0xc, 0xf, false));
    return __int_as_float(__builtin_amdgcn_readlane(__float_as_int(v), 63));
}
__device__ __forceinline__ float wsum(float v, int lane) { (void)lane; return wave_total(v); }
typedef __attribute__((address_space(8))) void* rsrc_t;
typedef __amdgpu_buffer_rsrc_t brsrc_t;
__device__ __forceinline__ brsrc_t make_rsrc(const void* p, unsigned bytes) { return __builtin_amdgcn_make_buffer_rsrc((void*)p, 0, (int)bytes, 0x00020000); }
__device__ __forceinline__ bf16x8 bld16(brsrc_t r, unsigned voff, unsigned soff) { return __builtin_bit_cast(bf16x8, __builtin_amdgcn_raw_buffer_load_b128(r, (int)voff, (int)soff, 0)); }
constexpr float LOG2E = 1.4426950408889634f;
constexpr float SM_THR = 8.0f;

#define MEMFENCE() asm volatile("" ::: "memory")
__device__ __forceinline__ void diff_attn_wave(const bf16* QB, brsrc_t rK, brsrc_t rV, bf16* CAT, int b, int h, int q0, float lam, float lambda_init, const float* subln, int lane) {
    const int qi = lane & 15, g = lane >> 4, tq = q0 + qi, cq = q0 >> 6;
    const float slope = exp2f(-2.0f * (float)(h + 1)), c1 = 0.125f * LOG2E, kb = slope * 8.0f;
    const bf16* qrow = QB + (size_t)(b * SEQ + tq) * 512 + h * 128;
    bf16x8 qf[2][2];
#pragma unroll
    for (int m = 0; m < 2; ++m)
#pragma unroll
        for (int s = 0; s < 2; ++s) qf[m][s] = *(const bf16x8*)(qrow + m * 64 + 32 * s + 8 * g);
    f32x4 o1[8], o2[8];
#pragma unroll
    for (int i = 0; i < 8; ++i) { o1[i] = (f32x4){0.f, 0.f, 0.f, 0.f}; o2[i] = (f32x4){0.f, 0.f, 0.f, 0.f}; }
    float m1 = negbig(), m2 = negbig(), l1 = 0.f, l2 = 0.f;
    const unsigned kvo = (unsigned)(((lane & 15) * 512 + h * 128 + 8 * g) * 2);
    const unsigned vvo = (unsigned)(((h * 128 + (lane & 15)) * VTD_LD + 8 * g) * 2);
    bf16x8 kf[2][4];
    { const int base = 32 * (2 * cq + 1);
#pragma unroll
      for (int sub = 0; sub < 2; ++sub) { const unsigned so = (unsigned)(b * SEQ + base + 16 * sub) * 1024u;
#pragma unroll
          for (int j = 0; j < 4; ++j) kf[sub][j] = bld16(rK, kvo + 64 * j, so); } }
    MEMFENCE();
#pragma unroll 1
    for (int grp = 2 * cq + 1; grp >= 0; --grp) {
        const int base = 32 * grp;
        bf16x8 vf[8];
        { const unsigned sv = (unsigned)(b * SEQ + base) * 2u;
#pragma unroll
          for (int ds = 0; ds < 8; ++ds) vf[ds] = bld16(rV, vvo, sv + (unsigned)ds * (16u * VTD_LD * 2u)); }
        MEMFENCE();
        f32x4 s1[2], s2[2];
#pragma unroll
        for (int sub = 0; sub < 2; ++sub) {
            f32x4 init;
#pragma unroll
            for (int i = 0; i < 4; ++i) { const int key = base + 16 * sub + 4 * g + i; const int kk = key < 2 * tq - key ? key : 2 * tq - key; init[i] = kb * (float)(kk - 64 * cq); }
            s1[sub] = mfma16(kf[sub][0], qf[0][0], init); s1[sub] = mfma16(kf[sub][1], qf[0][1], s1[sub]);
            s2[sub] = mfma16(kf[sub][2], qf[1][0], init); s2[sub] = mfma16(kf[sub][3], qf[1][1], s2[sub]);
        }
        { const int nb = (grp > 0) ? base - 32 : base;
#pragma unroll
          for (int sub = 0; sub < 2; ++sub) { const unsigned so = (unsigned)(b * SEQ + nb + 16 * sub) * 1024u;
#pragma unroll
              for (int j = 0; j < 4; ++j) kf[sub][j] = bld16(rK, kvo + 64 * j, so); } }
        MEMFENCE();
        float mx1 = fmaxf(fmaxf(fmaxf(s1[0][0], s1[0][1]), fmaxf(s1[0][2], s1[0][3])), fmaxf(fmaxf(s1[1][0], s1[1][1]), fmaxf(s1[1][2], s1[1][3])));
        float mx2 = fmaxf(fmaxf(fmaxf(s2[0][0], s2[0][1]), fmaxf(s2[0][2], s2[0][3])), fmaxf(fmaxf(s2[1][0], s2[1][1]), fmaxf(s2[1][2], s2[1][3])));
        const float t1 = c1 * xmax16_32(mx1, lane), t2 = c1 * xmax16_32(mx2, lane);
        if (__any((t1 > m1 + SM_THR) || (t2 > m2 + SM_THR))) {
            const float n1 = fmaxf(m1, t1), n2 = fmaxf(m2, t2), a1 = __builtin_amdgcn_exp2f(m1 - n1), a2 = __builtin_amdgcn_exp2f(m2 - n2);
            l1 *= a1; l2 *= a2; m1 = n1; m2 = n2;
#pragma unroll
            for (int i = 0; i < 8; ++i) { o1[i] *= a1; o2[i] *= a2; }
        }
#pragma unroll
        for (int sub = 0; sub < 2; ++sub)
#pragma unroll
            for (int i = 0; i < 4; ++i) { s1[sub][i] = __builtin_amdgcn_exp2f(c1 * s1[sub][i] - m1); s2[sub][i] = __builtin_amdgcn_exp2f(c1 * s2[sub][i] - m2); l1 += s1[sub][i]; l2 += s2[sub][i]; }
        const bf16x8 p1 = pack8(s1[0], s1[1]), p2 = pack8(s2[0], s2[1]);
#pragma unroll
        for (int ds = 0; ds < 8; ++ds) { o1[ds] = mfma16(vf[ds], p1, o1[ds]); o2[ds] = mfma16(vf[ds], p2, o2[ds]); }
    }
    l1 = xsum16_32(l1, lane); l2 = xsum16_32(l2, lane);
    const float i1 = 1.0f / l1, i2 = lam / l2; float ss = 0.f;
#pragma unroll
    for (int ds = 0; ds < 8; ++ds)
#pragma unroll
        for (int i = 0; i < 4; ++i) { const float v = o1[ds][i] * i1 - o2[ds][i] * i2; o1[ds][i] = v; ss += v * v; }
    ss = xsum16_32(ss, lane);
    const float r = (1.0f / sqrtf(ss * (1.0f / 128.0f) + RMS_EPS)) * (1.0f - lambda_init);
    bf16* orow = CAT + (size_t)(b * SEQ + tq) * D + 512 + h * 128 + 4 * g;
#pragma unroll
    for (int ds = 0; ds < 8; ++ds) { const f32x4 sl = *(const f32x4*)(subln + 16 * ds + 4 * g); const f32x4 y = o1[ds] * r * sl;
        u32x2 w; w.x = cvt_pk_bf16(y[0], y[1]); w.y = cvt_pk_bf16(y[2], y[3]); *(u32x2*)(orow + 16 * ds) = w; }
}

__device__ __forceinline__ void diff_attn_unit(LAS unsigned char* lds, const bf16* QB, const bf16* KB, const bf16* VT, bf16* CAT, int b, int h, int ub, int wave, float lam, float lambda_init, const float* subln) {
    const int lane = lane_id(), tid = wave * 64 + lane;
    const int qi = lane & 15, g = lane >> 4, q0 = 128 * ub + 16 * wave, tq = q0 + qi, cq = q0 >> 6;
    float c1 = 0.125f * LOG2E; asm volatile("" : "+v"(c1));
    const float kb2 = exp2f(-2.0f * (float)(h + 1)) * LOG2E;
    const bf16* qrow = QB + (size_t)(b * SEQ + tq) * 512 + h * 128;
    bf16x8 qf[2][2];
#pragma unroll
    for (int m = 0; m < 2; ++m)
#pragma unroll
        for (int s = 0; s < 2; ++s) { const u32x4 r = *(const u32x4*)(qrow + m * 64 + 32 * s + 8 * g); u32x4 w;
            w.x = cvt_pk_bf16(__uint_as_float(r.x << 16) * c1, __uint_as_float(r.x & 0xffff0000u) * c1); w.y = cvt_pk_bf16(__uint_as_float(r.y << 16) * c1, __uint_as_float(r.y & 0xffff0000u) * c1);
            w.z = cvt_pk_bf16(__uint_as_float(r.z << 16) * c1, __uint_as_float(r.z & 0xffff0000u) * c1); w.w = cvt_pk_bf16(__uint_as_float(r.w << 16) * c1, __uint_as_float(r.w & 0xffff0000u) * c1);
            qf[m][s] = __builtin_bit_cast(bf16x8, w); }
    unsigned one2 = 0x3f803f80u; asm volatile("" : "+v"(one2));
    const bf16x8 ones = __builtin_bit_cast(bf16x8, (u32x4){one2, one2, one2, one2});
    f32x4 o1[8], o2[8], ol1, ol2;
    { float z = 0.f; asm volatile("" : "+v"(z));
#pragma unroll
      for (int i = 0; i < 8; ++i) { o1[i] = (f32x4){z, z, z, z}; o2[i] = (f32x4){z, z, z, z}; }
      ol1 = (f32x4){z, z, z, z}; ol2 = (f32x4){z, z, z, z}; }
    float m1 = 0.f, m2 = 0.f; bool first = true;
    float ib[2][4];
#pragma unroll
    for (int sub = 0; sub < 2; ++sub)
#pragma unroll
        for (int i = 0; i < 4; ++i) ib[sub][i] = kb2 * (float)(16 * sub + 4 * g + i);
    const int skey = tid >> 4, sch = tid & 15, sd = tid >> 2, svc = tid & 3;
    const bf16* kg = KB + (size_t)(b * SEQ + skey) * 512 + h * 128 + sch * 8;
    const bf16* vg = VT + (size_t)(h * 128 + sd) * VTD_LD + (size_t)b * SEQ + 8 * svc;
    const unsigned kdst = (unsigned)(skey * 256 + ((sch ^ (skey & 15)) * 16)), vdst = (unsigned)(8192 + sd * 64 + (((svc + (sd >> 2)) & 3) * 16));
    unsigned ka[2][4], va[8];
#pragma unroll
    for (int sub = 0; sub < 2; ++sub)
#pragma unroll
        for (int j = 0; j < 4; ++j) { const int row = 16 * sub + qi; ka[sub][j] = (unsigned)(row * 256 + (((4 * j + g) ^ (row & 15)) * 16)); }
#pragma unroll
    for (int ds = 0; ds < 8; ++ds) { const int d = 16 * ds + qi; va[ds] = (unsigned)(8192 + d * 64 + (((g + (d >> 2)) & 3) * 16)); }
    const int gmax = 4 * ub + 3, gmine = 2 * cq + 1;
    u32x4 kregA = *(const u32x4*)(kg + (size_t)(32 * gmax) * 512), vregA = *(const u32x4*)(vg + 32 * gmax);
    u32x4 kregB = *(const u32x4*)(kg + (size_t)(32 * (gmax - 1)) * 512), vregB = *(const u32x4*)(vg + 32 * (gmax - 1));
#pragma unroll 1
    for (int gp = gmax; gp >= 1; gp -= 2) {
      LAS unsigned char* sb = lds + (((gp >> 1) & 1) ? 32768 : 0);
      *(LAS u32x4*)(sb + 16384 + kdst) = kregA; *(LAS u32x4*)(sb + 16384 + vdst) = vregA; *(LAS u32x4*)(sb + kdst) = kregB; *(LAS u32x4*)(sb + vdst) = vregB;
      { const int na = gp > 1 ? gp - 2 : 1, nb = na - 1;
        kregA = *(const u32x4*)(kg + (size_t)(32 * na) * 512); vregA = *(const u32x4*)(vg + 32 * na); kregB = *(const u32x4*)(kg + (size_t)(32 * nb) * 512); vregB = *(const u32x4*)(vg + 32 * nb); }
      MEMFENCE();
      __syncthreads();
#pragma unroll
      for (int half = 0; half < 2; ++half) {
        const int grp = gp - half;
        LAS unsigned char* buf = sb + ((grp & 1) ? 16384 : 0);
        if (grp <= gmine) {
            const int base = 32 * grp;
            bf16x8 kf[2][4];
#pragma unroll
            for (int sub = 0; sub < 2; ++sub)
#pragma unroll
                for (int j = 0; j < 4; ++j) kf[sub][j] = *(const LAS bf16x8*)(buf + ka[sub][j]);
            __builtin_amdgcn_sched_barrier(0);
            f32x4 s1[2], s2[2];
            if (base + 31 <= q0) {
                const float gb = kb2 * (float)(base - 64 * cq), g1 = gb - m1, g2 = gb - m2;
#pragma unroll
                for (int sub = 0; sub < 2; ++sub)
#pragma unroll
                    for (int i = 0; i < 4; ++i) { s1[sub][i] = ib[sub][i] + g1; s2[sub][i] = ib[sub][i] + g2; }
            } else {
#pragma unroll
                for (int sub = 0; sub < 2; ++sub)
#pragma unroll
                    for (int i = 0; i < 4; ++i) { const int key = base + 16 * sub + 4 * g + i; const int kk = key < 2 * tq - key ? key : 2 * tq - key; const float bv = kb2 * (float)(kk - 64 * cq); s1[sub][i] = bv - m1; s2[sub][i] = bv - m2; }
            }
#pragma unroll
            for (int sub = 0; sub < 2; ++sub) {
                s1[sub] = mfma16(kf[sub][0], qf[0][0], s1[sub]); s2[sub] = mfma16(kf[sub][2], qf[1][0], s2[sub]);
                s1[sub] = mfma16(kf[sub][1], qf[0][1], s1[sub]); s2[sub] = mfma16(kf[sub][3], qf[1][1], s2[sub]);
            }
            const float mx1 = fmaxf(fmaxf(fmaxf(s1[0][0], s1[0][1]), fmaxf(s1[0][2], s1[0][3])), fmaxf(fmaxf(s1[1][0], s1[1][1]), fmaxf(s1[1][2], s1[1][3])));
            const float mx2 = fmaxf(fmaxf(fmaxf(s2[0][0], s2[0][1]), fmaxf(s2[0][2], s2[0][3])), fmaxf(fmaxf(s2[1][0], s2[1][1]), fmaxf(s2[1][2], s2[1][3])));
            if (first || __any((mx1 > -30.0f) || (mx2 > -30.0f))) {
                bf16x8 vf[8];
#pragma unroll
                for (int ds = 0; ds < 8; ++ds) vf[ds] = *(const LAS bf16x8*)(buf + va[ds]);
                __builtin_amdgcn_sched_barrier(0);
                if (first || __any((mx1 > SM_THR) || (mx2 > SM_THR))) {
                    const float t1 = xmax16_32(mx1, lane), t2 = xmax16_32(mx2, lane);
                    const float d1 = first ? t1 : fmaxf(t1, 0.f), d2 = first ? t2 : fmaxf(t2, 0.f);
                    m1 += d1; m2 += d2;
                    if (!first) { const float a1 = __builtin_amdgcn_exp2f(-d1), a2 = __builtin_amdgcn_exp2f(-d2);
#pragma unroll
                        for (int i = 0; i < 8; ++i) { o1[i] *= a1; o2[i] *= a2; }
                        ol1 *= a1; ol2 *= a2; }
#pragma unroll
                    for (int sub = 0; sub < 2; ++sub)
#pragma unroll
                        for (int i = 0; i < 4; ++i) { s1[sub][i] -= d1; s2[sub][i] -= d2; }
                    first = false;
                }
#pragma unroll
                for (int sub = 0; sub < 2; ++sub)
#pragma unroll
                    for (int i = 0; i < 4; ++i) { s1[sub][i] = __builtin_amdgcn_exp2f(s1[sub][i]); s2[sub][i] = __builtin_amdgcn_exp2f(s2[sub][i]); }
                const bf16x8 p1 = pack8(s1[0], s1[1]), p2 = pack8(s2[0], s2[1]);
#pragma unroll
                for (int ds = 0; ds < 8; ++ds) { o1[ds] = mfma16(vf[ds], p1, o1[ds]); o2[ds] = mfma16(vf[ds], p2, o2[ds]); }
                ol1 = mfma16(ones, p1, ol1); ol2 = mfma16(ones, p2, ol2);
            }
        }
      }
    }
    const float i1 = 1.0f / ol1[0], i2 = lam / ol2[0]; float ss = 0.f;
    f32x4 sl[8];
#pragma unroll
    for (int ds = 0; ds < 8; ++ds) sl[ds] = *(const f32x4*)(subln + 16 * ds + 4 * g);
#pragma unroll
    for (int ds = 0; ds < 8; ++ds)
#pragma unroll
        for (int i = 0; i < 4; ++i) { const float v = o1[ds][i] * i1 - o2[ds][i] * i2; o1[ds][i] = v; ss += v * v; }
    ss = xsum16_32(ss, lane);
    const float r = (1.0f / sqrtf(ss * (1.0f / 128.0f) + RMS_EPS)) * (1.0f - lambda_init);
    bf16* orow = CAT + (size_t)(b * SEQ + tq) * D + 512 + h * 128 + 4 * g;
#pragma unroll
    for (int ds = 0; ds < 8; ++ds) { const f32x4 y = o1[ds] * r * sl[ds];
        u32x2 w; w.x = cvt_pk_bf16(y[0], y[1]); w.y = cvt_pk_bf16(y[2], y[3]); *(u32x2*)(orow + 16 * ds) = w; }
    __syncthreads();
}

__device__ __forceinline__ void mem_attn_wave(const bf16* QM, brsrc_t rK, brsrc_t rV, bf16* OM, int b, int h, int t0, int lane) {
    const int qi = lane & 15, g = lane >> 4; const float c1 = 0.0625f * LOG2E;
    const bf16* qrow = QM + (size_t)(t0 + qi) * D + h * 256 + 8 * g;
    bf16x8 qf[8];
#pragma unroll
    for (int s = 0; s < 8; ++s) qf[s] = *(const bf16x8*)(qrow + 32 * s);
    f32x4 o[16];
#pragma unroll
    for (int i = 0; i < 16; ++i) o[i] = (f32x4){0.f, 0.f, 0.f, 0.f};
    float mm = negbig(), ll = 0.f;
    const unsigned kvo = (unsigned)(((lane & 15) * KM_LD + h * 256 + 8 * g) * 2);
    const unsigned vvo = (unsigned)(((h * 256 + (lane & 15)) * VTM_LD + 8 * g) * 2);
    bf16x8 kf[8];
    { const unsigned so = (unsigned)(b * MEM_TOK) * (unsigned)(KM_LD * 2);
#pragma unroll
      for (int s = 0; s < 8; ++s) kf[s] = bld16(rK, kvo + 64 * s, so); }
    MEMFENCE();
#pragma unroll 1
    for (int grp = 0; grp < 8; ++grp) {
        const int base = 32 * grp;
        f32x4 sc[2];
#pragma unroll
        for (int sub = 0; sub < 2; ++sub) {
            f32x4 a = (f32x4){0.f, 0.f, 0.f, 0.f};
#pragma unroll
            for (int s = 0; s < 8; ++s) a = mfma16(kf[s], qf[s], a);
            sc[sub] = a;
            { const int nk = base + 16 * sub + 16; const unsigned so = (unsigned)(b * MEM_TOK + (nk < MEM_TOK ? nk : 0)) * (unsigned)(KM_LD * 2);
#pragma unroll
              for (int s = 0; s < 8; ++s) kf[s] = bld16(rK, kvo + 64 * s, so); }
            MEMFENCE();
        }
        bf16x8 vf[8];
        const unsigned sv = (unsigned)(b * MEM_TOK + base) * 2u;
#pragma unroll
        for (int ds = 0; ds < 8; ++ds) vf[ds] = bld16(rV, vvo, sv + (unsigned)ds * (16u * VTM_LD * 2u));
        MEMFENCE();
        const float mx = fmaxf(fmaxf(fmaxf(sc[0][0], sc[0][1]), fmaxf(sc[0][2], sc[0][3])), fmaxf(fmaxf(sc[1][0], sc[1][1]), fmaxf(sc[1][2], sc[1][3])));
        const float t = c1 * xmax16_32(mx, lane);
        if (__any(t > mm + SM_THR)) { const float n = fmaxf(mm, t), a = __builtin_amdgcn_exp2f(mm - n); ll *= a; mm = n;
#pragma unroll
            for (int i = 0; i < 16; ++i) o[i] *= a; }
#pragma unroll
        for (int sub = 0; sub < 2; ++sub)
#pragma unroll
            for (int i = 0; i < 4; ++i) { sc[sub][i] = __builtin_amdgcn_exp2f(c1 * sc[sub][i] - mm); ll += sc[sub][i]; }
        const bf16x8 pf = pack8(sc[0], sc[1]);
#pragma unroll
        for (int ds = 0; ds < 8; ++ds) o[ds] = mfma16(vf[ds], pf, o[ds]);
#pragma unroll
        for (int ds = 0; ds < 8; ++ds) vf[ds] = bld16(rV, vvo, sv + (unsigned)(ds + 8) * (16u * VTM_LD * 2u));
        MEMFENCE();
#pragma unroll
        for (int ds = 0; ds < 8; ++ds) o[ds + 8] = mfma16(vf[ds], pf, o[ds + 8]);
    }
    ll = xsum16_32(ll, lane); const float inv = 1.0f / ll;
    bf16* orow = OM + (size_t)(t0 + qi) * D + h * 256 + 4 * g;
#pragma unroll
    for (int ds = 0; ds < 16; ++ds) { const f32x4 y = o[ds] * inv; u32x2 w; w.x = cvt_pk_bf16(y[0], y[1]); w.y = cvt_pk_bf16(y[2], y[3]); *(u32x2*)(orow + 16 * ds) = w; }
}

__device__ __forceinline__ void mem_attn_unit(LAS unsigned char* lds, const bf16* QM, const bf16* KM, const bf16* VT, bf16* OM, int tb, int h, int wave) {
    const int lane = lane_id(), tid = wave * 64 + lane;
    const int qi = lane & 15, g = lane >> 4, t0 = 128 * tb + 16 * wave, b = (128 * tb) / SEQ;
    float c1 = 0.0625f * LOG2E; asm volatile("" : "+v"(c1));
    const bf16* qrow = QM + (size_t)(t0 + qi) * D + h * 256 + 8 * g;
    bf16x8 qf[8];
#pragma unroll
    for (int s = 0; s < 8; ++s) { const u32x4 r = *(const u32x4*)(qrow + 32 * s); u32x4 w;
        w.x = cvt_pk_bf16(__uint_as_float(r.x << 16) * c1, __uint_as_float(r.x & 0xffff0000u) * c1); w.y = cvt_pk_bf16(__uint_as_float(r.y << 16) * c1, __uint_as_float(r.y & 0xffff0000u) * c1);
        w.z = cvt_pk_bf16(__uint_as_float(r.z << 16) * c1, __uint_as_float(r.z & 0xffff0000u) * c1); w.w = cvt_pk_bf16(__uint_as_float(r.w << 16) * c1, __uint_as_float(r.w & 0xffff0000u) * c1);
        qf[s] = __builtin_bit_cast(bf16x8, w); }
    unsigned one2 = 0x3f803f80u; asm volatile("" : "+v"(one2));
    const bf16x8 ones = __builtin_bit_cast(bf16x8, (u32x4){one2, one2, one2, one2});
    f32x4 o[16], ol;
    { float z = 0.f; asm volatile("" : "+v"(z));
#pragma unroll
      for (int i = 0; i < 16; ++i) o[i] = (f32x4){z, z, z, z};
      ol = (f32x4){z, z, z, z}; }
    float mm = 0.f;
    const bf16* kg[2]; const bf16* vg[2]; unsigned kdst[2], vdst[2];
#pragma unroll
    for (int i = 0; i < 2; ++i) { const int n = tid + 512 * i, key = n >> 5, ch = n & 31, d = n >> 2, c = n & 3;
        kg[i] = KM + (size_t)(b * MEM_TOK + key) * KM_LD + h * 256 + ch * 8; kdst[i] = (unsigned)(key * 512 + (((ch & 16) | ((ch ^ key) & 15)) * 16));
        vg[i] = VT + (size_t)(h * 256 + d) * VTM_LD + b * MEM_TOK + 8 * c; vdst[i] = (unsigned)(16384 + d * 64 + (((c + (d >> 2)) & 3) * 16)); }
    unsigned ka[2][8], va[16];
#pragma unroll
    for (int sub = 0; sub < 2; ++sub)
#pragma unroll
        for (int s = 0; s < 8; ++s) { const int row = 16 * sub + qi, ch = 4 * s + g; ka[sub][s] = (unsigned)(row * 512 + (((ch & 16) | ((ch ^ row) & 15)) * 16)); }
#pragma unroll
    for (int ds = 0; ds < 16; ++ds) { const int d = 16 * ds + qi; va[ds] = (unsigned)(16384 + d * 64 + (((g + (d >> 2)) & 3) * 16)); }
    u32x4 kreg[2], vreg[2];
#pragma unroll
    for (int i = 0; i < 2; ++i) { kreg[i] = *(const u32x4*)(kg[i]); vreg[i] = *(const u32x4*)(vg[i]); }
#pragma unroll 1
    for (int grp = 0; grp < 8; ++grp) {
        LAS unsigned char* buf = lds + ((grp & 1) ? 32768 : 0);
#pragma unroll
        for (int i = 0; i < 2; ++i) { *(LAS u32x4*)(buf + kdst[i]) = kreg[i]; *(LAS u32x4*)(buf + vdst[i]) = vreg[i]; }
        { const int ng = grp < 7 ? grp + 1 : 7;
#pragma unroll
          for (int i = 0; i < 2; ++i) { kreg[i] = *(const u32x4*)(kg[i] + (size_t)(32 * ng) * KM_LD); vreg[i] = *(const u32x4*)(vg[i] + 32 * ng); } }
        MEMFENCE();
        __syncthreads();
        bf16x8 kf[2][8];
#pragma unroll
        for (int sub = 0; sub < 2; ++sub)
#pragma unroll
            for (int s = 0; s < 8; ++s) kf[sub][s] = *(const LAS bf16x8*)(buf + ka[sub][s]);
        __builtin_amdgcn_sched_barrier(0);
        f32x4 sc[2];
        { const float nm = -mm; sc[0] = (f32x4){nm, nm, nm, nm}; sc[1] = (f32x4){nm, nm, nm, nm}; }
#pragma unroll
        for (int s = 0; s < 8; ++s) { sc[0] = mfma16(kf[0][s], qf[s], sc[0]); sc[1] = mfma16(kf[1][s], qf[s], sc[1]); }
        bf16x8 vf[16];
#pragma unroll
        for (int ds = 0; ds < 16; ++ds) vf[ds] = *(const LAS bf16x8*)(buf + va[ds]);
        __builtin_amdgcn_sched_barrier(0);
        const float mx = fmaxf(fmaxf(fmaxf(sc[0][0], sc[0][1]), fmaxf(sc[0][2], sc[0][3])), fmaxf(fmaxf(sc[1][0], sc[1][1]), fmaxf(sc[1][2], sc[1][3])));
        if (grp == 0 || __any(mx > SM_THR)) {
            const float t = xmax16_32(mx, lane), d = grp == 0 ? t : fmaxf(t, 0.f); mm += d;
            if (grp != 0) { const float a = __builtin_amdgcn_exp2f(-d);
#pragma unroll
                for (int i = 0; i < 16; ++i) o[i] *= a;
                ol *= a; }
#pragma unroll
            for (int sub = 0; sub < 2; ++sub)
#pragma unroll
                for (int i = 0; i < 4; ++i) sc[sub][i] -= d;
        }
#pragma unroll
        for (int sub = 0; sub < 2; ++sub)
#pragma unroll
            for (int i = 0; i < 4; ++i) sc[sub][i] = __builtin_amdgcn_exp2f(sc[sub][i]);
        const bf16x8 pf = pack8(sc[0], sc[1]);
#pragma unroll
        for (int ds = 0; ds < 16; ++ds) o[ds] = mfma16(vf[ds], pf, o[ds]);
        ol = mfma16(ones, pf, ol);
    }
    const float inv = 1.0f / ol[0];
    bf16* orow = OM + (size_t)(t0 + qi) * D + h * 256 + 4 * g;
#pragma unroll
    for (int ds = 0; ds < 16; ++ds) { const f32x4 y = o[ds] * inv; u32x2 w; w.x = cvt_pk_bf16(y[0], y[1]); w.y = cvt_pk_bf16(y[2], y[3]); *(u32x2*)(orow + 16 * ds) = w; }
    __syncthreads();
}

constexpr int TK_SC = 0;
constexpr int TK_QL = 131072;
constexpr int TK_SEL = TK_QL + 16384;
constexpr int TK_HIST = TK_SEL + 4096;
constexpr int TK_CAND = TK_HIST + 8192;
constexpr int TK_MM = TK_CAND + 2048;
constexpr int TK_CAP = 32;
static_assert(TK_MM + 128 <= LDS_MISC, "sparse-attention LDS map");
#ifndef REP_S2X
#define REP_S2X 1
#endif
#ifndef REP_S3
#define REP_S3 1
#endif
#ifndef TOPK_SLOW
#define TOPK_SLOW 1
#endif
#ifndef TOPK_MODE
#define TOPK_MODE 0
#endif
typedef float f32x16v __attribute__((ext_vector_type(16)));
__device__ __forceinline__ unsigned f2ord(float f) { const unsigned u = __float_as_uint(f); return (u & 0x80000000u) ? ~u : (u | 0x80000000u); }
__device__ __forceinline__ float ord2f(unsigned k) { return __uint_as_float((k & 0x80000000u) ? (k & 0x7fffffffu) : ~k); }
__device__ __forceinline__ unsigned offb(unsigned row, unsigned ch) { return 256u * row + 16u * (ch ^ (((row & 3u) << 2) | ((row >> 2) & 3u))); }
__device__ __forceinline__ int wave_incl_scan(int v, int lane) {
    (void)lane;
    v += __builtin_amdgcn_update_dpp(0, v, 0x111, 0xf, 0xf, true);
    v += __builtin_amdgcn_update_dpp(0, v, 0x112, 0xf, 0xf, true);
    v += __builtin_amdgcn_update_dpp(0, v, 0x114, 0xf, 0xf, true);
    v += __builtin_amdgcn_update_dpp(0, v, 0x118, 0xf, 0xf, true);
    v += __builtin_amdgcn_update_dpp(0, v, 0x142, 0xa, 0xf, false);
    v += __builtin_amdgcn_update_dpp(0, v, 0x143, 0xc, 0xf, false);
    return v;
}
__device__ __forceinline__ void hist_cross(const LAS unsigned* hist, int target, int lane, int& tb, int& cabove, int& cnt) {
    const u32x4 c = *(const LAS u32x4*)(hist + 4 * lane);
    const int s4 = (int)(c.x + c.y + c.z + c.w), incl = wave_incl_scan(s4, lane), excl = incl - s4;
    const bool has = (excl < target) && (incl >= target);
    int cum = excl, b = 0, ca = excl, cn = (int)c.x;
    { const int c0 = (int)c.x, c1 = (int)c.y, c2 = (int)c.z, c3 = (int)c.w;
      if (cum + c0 >= target) { b = 0; ca = cum; cn = c0; }
      else if (cum + c0 + c1 >= target) { b = 1; ca = cum + c0; cn = c1; }
      else if (cum + c0 + c1 + c2 >= target) { b = 2; ca = cum + c0 + c1; cn = c2; }
      else { b = 3; ca = cum + c0 + c1 + c2; cn = c3; } }
    const unsigned long long m = __ballot(has);
    const int src = m ? (int)__builtin_ctzll(m) : 0;
    tb = __builtin_amdgcn_readlane(4 * lane + b, src); cabove = __builtin_amdgcn_readlane(ca, src); cnt = __builtin_amdgcn_readlane(cn, src);
}
#define TR_READ(dst, addr) asm volatile("ds_read_b64_tr_b16 %0, %1" : "=v"(dst) : "v"(addr) : "memory")
#define TR_READ_O(dst, addr, off) asm volatile("ds_read_b64_tr_b16 %0, %1 offset:%2" : "=v"(dst) : "v"(addr), "n"(off) : "memory")

__device__ __forceinline__ float tk_coord(float mx, float x, float scale) { return __fmul_rn(__fsub_rn(mx, x), scale); }
__device__ __forceinline__ int tk_sub(float t, int bin) { int sub = (int)__fmul_rn(__fsub_rn(t, (float)bin), 256.0f); return sub > 255 ? 255 : sub; }
__device__ __forceinline__ void topk_select(const LAS float* sc, LAS unsigned short* sel, LAS unsigned* hist, LAS float* cv, LAS unsigned* ci, float mx, float mn, int n, int lane) {
    const int nj = n >> 6;
    if (!(mx > mn)) {
        for (int i = lane; i < TOPK; i += 64) sel[i] = (unsigned short)i;
        return;
    }
    const float scale = 250.0f / (mx - mn);
    const unsigned long long ltmask = (1ull << lane) - 1ull;
    { unsigned zr; asm volatile("v_mov_b32 %0, 0" : "=v"(zr)); *(LAS u32x4*)(hist + 4 * lane) = (u32x4){zr, zr, zr, zr}; }
    LDS_WAIT();
    for (int j = 0; j < nj; j += 4) {
        float x4[4];
#pragma unroll
        for (int u = 0; u < 4; ++u) x4[u] = sc[lane + 64 * ((j + u) < nj ? (j + u) : j)];
#pragma unroll
        for (int u = 0; u < 4; ++u) { const int bin = (int)tk_coord(mx, x4[u], scale); if (j + u < nj) atomicAdd((unsigned*)(hist + bin), 1u); }
    }
    LDS_WAIT();
    int tb, cabove, cnt; hist_cross(hist, TOPK, lane, tb, cabove, cnt);
    int tcode = tb * 256; const bool l1 = cnt > TK_CAP;
    if (l1) {
        { unsigned zr; asm volatile("v_mov_b32 %0, 0" : "=v"(zr)); *(LAS u32x4*)(hist + 4 * lane) = (u32x4){zr, zr, zr, zr}; }
        LDS_WAIT();
#pragma unroll 4
        for (int j = 0; j < nj; ++j) { const float x = sc[lane + 64 * j]; const float t = tk_coord(mx, x, scale); const int bin = (int)t;
            if (bin == tb) { const int sub = tk_sub(t, bin); atomicAdd((unsigned*)(hist + sub), 1u); } }
        LDS_WAIT();
        int tb2, ca2, cnt2; hist_cross(hist, TOPK - cabove, lane, tb2, ca2, cnt2);
        tcode += tb2; cnt = cnt2;
    }
    int base = 0, cb = 0;
    for (int j0 = 0; j0 < nj; j0 += 4) {
        float x4[4];
#pragma unroll
        for (int u = 0; u < 4; ++u) x4[u] = sc[lane + 64 * ((j0 + u) < nj ? (j0 + u) : j0)];
#pragma unroll
        for (int u = 0; u < 4; ++u) {
            const int idx = lane + 64 * (j0 + u); const float x = x4[u]; const float t = tk_coord(mx, x, scale); const int bin = (int)t;
            int sub = 0; if (l1) sub = tk_sub(t, bin);
            const int code = (j0 + u < nj) ? bin * 256 + sub : 0x7fffffff;
            const unsigned long long sm = __ballot(code < tcode), cm = __ballot(code == tcode);
            if (code < tcode) sel[base + __popcll(sm & ltmask)] = (unsigned short)idx;
            if (code == tcode) { const int pos = cb + __popcll(cm & ltmask); if (pos < TK_CAP) { cv[pos] = x; ci[pos] = (unsigned)idx; } }
            base += __popcll(sm); cb += __popcll(cm);
        }
    }
    LDS_WAIT();
    const int r = TOPK - base;
    if (cb <= TK_CAP) {
        const float v = lane < cb ? cv[lane] : 0.f; int rank = 0;
        for (int j = 0; j < cb; ++j) { const float u = cv[j]; rank += (u > v || (u == v && j < lane)) ? 1 : 0; }
        const bool take = lane < cb && rank < r;
        const unsigned long long tm = __ballot(take);
        if (take) sel[base + __popcll(tm & ltmask)] = (unsigned short)ci[lane];
    } else {
        unsigned prefix = 0u; int rem = r;
#pragma unroll 1
        for (int pb = 3; pb >= 0; --pb) {
            { unsigned zr; asm volatile("v_mov_b32 %0, 0" : "=v"(zr)); *(LAS u32x4*)(hist + 4 * lane) = (u32x4){zr, zr, zr, zr}; }
            LDS_WAIT();
            for (int j = 0; j < nj; ++j) { const float x = sc[lane + 64 * j]; const float t = tk_coord(mx, x, scale); const int bin = (int)t;
                int sub = 0; if (l1) sub = tk_sub(t, bin);
                const unsigned k = f2ord(x);
                if ((bin * 256 + sub) == tcode && (pb == 3 || (k >> (8 * (pb + 1))) == prefix)) atomicAdd((unsigned*)(hist + (255 - (int)((k >> (8 * pb)) & 255u))), 1u); }
            LDS_WAIT();
            int tbp, cab, cn; hist_cross(hist, rem, lane, tbp, cab, cn);
            rem -= cab; prefix = (prefix << 8) | (unsigned)(255 - tbp);
        }
        int outp = base, eqtaken = 0;
        for (int j = 0; j < nj; ++j) {
            const int idx = lane + 64 * j; const float x = sc[idx]; const float t = tk_coord(mx, x, scale); const int bin = (int)t;
            int sub = 0; if (l1) sub = tk_sub(t, bin);
            const bool isc = (bin * 256 + sub) == tcode; const unsigned k = f2ord(x);
            const unsigned long long em = __ballot(isc && k == prefix);
            const bool takeeq = isc && k == prefix && (eqtaken + __popcll(em & ltmask)) < rem;
            const bool take = (isc && k > prefix) || takeeq;
            const unsigned long long tm = __ballot(take);
            if (take) sel[outp + __popcll(tm & ltmask)] = (unsigned short)idx;
            outp += __popcll(tm); eqtaken += __popcll(em);
        }
    }
}

__device__ __forceinline__ void dsa_attn_query(brsrc_t rC, const LAS unsigned short* sel, LAS unsigned char* tile, bf16* ql  , int b, int tq) {
    const int lane = lane_id();
    const int g = lane >> 4, hd = lane & 15, h8 = hd & 7;
    float c1 = 0.125f * LOG2E; asm volatile("" : "+v"(c1));
    const float nsl2 = -__builtin_amdgcn_exp2f(-(float)(h8 + 1)) * LOG2E;
    bf16x8 qb[4];
#pragma unroll
    for (int s = 0; s < 4; ++s) { const u32x4 r = *(const u32x4*)(ql + h8 * 128 + 32 * s + 8 * g); u32x4 w;
        w.x = cvt_pk_bf16(__uint_as_float(r.x << 16) * c1, __uint_as_float(r.x & 0xffff0000u) * c1); w.y = cvt_pk_bf16(__uint_as_float(r.y << 16) * c1, __uint_as_float(r.y & 0xffff0000u) * c1);
        w.z = cvt_pk_bf16(__uint_as_float(r.z << 16) * c1, __uint_as_float(r.z & 0xffff0000u) * c1); w.w = cvt_pk_bf16(__uint_as_float(r.w << 16) * c1, __uint_as_float(r.w & 0xffff0000u) * c1);
        qb[s] = __builtin_bit_cast(bf16x8, w); }
    unsigned one2 = 0x3f803f80u; asm volatile("" : "+v"(one2));
    const bf16x8 ones = __builtin_bit_cast(bf16x8, (u32x4){one2, one2, one2, one2});
    f32x4 o[8], ol;
    { float z = 0.f; asm volatile("" : "+v"(z));
#pragma unroll
      for (int c = 0; c < 8; ++c) o[c] = (f32x4){z, z, z, z};
      ol = (f32x4){z, z, z, z}; }
    float mm = 0.f; bool first = true;
    unsigned ra[4], ta[8];
#pragma unroll
    for (int s = 0; s < 4; ++s) ra[s] = offb((unsigned)hd, (unsigned)(4 * s + g));
    { const unsigned q = (unsigned)(hd >> 2), p = (unsigned)(lane & 3);
#pragma unroll
      for (int c = 0; c < 8; ++c) ta[c] = offb(4u * g + q, 2u * c + (p >> 1)) + 8u * (p & 1u); }
    u32x4 grA[8], grB[8];
#define DSA_GATHER(GR, t_) do { _Pragma("unroll") for (int i = 0; i < 8; ++i) { const unsigned key = sel[32 * (t_) + 4 * i + g]; \
        GR[i] = __builtin_amdgcn_raw_buffer_load_b128(rC, (int)(((unsigned)(b * SEQ) + key) * 256u + (unsigned)hd * 16u), 0, 0); } } while (0)
#define DSA_TILE(tl, GR) do { \
        LAS unsigned char* img = tile + ((tl) & 1) * 8192; \
        _Pragma("unroll") for (int i = 0; i < 8; ++i) *(LAS u32x4*)(img + offb((unsigned)(4 * i + g), (unsigned)hd)) = GR[i]; \
        { const int nt_ = (tl) < 6 ? (tl) + 2 : 7; DSA_GATHER(GR, nt_); } \
        MEMFENCE(); \
        bf16x8 af[2][4]; \
        _Pragma("unroll") for (int rb = 0; rb < 2; ++rb) _Pragma("unroll") for (int s = 0; s < 4; ++s) af[rb][s] = *(const LAS bf16x8*)(img + ra[s] + 4096 * rb); \
        u32x2 tr[2][8]; const unsigned ib = (unsigned)(size_t)img; \
        _Pragma("unroll") for (int c = 0; c < 8; ++c) { const unsigned ad = ib + ta[c]; TR_READ(tr[0][c], ad); TR_READ_O(tr[1][c], ad, 4096); } \
        f32x4 sc[2]; \
        _Pragma("unroll") for (int rb = 0; rb < 2; ++rb) { const u32x2 kk = *(const LAS u32x2*)(sel + 32 * (tl) + 16 * rb + 4 * g); \
            const unsigned k4[4] = {kk.x & 0xffffu, kk.x >> 16, kk.y & 0xffffu, kk.y >> 16}; \
            _Pragma("unroll") for (int i = 0; i < 4; ++i) sc[rb][i] = __builtin_fmaf(nsl2, fabsf((float)(tq - (int)k4[i])), -mm); } \
        _Pragma("unroll") for (int s = 0; s < 4; ++s) { sc[0] = mfma16(af[0][s], qb[s], sc[0]); sc[1] = mfma16(af[1][s], qb[s], sc[1]); } \
        const float mx = fmaxf(fmaxf(fmaxf(sc[0][0], sc[0][1]), fmaxf(sc[0][2], sc[0][3])), fmaxf(fmaxf(sc[1][0], sc[1][1]), fmaxf(sc[1][2], sc[1][3]))); \
        if (first || __any(mx > SM_THR)) { \
            const float t = xmax16_32(mx, lane), d = first ? t : fmaxf(t, 0.f); mm += d; \
            if (!first) { const float alpha = __builtin_amdgcn_exp2f(-d); f32x4 ar; \
                _Pragma("unroll") for (int i = 0; i < 4; ++i) ar[i] = __int_as_float(__builtin_amdgcn_ds_bpermute((4 * g + i) << 2, __float_as_int(alpha))); \
                _Pragma("unroll") for (int c = 0; c < 8; ++c) o[c] *= ar; \
                ol *= ar; } \
            _Pragma("unroll") for (int rb = 0; rb < 2; ++rb) _Pragma("unroll") for (int i = 0; i < 4; ++i) sc[rb][i] -= d; \
            first = false; } \
        _Pragma("unroll") for (int rb = 0; rb < 2; ++rb) _Pragma("unroll") for (int i = 0; i < 4; ++i) sc[rb][i] = __builtin_amdgcn_exp2f(sc[rb][i]); \
        const bf16x8 pf = pack8(sc[0], sc[1]); \
        asm volatile("s_waitcnt lgkmcnt(0)" : "+v"(tr[0][0]), "+v"(tr[0][1]), "+v"(tr[0][2]), "+v"(tr[0][3]), "+v"(tr[0][4]), "+v"(tr[0][5]), "+v"(tr[0][6]), "+v"(tr[0][7]), \
                                              "+v"(tr[1][0]), "+v"(tr[1][1]), "+v"(tr[1][2]), "+v"(tr[1][3]), "+v"(tr[1][4]), "+v"(tr[1][5]), "+v"(tr[1][6]), "+v"(tr[1][7]) :: "memory"); \
        _Pragma("unroll") for (int c = 0; c < 8; ++c) { u32x4 bw; bw.x = tr[0][c].x; bw.y = tr[0][c].y; bw.z = tr[1][c].x; bw.w = tr[1][c].y; \
            o[c] = mfma16(pf, __builtin_bit_cast(bf16x8, bw), o[c]); } \
        ol = mfma16(pf, ones, ol); \
    } while (0)
    DSA_GATHER(grA, 0); DSA_GATHER(grB, 1);
    MEMFENCE();
    const int ntp = (tq >> 6) < 3 ? (tq >> 6) + 1 : 4;
#pragma unroll 1
    for (int tp = 0; tp < ntp; ++tp) { DSA_TILE(2 * tp, grA); DSA_TILE(2 * tp + 1, grB); }
#undef DSA_TILE
#undef DSA_GATHER
    if (g < 2) {
        bf16* olat = ql;
        f32x4 ir;
#pragma unroll
        for (int i = 0; i < 4; ++i) ir[i] = 1.0f / ol[i];
#pragma unroll
        for (int c = 0; c < 8; ++c) { const f32x4 y = o[c] * ir;
#pragma unroll
            for (int i = 0; i < 4; ++i) olat[(4 * g + i) * 128 + 16 * c + hd] = f2bf(y[i]); }
    }
}

__device__ const unsigned short c_diff_tab[1024] = {
    995,999,1003,1007,1011,1015,1019,1023,963,967,971,975,979,983,987,991,931,935,939,943,947,951,955,959,899,903,907,911,915,919,923,927,
    867,871,875,879,883,887,891,895,835,839,843,847,851,855,859,863,803,807,811,815,819,823,827,831,771,775,779,783,787,791,795,799,
    739,743,747,751,755,759,763,767,707,711,715,719,723,727,731,735,675,679,683,687,691,695,699,703,643,647,651,655,659,663,667,671,
    611,615,619,623,627,631,635,639,579,583,587,591,595,599,603,607,994,998,1002,1006,1010,1014,1018,1022,962,966,970,974,978,982,986,990,
    930,934,938,942,946,950,954,958,547,551,555,559,563,567,571,575,898,902,906,910,914,918,922,926,866,870,874,878,882,886,890,894,
    834,838,842,846,850,854,858,862,802,806,810,814,818,822,826,830,515,519,523,527,531,535,539,543,770,774,778,782,786,790,794,798,
    738,742,746,750,754,758,762,766,706,710,714,718,722,726,730,734,674,678,682,686,690,694,698,702,483,487,491,495,499,503,507,511,
    642,646,650,654,658,662,666,670,610,614,618,622,626,630,634,638,578,582,586,590,594,598,602,606,546,550,554,558,562,566,570,574,
    479,475,471,467,463,459,455,451,542,538,534,530,526,522,518,514,510,506,502,498,494,490,486,482,478,474,470,466,462,458,454,450,
    431,430,427,426,423,422,419,418,447,446,443,442,439,438,435,434,399,398,395,394,391,390,387,386,415,414,411,410,407,406,403,402,
    367,366,363,362,359,358,355,354,383,382,379,378,375,374,371,370,335,334,331,330,327,326,323,322,351,350,347,346,343,342,339,338,
    1021,1017,1013,1009,1005,1001,997,993,989,985,981,977,973,969,965,961,957,953,949,945,941,937,933,929,925,921,917,913,909,905,901,897,
    303,302,299,298,295,294,291,290,319,318,315,314,311,310,307,306,893,889,885,881,877,873,869,865,861,857,853,849,845,841,837,833,
    829,825,821,817,813,809,805,801,797,793,789,785,781,777,773,769,271,270,267,266,263,262,259,258,287,286,283,282,279,278,275,274,
    1020,1016,1012,1008,1004,1000,996,992,765,761,757,753,749,745,741,737,988,984,980,976,972,968,964,960,733,729,725,721,717,713,709,705,
    828,824,820,816,812,808,804,800,223,222,219,218,215,214,211,210,413,409,405,401,397,393,389,385,191,190,187,186,183,182,179,178,
    33,34,35,37,38,39,41,42,192,196,200,204,208,212,216,220,86,87,89,90,91,93,94,95,512,516,520,524,528,532,536,540,
    161,165,169,173,177,181,185,189,544,548,552,556,560,564,568,572,321,325,329,333,337,341,345,349,576,580,584,588,592,596,600,604,
    353,357,361,365,369,373,377,381,608,612,616,620,624,628,632,636,162,163,166,167,170,171,174,175,449,453,457,461,465,469,473,477,
    513,517,521,525,529,533,537,541,832,836,840,844,848,852,856,860,609,613,617,621,625,629,633,637,641,645,649,653,657,661,665,669,
    673,677,681,685,689,693,697,701,896,900,904,908,912,916,920,924,242,243,246,247,250,251,254,255,864,868,872,876,880,884,888,892,
    226,227,230,231,234,235,238,239,928,932,936,940,944,948,952,956,545,549,553,557,561,565,569,573,577,581,585,589,593,597,601,605,
    194,195,198,199,202,203,206,207,768,772,776,780,784,788,792,796,481,485,489,493,497,501,505,509,736,740,744,748,752,756,760,764,
    672,676,680,684,688,692,696,700,417,421,425,429,433,437,441,445,640,644,648,652,656,660,664,668,704,708,712,716,720,724,728,732,
    74,73,71,70,69,67,66,65,157,153,149,145,141,137,133,129,348,344,340,336,332,328,324,320,316,312,308,304,300,296,292,288,
    85,83,82,81,79,78,77,75,252,248,244,240,236,232,228,224,380,376,372,368,364,360,356,352,125,121,117,113,109,105,101,97,
    444,440,436,432,428,424,420,416,317,313,309,305,301,297,293,289,127,126,123,122,119,118,115,114,143,142,139,138,135,134,131,130,
    285,281,277,273,269,265,261,257,221,217,213,209,205,201,197,193,476,472,468,464,460,456,452,448,412,408,404,400,396,392,388,384,
    253,249,245,241,237,233,229,225,508,504,500,496,492,488,484,480,159,158,155,154,151,150,147,146,111,110,107,106,103,102,99,98,
    284,280,276,272,268,264,260,256,188,184,180,176,172,168,164,160,156,152,148,144,140,136,132,128,53,51,50,49,47,46,45,43,
    63,62,61,59,58,57,55,54,7,6,5,4,3,2,1,0,23,22,21,20,19,18,17,16,15,14,13,12,11,10,9,8,
    31,30,29,28,27,26,25,24,60,56,52,48,44,40,36,32,124,120,116,112,108,104,100,96,92,88,84,80,76,72,68,64,
};

__device__ const unsigned char c_diff_ub[128] = {
    31,30,29,28,27,26,25,24,23,22,21,20,19,18,17,16,15,14,13,12,11,10,9,8,7,6,5,4,3,2,1,0,
    0,1,2,3,4,5,6,7,8,9,10,11,12,13,14,15,16,17,18,19,20,21,22,23,24,25,26,27,28,29,30,31,
    13,12,11,10,9,8,7,6,5,4,3,2,1,0,14,15,16,17,18,19,20,21,22,23,24,25,26,27,28,29,30,31,
    0,1,3,4,6,7,9,10,12,13,15,18,21,24,2,5,8,11,14,16,17,19,20,22,23,25,26,27,28,29,30,31,
};

struct Args { const float* in[31]; float* out; unsigned char* ws; int ph_lo, ph_hi, l_lo, l_hi, c_lo, c_hi, use_bar, pad; };
enum Phase { P_PRO0 = 0, P_PRO1, P_CVT, P_WIN, P_CKVN, P_ATTN, P_DIFF, P_WO, P_LN1, P_WQ, P_MEMATT, P_WMO, P_LN2, P_RGEMM, P_ROUTE, P_GU, P_DN, P_COMB, P_NUM };

struct Frame {
    LAS unsigned char* lds;
    int wave, G, vcu;
};


constexpr int CVT_SCR_BYTES = 64 * 65 * 4;
__device__ __forceinline__ void transpose_item(const float* W, int ldw, int K, int nvalid, bf16* WT, LAS float* scr, int kb, int nb, int lane) {
    const int k0 = 64 * kb, n0 = 64 * nb, r4 = lane >> 4, c4 = lane & 15;
    const bool ok = (n0 + 4 * c4) < nvalid;
    f32x4 v[16];
    const float* src = W + (size_t)(k0 + r4) * ldw + n0 + 4 * c4;
#pragma unroll
    for (int i = 0; i < 16; ++i) v[i] = ok ? *(const f32x4*)(src + (size_t)(4 * i) * ldw) : (f32x4){0.f, 0.f, 0.f, 0.f};
#pragma unroll
    for (int i = 0; i < 16; ++i) { LAS float* d = scr + (4 * i + r4) * 65 + 4 * c4; d[0] = v[i][0]; d[1] = v[i][1]; d[2] = v[i][2]; d[3] = v[i][3]; }
    LDS_WAIT(); asm volatile("" ::: "memory");
    const int c = lane & 7;
#pragma unroll
    for (int j = 0; j < 8; ++j) { const int n = (lane >> 3) + 8 * j; const LAS float* sp = scr + (8 * c) * 65 + n;
        u32x4 o; o.x = cvt_pk_bf16(sp[0 * 65], sp[1 * 65]); o.y = cvt_pk_bf16(sp[2 * 65], sp[3 * 65]); o.z = cvt_pk_bf16(sp[4 * 65], sp[5 * 65]); o.w = cvt_pk_bf16(sp[6 * 65], sp[7 * 65]);
        *(u32x4*)(WT + (size_t)(n0 + n) * K + k0 + 8 * c) = o; }
    LDS_WAIT(); asm volatile("" ::: "memory");
}
__device__ __forceinline__ void cvt_job(const float* W, int ldw, int K, int ncols, int nvalid, bf16* WT, LAS float* scr, int item, int lane) {
    const int nblk = ncols / 64; transpose_item(W, ldw, K, nvalid, WT, scr, item / nblk, item % nblk, lane);
}

__device__ __forceinline__ void cvt_layer_item(const Args& a, int l, unsigned char* wb, LAS float* scr, int it, int lane) {
    const float* src; int ldw, K = D, ncols, nvalid; size_t dst;
    if (it < 640) { const int seg = it >> 7; const int srcc = (seg == 0) ? 0 : (seg == 1) ? 640 : (seg == 2) ? 1224 : (seg == 3) ? 1736 : 2248;
        src = a.in[4] + (size_t)l * D * WIN_COLS + srcc; ldw = WIN_COLS; ncols = 512; nvalid = 512; dst = WB_WIN + (size_t)(seg < 4 ? seg * 512 : 2304) * D * 2; it &= 127; }
    else if (it < 672) { src = a.in[4] + (size_t)l * D * WIN_COLS + 512; ldw = WIN_COLS; ncols = 128; nvalid = 128; dst = WB_WIN + (size_t)2048 * D * 2; it -= 640; }
    else if (it < 688) { src = a.in[4] + (size_t)l * D * WIN_COLS + 1152; ldw = WIN_COLS; ncols = 64; nvalid = 64; dst = WB_WIN + (size_t)2176 * D * 2; it -= 672; }
    else if (it < 704) { src = a.in[4] + (size_t)l * D * WIN_COLS + 1216; ldw = WIN_COLS; ncols = 64; nvalid = 8; dst = WB_WIN + (size_t)2240 * D * 2; it -= 688; }
    else if (it < 960) { src = a.in[13] + (size_t)l * D * D; ldw = D; ncols = D; nvalid = D; dst = WB_WO; it -= 704; }
    else if (it < 1216) { src = a.in[16] + (size_t)l * D * D; ldw = D; ncols = D; nvalid = D; dst = WB_WQ; it -= 960; }
    else if (it < 1472) { src = a.in[18] + (size_t)l * D * D; ldw = D; ncols = D; nvalid = D; dst = WB_WMO; it -= 1216; }
    else if (it < 1600) { it -= 1472; const int sub = it >> 5, up = sub & 1, t = sub >> 1;
        src = (up ? a.in[27] : a.in[26]) + (size_t)l * D * SH_DIM + 128 * t; ldw = SH_DIM; ncols = 128; nvalid = 128; dst = WB_SGU + (size_t)(256 * t + 128 * up) * D * 2; it &= 31; }
    else if (it < 1664) { src = a.in[28] + (size_t)l * SH_DIM * D; ldw = D; K = SH_DIM; ncols = D; nvalid = D; dst = WB_SD; it -= 1600; }
    else if (it < 1664 + 8192) { it -= 1664; const int e = it >> 7, sub = (it >> 5) & 3, up = sub & 1, t = sub >> 1;
        src = (up ? a.in[24] : a.in[23]) + ((size_t)l * N_EXP + e) * D * EXP_DIM + 128 * t; ldw = EXP_DIM; ncols = 128; nvalid = 128; dst = WB_GU + ((size_t)e * 512 + 256 * t + 128 * up) * D * 2; it &= 31; }
    else if (it < 1664 + 8192 + 4096) { it -= 1664 + 8192; const int e = it >> 6;
        src = a.in[25] + ((size_t)l * N_EXP + e) * EXP_DIM * D; ldw = D; K = EXP_DIM; ncols = D; nvalid = D; dst = WB_DN + (size_t)e * D * EXP_DIM * 2; it &= 63; }
    else if (it < 1664 + 8192 + 4096 + 16) { it -= 1664 + 8192 + 4096; const int hh = it >> 1;
        src = a.in[7] + ((size_t)l * A_HEADS + hh) * KV_LORA * 64; ldw = 64; K = KV_LORA; ncols = 64; nvalid = 64; dst = WB_UV + (size_t)hh * 64 * KV_LORA * 2; it &= 1; }
    else { it -= 1664 + 8192 + 4096 + 16;
        src = a.in[21] + (size_t)l * D * N_EXP; ldw = N_EXP; ncols = 256; nvalid = N_EXP; dst = WB_RW; }
    cvt_job(src, ldw, K, ncols, nvalid, (bf16*)(wb + dst), scr, it, lane);
}
constexpr int CVT_LAYER_ITEMS = 1664 + 8192 + 4096 + 16 + 64;

__device__ __forceinline__ void ln_row(const float* xrow, const float* g, const float* b, float* hrow, bf16* orow, int lane) {
    f32x4 v[4]; float s = 0.f;
#pragma unroll
    for (int j = 0; j < 4; ++j) { v[j] = *((const f32x4*)xrow + lane + 64 * j); s += (v[j][0] + v[j][1]) + (v[j][2] + v[j][3]); }
    const float mean = wsum(s, lane) * (1.f / D); float s2 = 0.f;
#pragma unroll
    for (int j = 0; j < 4; ++j) { v[j] = v[j] - mean; s2 += (v[j][0] * v[j][0] + v[j][1] * v[j][1]) + (v[j][2] * v[j][2] + v[j][3] * v[j][3]); }
    const float rstd = 1.f / sqrtf(wsum(s2, lane) * (1.f / D) + LN_EPS);
#pragma unroll
    for (int j = 0; j < 4; ++j) { const f32x4 gg = *((const f32x4*)g + lane + 64 * j), bb = *((const f32x4*)b + lane + 64 * j);
        const f32x4 o = v[j] * rstd * gg + bb; if (hrow) *((f32x4*)hrow + lane + 64 * j) = o;
        u32x2 w; w.x = pk2(o[0], o[1]); w.y = pk2(o[2], o[3]); *((u32x2*)orow + lane + 64 * j) = w; }
}


__device__ __forceinline__ void add_bf16x4(f32x4& v, const u32x2 y) { v[0] += __uint_as_float(y.x << 16); v[1] += __uint_as_float(y.x & 0xffff0000u); v[2] += __uint_as_float(y.y << 16); v[3] += __uint_as_float(y.y & 0xffff0000u); }
__device__ __forceinline__ void acc_bf16x8(float (&v)[8], const u32x4 y, float sc) {
    v[0] += sc * __uint_as_float(y.x << 16); v[1] += sc * __uint_as_float(y.x & 0xffff0000u); v[2] += sc * __uint_as_float(y.y << 16); v[3] += sc * __uint_as_float(y.y & 0xffff0000u);
    v[4] += sc * __uint_as_float(y.z << 16); v[5] += sc * __uint_as_float(y.z & 0xffff0000u); v[6] += sc * __uint_as_float(y.w << 16); v[7] += sc * __uint_as_float(y.w & 0xffff0000u);
}
template <int NR, bool HAS_Y, bool HAS_X, bool HAS_SLOTS>
__device__ __forceinline__ void ln_res_rows(const bf16* hrow, size_t hstride, const bf16* yrow, size_t ystride, const bf16* xrow, size_t xstride, const bf16* slots, size_t sstride,
                                            float alpha, const float* g, const float* b, bf16* orow, size_t ostride, float* fout, size_t fstride, int lane) {
    u32x4 hv[NR][2], yv[NR][2], xv[NR][2], sv[NR][HAS_SLOTS ? 8 : 1][2];
#pragma unroll
    for (int r = 0; r < NR; ++r)
#pragma unroll
        for (int c = 0; c < 2; ++c) { const int e = 8 * lane + 512 * c;
            hv[r][c] = *(const u32x4*)(hrow + r * hstride + e);
            if (HAS_Y) yv[r][c] = *(const u32x4*)(yrow + r * ystride + e);
            if (HAS_X) xv[r][c] = *(const u32x4*)(xrow + r * xstride + e);
            if (HAS_SLOTS) {
#pragma unroll
                for (int k = 0; k < 8; ++k) sv[r][k][c] = *(const u32x4*)(slots + r * sstride + (size_t)k * D + e); } }
    MEMFENCE();
    float v[NR][2][8], mean[NR], rstd[NR];
#pragma unroll
    for (int r = 0; r < NR; ++r) { float s = 0.f;
#pragma unroll
        for (int c = 0; c < 2; ++c) {
#pragma unroll
            for (int i = 0; i < 8; ++i) v[r][c][i] = 0.f;
            acc_bf16x8(v[r][c], hv[r][c], alpha);
            if (HAS_Y) acc_bf16x8(v[r][c], yv[r][c], 1.0f);
            if (HAS_X) acc_bf16x8(v[r][c], xv[r][c], 1.0f);
            if (HAS_SLOTS) {
#pragma unroll
                for (int k = 0; k < 8; ++k) acc_bf16x8(v[r][c], sv[r][k][c], 1.0f); }
#pragma unroll
            for (int i = 0; i < 8; ++i) s += v[r][c][i]; }
        mean[r] = s; }
#pragma unroll
    for (int r = 0; r < NR; ++r) mean[r] = wave_total(mean[r]);
#pragma unroll
    for (int r = 0; r < NR; ++r) { mean[r] *= (1.f / D); float q = 0.f;
#pragma unroll
        for (int c = 0; c < 2; ++c)
#pragma unroll
            for (int i = 0; i < 8; ++i) { v[r][c][i] -= mean[r]; q += v[r][c][i] * v[r][c][i]; }
        rstd[r] = q; }
#pragma unroll
    for (int r = 0; r < NR; ++r) rstd[r] = wave_total(rstd[r]);
#pragma unroll
    for (int c = 0; c < 2; ++c) { const int e = 8 * lane + 512 * c;
        const f32x4 g0 = *(const f32x4*)(g + e), g1 = *(const f32x4*)(g + e + 4), b0 = *(const f32x4*)(b + e), b1 = *(const f32x4*)(b + e + 4);
#pragma unroll
        for (int r = 0; r < NR; ++r) { const float rs = 1.f / sqrtf(rstd[r] * (1.f / D) + LN_EPS);
            f32x4 o0, o1;
#pragma unroll
            for (int i = 0; i < 4; ++i) { o0[i] = v[r][c][i] * rs * g0[i] + b0[i]; o1[i] = v[r][c][4 + i] * rs * g1[i] + b1[i]; }
            if (fout) { *(f32x4*)(fout + r * fstride + e) = o0; *(f32x4*)(fout + r * fstride + e + 4) = o1; }
            else { u32x4 w; w.x = cvt_pk_bf16(o0[0], o0[1]); w.y = cvt_pk_bf16(o0[2], o0[3]); w.z = cvt_pk_bf16(o1[0], o1[1]); w.w = cvt_pk_bf16(o1[2], o1[3]);
                *(u32x4*)(orow + r * ostride + e) = w; } } }
}

__global__ void __launch_bounds__(NTHR, 2) mk_fwd(Args a) {
    extern __shared__ __attribute__((aligned(16))) unsigned char lds_raw[];
    Frame F;
    F.lds = (LAS unsigned char*)lds_raw;
    F.wave = __builtin_amdgcn_readfirstlane(threadIdx.x >> 6);
    F.G = gridDim.x; { const int bx = blockIdx.x; F.vcu = (F.G % 8 == 0) ? (bx % 8) * (F.G / 8) + bx / 8 : bx; }
    volatile LAS unsigned* MISC = (volatile LAS unsigned*)(F.lds + LDS_MISC);
    if (threadIdx.x < 32) MISC[threadIdx.x] = 0u;
    __syncthreads();
    XcdBarrier bar; bar.bar = (unsigned*)(a.ws + WS_CTL) + CW_BAR; bar.x = 0; bar.st = MISC + 8;
    if (a.use_bar) bar = xcd_barrier_post((unsigned*)(a.ws + WS_CTL) + CW_BAR, MISC + 8);
#define GRID_BAR() do { if (a.use_bar) xcd_barrier(bar, F.wave); } while (0)
#define IN(k) (a.ph_lo <= (k) && (k) < a.ph_hi)
#define PHASE_BASES() GAS unsigned char* wsg_ = (GAS unsigned char*)a.ws; asm volatile("" : "+s"(wsg_)); unsigned char* ws = (unsigned char*)wsg_; GAS float* hg_ = (GAS float*)a.out; asm volatile("" : "+s"(hg_)); float* H = (float*)hg_; bf16* HB = (bf16*)(ws + WS_HB); (void)H; (void)HB
    const int gw = F.vcu * NWAVES + F.wave, NGW = F.G * NWAVES;
    LAS float* scr = (LAS float*)(F.lds + LDS_STAGE + F.wave * CVT_SCR_BYTES);

    if (IN(P_PRO0)) {
        PHASE_BASES();
        { const int lane = lane_id();
          f32x4 gg[4], bb[4];
#pragma unroll
          for (int j = 0; j < 4; ++j) { gg[j] = *((const f32x4*)a.in[2] + lane + 64 * j); bb[j] = *((const f32x4*)a.in[3] + lane + 64 * j); }
          for (int m = gw; m < NTOK; m += 2 * NGW) {
              f32x4 v[2][4]; float s[2];
#pragma unroll
              for (int u = 0; u < 2; ++u) { const int row = m + u * NGW < NTOK ? m + u * NGW : m; s[u] = 0.f;
#pragma unroll
                  for (int j = 0; j < 4; ++j) { v[u][j] = *((const f32x4*)(a.in[0] + (size_t)row * D) + lane + 64 * j); s[u] += (v[u][j][0] + v[u][j][1]) + (v[u][j][2] + v[u][j][3]); } }
#pragma unroll
              for (int u = 0; u < 2; ++u) { const float mean = wave_total(s[u]) * (1.f / D); float s2 = 0.f;
#pragma unroll
                  for (int j = 0; j < 4; ++j) { v[u][j] = v[u][j] - mean; s2 += (v[u][j][0] * v[u][j][0] + v[u][j][1] * v[u][j][1]) + (v[u][j][2] * v[u][j][2] + v[u][j][3] * v[u][j][3]); }
                  s[u] = s2; }
#pragma unroll
              for (int u = 0; u < 2; ++u) { const int row = m + u * NGW; const float rstd = 1.f / sqrtf(wave_total(s[u]) * (1.f / D) + LN_EPS);
                  if (row < NTOK) {
#pragma unroll
                      for (int j = 0; j < 4; ++j) { const f32x4 o = v[u][j] * rstd * gg[j] + bb[j]; u32x2 w; w.x = pk2(o[0], o[1]); w.y = pk2(o[2], o[3]); *((u32x2*)(HB + (size_t)row * D) + lane + 64 * j) = w; } } }
          } }
        { bf16* MEMB = (bf16*)(ws + WS_MEMB); const float* mem = a.in[1];
          for (size_t i = ((size_t)blockIdx.x * NTHR + F.wave * 64 + lane_id()) * 4; i < (size_t)BATCH * MEM_TOK * D; i += (size_t)F.G * NTHR * 4) { const f32x4 v = *(const f32x4*)(mem + i); u32x2 w; w.x = pk2(v[0], v[1]); w.y = pk2(v[2], v[3]); *(u32x2*)(MEMB + i) = w; } }
        for (int it = gw; it < 1024; it += NGW) { const int l = it >> 9, v = (it >> 8) & 1, r = it & 255;
            cvt_job(a.in[17] + (size_t)l * D * 2048 + 1024 * v, 2048, D, D, D, (bf16*)(ws + (v ? WS_WVT : WS_WKT) + (size_t)l * 4 * MiB), scr, r, lane_id()); }
    }
#pragma unroll
    for (int l = 0; l < DEPTH; ++l) { if (l < a.l_lo || l >= a.l_hi) continue;
        if (IN(P_CVT)) {
            PHASE_BASES(); unsigned char* wb = ws + WS_WB;
            for (int it = gw; it < CVT_LAYER_ITEMS; it += NGW) cvt_layer_item(a, l, wb, scr, it, lane_id());
            { const float* wuk = a.in[6] + (size_t)l * A_HEADS * KV_LORA * 64; bf16* o = (bf16*)(wb + WB_UK);
              for (int i = (gw * 64 + lane_id()) * 4; i < A_HEADS * KV_LORA * 64; i += NGW * 64 * 4) { const f32x4 v = *(const f32x4*)(wuk + i); u32x2 w; w.x = pk2(v[0], v[1]); w.y = pk2(v[2], v[3]); *(u32x2*)(o + i) = w; } }
            GRID_BAR();
        }
        if (IN(P_WIN)) {
            PHASE_BASES(); unsigned char* wb = ws + WS_WB;
            pg8::Gemm g{HB, (const bf16*)(wb + WB_WIN), D, 0, 0}; pg8::DenseOrder S; S.init(NTOK, WIN_PAD, 1, F.G, (int)blockIdx.x);
            pg8::EpiProjMk E{(bf16*)(ws + WS_PROJ5), (bf16*)(ws + WS_MISC10), (float*)(ws + WS_WIDX), (bf16*)(ws + WS_SEL)};
            pg8::gemm_phase<pg8::EpiProjMk, pg8::DenseOrder, false>(F.lds + LDS_STAGE, g, S, E, nullptr, F.wave);
            { pg8::Gemm g2{(const bf16*)(wb + WB_WIN) + (size_t)2304 * D, HB, D, 0, 0}; pg8::DenseOrder S2; S2.init(512, NTOK, 1, F.G, (int)((blockIdx.x + 128) % F.G));
              pg8::EpiVT E2{(bf16*)(ws + WS_VTD), VTD_LD, 0};
              pg8::gemm_phase<pg8::EpiVT, pg8::DenseOrder, false>(F.lds + LDS_STAGE, g2, S2, E2, nullptr, F.wave); }
            if (l == 0) {
                { pg8::Gemm g3{(const bf16*)(ws + WS_MEMB), (const bf16*)(ws + WS_WKT), D, 0, (size_t)2 * MiB}; pg8::DenseOrder S3; S3.init(2048, 1024, DEPTH, F.G, (int)((blockIdx.x + F.G / 2) % F.G));
                  pg8::EpiBf16 E3{(bf16*)(ws + WS_KM), KM_LD, (size_t)2048 * KM_LD, 0, 0};
                  pg8::gemm_phase<pg8::EpiBf16, pg8::DenseOrder, false>(F.lds + LDS_STAGE, g3, S3, E3, nullptr, F.wave); }
                { pg8::Gemm g4{(const bf16*)(ws + WS_WVT), (const bf16*)(ws + WS_MEMB), D, (size_t)2 * MiB, 0}; pg8::DenseOrder S4; S4.init(1024, 2048, DEPTH, F.G, (int)((blockIdx.x + F.G / 4) % F.G));
                  pg8::EpiVT E4{(bf16*)(ws + WS_VTM), VTM_LD, (size_t)1024 * VTM_LD};
                  pg8::gemm_phase<pg8::EpiVT, pg8::DenseOrder, false>(F.lds + LDS_STAGE, g4, S4, E4, nullptr, F.wave); }
            }
            GRID_BAR();
        }
        if (IN(P_CKVN)) {
            PHASE_BASES();
            const int lane = lane_id();
            const bf16* MISCp = (const bf16*)(ws + WS_MISC10); bf16* CKVp = (bf16*)(ws + WS_CKV); const float* gn = a.in[5] + l * KV_LORA;
            const float g0 = gn[lane], g1 = gn[64 + lane];
            for (int row0 = gw; row0 < NTOK; row0 += 4 * NGW) {
                float x0[4], x1[4];
#pragma unroll
                for (int u = 0; u < 4; ++u) { const int row = row0 + u * NGW < NTOK ? row0 + u * NGW : row0; x0[u] = bf2f(MISCp[(size_t)row * 256 + lane]); x1[u] = bf2f(MISCp[(size_t)row * 256 + 64 + lane]); }
#pragma unroll
                for (int u = 0; u < 4; ++u) { const int row = row0 + u * NGW;
                    const float r = 1.0f / sqrtf(wsum(x0[u] * x0[u] + x1[u] * x1[u], lane) * (1.f / KV_LORA) + RMS_EPS);
                    if (row < NTOK) { CKVp[(size_t)row * 128 + lane] = f2bf(x0[u] * r * g0); CKVp[(size_t)row * 128 + 64 + lane] = f2bf(x1[u] * r * g1); } }
            }
            GRID_BAR();
        }
#pragma unroll 1
        for (int apass = 0; apass < 2; ++apass) { const int awhich = apass ^ (((int)blockIdx.x >> 3) & 1);
        if (awhich == 0 && IN(P_ATTN)) {
            PHASE_BASES(); unsigned char* wb = ws + WS_WB;
            const int w = F.wave;
            LAS float* SC = (LAS float*)(F.lds + TK_SC); LAS bf16* QL = (LAS bf16*)(F.lds + TK_QL); LAS unsigned short* SEL = (LAS unsigned short*)(F.lds + TK_SEL);
            LAS unsigned* HIST = (LAS unsigned*)(F.lds + TK_HIST); LAS unsigned* MM = (LAS unsigned*)(F.lds + TK_MM);
            const size_t PS = (size_t)NTOK * 512;
            const bf16* QA = (const bf16*)(ws + WS_PROJ5); const bf16* QIDX = QA + PS; const float* WIDXp = (const float*)(ws + WS_WIDX);
            const bf16* WUK = (const bf16*)(wb + WB_UK); const bf16* WUVT = (const bf16*)(wb + WB_UV);
            bf16* CATp = (bf16*)(ws + WS_CAT);
            const brsrc_t rM = make_rsrc(ws + WS_SEL, (unsigned)((size_t)NTOK * 128)), rC = make_rsrc(ws + WS_CKV, (unsigned)((size_t)NTOK * 256));
            const int NIT = (4096 + F.G - 1) / F.G;
            bf16* QLAT = (bf16*)(ws + WS_Y);
#define ATTN_UNIT_IDX(it_) ((it_) * F.G + (((it_) & 1) ? (F.G - 1 - (int)blockIdx.x) : (int)blockIdx.x))
            { const int lane = lane_id(), hd = lane & 15, g = lane >> 4;
              bf16x8 wkn[16];
#pragma unroll
              for (int nt = 0; nt < 8; ++nt) { const bf16* wr = WUK + (size_t)(w * 128 + 16 * nt + hd) * 64 + 8 * g; wkn[2 * nt] = *(const bf16x8*)wr; wkn[2 * nt + 1] = *(const bf16x8*)(wr + 32); }
#pragma unroll 1
              for (int ib = 0; ib < NIT; ib += 8) {
                  bf16x8 qa[8][2];
#pragma unroll
                  for (int u = 0; u < 8; ++u) { const int idxu = (ib + u) < NIT ? ATTN_UNIT_IDX(ib + u) : 4096; const int idc = idxu < 4096 ? idxu : 0;
                      const bf16* qrow = QA + (size_t)((idc & 7) * SEQ + 8 * (511 - (idc >> 3)) + (hd & 7)) * 512 + w * 64 + 8 * g; qa[u][0] = *(const bf16x8*)qrow; qa[u][1] = *(const bf16x8*)(qrow + 32); }
#pragma unroll
                  for (int u = 0; u < 8; ++u) { const int idxu = (ib + u) < NIT ? ATTN_UNIT_IDX(ib + u) : 4096;
                      if (idxu < 4096) { bf16* qo = QLAT + (size_t)((idxu & 7) * SEQ + 8 * (511 - (idxu >> 3)) + (hd & 7)) * D + w * 128 + 4 * g;
#pragma unroll
                          for (int nt = 0; nt < 8; ++nt) { f32x4 acc = mfma16(wkn[2 * nt], qa[u][0], (f32x4){0.f, 0.f, 0.f, 0.f}); acc = mfma16(wkn[2 * nt + 1], qa[u][1], acc);
                              if (hd < 8) { u32x2 pk; pk.x = pk2(acc[0], acc[1]); pk.y = pk2(acc[2], acc[3]); *(u32x2*)(qo + 16 * nt) = pk; } } } } }
              const int tidp = w * 64 + lane; if (tidp < 8) MM[tidp] = 0u; else if (tidp < 16) MM[tidp] = 0xFFFFFFFFu; }
            __syncthreads();
#pragma unroll 1
            for (int it = 0; it < NIT; ++it) {
                LAS unsigned* MMt = MM + 16 * (it & 1);
                const int idx = ATTN_UNIT_IDX(it);
                const bool do4 = idx < 4096;
                const int qt = 511 - (idx >> 3), bb = idx & 7, tq0 = 8 * qt, tok0 = bb * SEQ + tq0, n = ((tq0 >> 6) + 1) * 64;
                if (do4) {
#ifndef REP_S1
#define REP_S1 1
#endif
#pragma unroll 1
                for (int rep1 = 0; rep1 < REP_S1; ++rep1)
                if (n > TOPK) {
                    const int lane = lane_id();
                    const int r = lane & 31, hi = lane >> 5, qq = 2 * ((r >> 2) & 1) + (r >> 4), hh = 4 * ((r >> 3) & 1) + (r & 3);
                    bf16x8 af[2][4]; float wq[2][16];
#pragma unroll
                    for (int rt = 0; rt < 2; ++rt) { const bf16* ar = QIDX + (size_t)(tok0 + 4 * rt + qq) * 512 + hh * 64 + 8 * hi;
#pragma unroll
                        for (int s4 = 0; s4 < 4; ++s4) af[rt][s4] = *(const bf16x8*)(ar + 16 * s4);
#pragma unroll
                        for (int i = 0; i < 16; ++i) wq[rt][i] = WIDXp[(size_t)(tok0 + 4 * rt + 2 * hi + (i >> 3)) * 8 + 4 * ((i >> 2) & 1) + (i & 3)] * 0.125f; }
                    float vmax[2][2], vmin[2][2];
#pragma unroll
                    for (int rt = 0; rt < 2; ++rt)
#pragma unroll
                        for (int u = 0; u < 2; ++u) { vmax[rt][u] = -3.0e38f; vmin[rt][u] = 3.0e38f; }
                    const unsigned kvo = (unsigned)(lane * 16);
                    const int ntile = n >> 5;
                    bf16x8 bqA[4], bqB[4];
#define IDX_LOAD(BQ, kt_) do { const int nk_ = (kt_) < ntile ? (kt_) : w; const unsigned so_ = (unsigned)(bb * 128 + nk_) * 4096u; \
                        _Pragma("unroll") for (int s4 = 0; s4 < 4; ++s4) BQ[s4] = bld16(rM, kvo + 1024 * s4, so_); } while (0)
#define IDX_TILE(BQ, kt_) do { \
                        f32x16v acc0, acc1; \
                        _Pragma("unroll") for (int i = 0; i < 16; ++i) { acc0[i] = 0.f; acc1[i] = 0.f; } \
                        _Pragma("unroll") for (int s4 = 0; s4 < 4; ++s4) { acc0 = __builtin_amdgcn_mfma_f32_32x32x16_bf16(af[0][s4], BQ[s4], acc0, 0, 0, 0); acc1 = __builtin_amdgcn_mfma_f32_32x32x16_bf16(af[1][s4], BQ[s4], acc1, 0, 0, 0); } \
                        asm volatile("" : "+v"(acc0), "+v"(acc1) :: "memory");     \
                        IDX_LOAD(BQ, (kt_) + 2 * NWAVES); \
                        MEMFENCE(); \
                        float sc4[2][2] = {{0.f, 0.f}, {0.f, 0.f}}; \
                        _Pragma("unroll") for (int i = 0; i < 16; ++i) { sc4[0][i >> 3] = __builtin_fmaf(wq[0][i], relu_f(acc0[i]), sc4[0][i >> 3]); sc4[1][i >> 3] = __builtin_fmaf(wq[1][i], relu_f(acc1[i]), sc4[1][i >> 3]); } \
                        _Pragma("unroll") for (int rt = 0; rt < 2; ++rt) _Pragma("unroll") for (int u = 0; u < 2; ++u) { const float v = sc4[rt][u]; SC[(4 * rt + 2 * hi + u) * 4096 + 32 * (kt_) + r] = v; vmax[rt][u] = fmaxf(vmax[rt][u], v); vmin[rt][u] = fminf(vmin[rt][u], v); } \
                    } while (0)
                    IDX_LOAD(bqA, w); IDX_LOAD(bqB, w + NWAVES);
                    MEMFENCE();
                    int kt = w;
#pragma unroll 1
                    for (; kt + NWAVES < ntile; kt += 2 * NWAVES) { IDX_TILE(bqA, kt); IDX_TILE(bqB, kt + NWAVES); }
                    if (kt < ntile) IDX_TILE(bqA, kt);
#undef IDX_TILE
#undef IDX_LOAD
#pragma unroll
                    for (int rt = 0; rt < 2; ++rt)
#pragma unroll
                        for (int u = 0; u < 2; ++u) { float a = vmax[rt][u], c = vmin[rt][u];
#define DPX(x, ctrl) __int_as_float(__builtin_amdgcn_update_dpp(__float_as_int(x), __float_as_int(x), ctrl, 0xf, 0xf, false))
                            a = fmaxf(a, DPX(a, 0xB1)); c = fminf(c, DPX(c, 0xB1)); a = fmaxf(a, DPX(a, 0x4E)); c = fminf(c, DPX(c, 0x4E));
                            a = fmaxf(a, DPX(a, 0x141)); c = fminf(c, DPX(c, 0x141)); a = fmaxf(a, DPX(a, 0x140)); c = fminf(c, DPX(c, 0x140));
#undef DPX
                            if ((r & 15) == 0) { atomicMax((unsigned*)(MMt + 4 * rt + 2 * hi + u), f2ord(a)); atomicMin((unsigned*)(MMt + 8 + 4 * rt + 2 * hi + u), f2ord(c)); } }
                }
                __syncthreads();
                { const int lane = lane_id();
                if (n <= TOPK) { for (int i = lane; i < TOPK; i += 64) SEL[w * 256 + i] = i < n ? (unsigned short)i : (unsigned short)0xFFFFu; }
                else { topk_select(SC + w * 4096, SEL + w * 256, HIST + w * 256, (LAS float*)(F.lds + TK_CAND + w * 256), (LAS unsigned*)(F.lds + TK_CAND + w * 256 + 128), ord2f(MMt[w]), ord2f(MMt[8 + w]), n, lane);
#if REP_S2X > 1
                    topk_select(SC + w * 4096, SEL + w * 256, HIST + w * 256, (LAS float*)(F.lds + TK_CAND + w * 256), (LAS unsigned*)(F.lds + TK_CAND + w * 256 + 128), ord2f(MMt[w]), ord2f(MMt[8 + w]), n, lane);
                    topk_select(SC + w * 4096, SEL + w * 256, HIST + w * 256, (LAS float*)(F.lds + TK_CAND + w * 256), (LAS unsigned*)(F.lds + TK_CAND + w * 256 + 128), ord2f(MMt[w]), ord2f(MMt[8 + w]), n, lane);
#endif
                }
                }
                dsa_attn_query(rC, SEL + w * 256, F.lds + TK_SC + w * 16384, QLAT + (size_t)(tok0 + w) * D, bb, tq0 + w);
#if REP_S3 > 1
                dsa_attn_query(rC, SEL + w * 256, F.lds + TK_SC + w * 16384, QLAT + (size_t)(tok0 + w) * D, bb, tq0 + w);
#endif
                }
                { const int tidp = w * 64 + lane_id(); LAS unsigned* MMn = MM + 16 * ((it + 1) & 1); if (tidp < 8) MMn[tidp] = 0u; else if (tidp < 16) MMn[tidp] = 0xFFFFFFFFu; }
                __syncthreads();
            }
            { const int lane = lane_id(), hd = lane & 15, g = lane >> 4;
              const brsrc_t rQ = make_rsrc(ws + WS_Y, (unsigned)((size_t)NTOK * D * 2));
              bf16x8 wv[4][4];
#pragma unroll
              for (int nt = 0; nt < 4; ++nt) { const bf16* wr = WUVT + (size_t)(w * 64 + 16 * nt + hd) * 128 + 8 * g;
#pragma unroll
                  for (int s4 = 0; s4 < 4; ++s4) wv[nt][s4] = *(const bf16x8*)(wr + 32 * s4); }
#pragma unroll 1
              for (int ib = 0; ib < NIT; ib += 4) {
                  bf16x8 ol[4][4];
#pragma unroll
                  for (int u = 0; u < 4; ++u) { const int idxu = (ib + u) < NIT ? ATTN_UNIT_IDX(ib + u) : 4096; const int idc = idxu < 4096 ? idxu : 0;
                      const unsigned oo = (unsigned)(((idc & 7) * SEQ + 8 * (511 - (idc >> 3)) + (hd & 7)) * D + w * 128 + 8 * g) * 2u;
#pragma unroll
                      for (int s4 = 0; s4 < 4; ++s4) ol[u][s4] = __builtin_bit_cast(bf16x8, __builtin_amdgcn_raw_buffer_load_b128(rQ, (int)(oo + 64u * s4), 0, 17)); }
#pragma unroll
                  for (int u = 0; u < 4; ++u) { const int idxu = (ib + u) < NIT ? ATTN_UNIT_IDX(ib + u) : 4096;
                      if (idxu < 4096) { bf16* co = CATp + (size_t)((idxu & 7) * SEQ + 8 * (511 - (idxu >> 3)) + (hd & 7)) * D + w * 64 + 4 * g;
#pragma unroll
                          for (int nt = 0; nt < 4; ++nt) { f32x4 acc = (f32x4){0.f, 0.f, 0.f, 0.f};
#pragma unroll
                              for (int s4 = 0; s4 < 4; ++s4) acc = mfma16(wv[nt][s4], ol[u][s4], acc);
                              if (hd < 8) { u32x2 pk; pk.x = pk2(acc[0], acc[1]); pk.y = pk2(acc[2], acc[3]); *(u32x2*)(co + 16 * nt) = pk; } } } } } }
#undef ATTN_UNIT_IDX
            __syncthreads();
        }
        if (awhich == 1 && IN(P_DIFF)) {
            PHASE_BASES();
            const int lane = lane_id();
            const float lambda_init = 0.8f - 0.6f * __expf(-0.3f * (float)l);
            const float d1 = wsum(a.in[8][l * 64 + lane] * a.in[9][l * 64 + lane], lane), d2 = wsum(a.in[10][l * 64 + lane] * a.in[11][l * 64 + lane], lane);
            const float lam = __expf(d1) - __expf(d2) + lambda_init;
            const size_t PS = (size_t)NTOK * 512;
            const bf16* PROJ5 = (const bf16*)(ws + WS_PROJ5);
            const brsrc_t rK = make_rsrc(PROJ5 + 3 * PS, (unsigned)(PS * 2)), rV = make_rsrc(ws + WS_VTD, (unsigned)(512u * VTD_LD * 2u));
#pragma unroll 1
            for (int i = 0; i < (1024 + F.G - 1) / F.G; ++i) {
                const int idx = i * F.G + ((i & 1) ? (F.G - 1 - (int)blockIdx.x) : (int)blockIdx.x);
                if (idx < 1024) { const int uid = c_diff_tab[idx]; int ub = uid >> 5, bb = (uid & 31) >> 2, hh = uid & 3;
                    if (F.G == 256) { bb = (int)blockIdx.x & 7; hh = 3 - i; ub = c_diff_ub[i * 32 + ((int)blockIdx.x >> 3)]; }
#if DIFF_V2
                    diff_attn_unit(F.lds + LDS_STAGE, PROJ5 + 2 * PS, PROJ5 + 3 * PS, (const bf16*)(ws + WS_VTD), (bf16*)(ws + WS_CAT), bb, hh, ub, F.wave, lam, lambda_init, a.in[12] + l * 128);
#else
                    diff_attn_wave(PROJ5 + 2 * PS, rK, rV, (bf16*)(ws + WS_CAT), bb, hh, 128 * ub + 16 * F.wave, lam, lambda_init, a.in[12] + l * 128, lane);
#endif
                }
            }
            __syncthreads();
        }
        }
        if (IN(P_ATTN) || IN(P_DIFF)) GRID_BAR();
        if (IN(P_WO)) {
            PHASE_BASES(); unsigned char* wb = ws + WS_WB;
            pg8::Gemm g{(const bf16*)(ws + WS_CAT), (const bf16*)(wb + WB_WO), D, 0, 0}; pg8::DenseOrder S; S.init(NTOK, D, 1, F.G, (int)blockIdx.x);
            pg8::EpiBf16 E{(bf16*)(ws + WS_Y), D, 0, 0, 0};
            pg8::gemm_phase<pg8::EpiBf16, pg8::DenseOrder, false>(F.lds + LDS_STAGE, g, S, E, nullptr, F.wave);
            GRID_BAR();
        }
        if (IN(P_LN1)) {
            PHASE_BASES();
            const int lane = lane_id(); const bf16* Y = (const bf16*)(ws + WS_Y);
            for (int row = gw; row < NTOK; row += 2 * NGW) ln_res_rows<2, true, false, false>(HB + (size_t)row * D, (size_t)NGW * D, Y + (size_t)row * D, (size_t)NGW * D, nullptr, 0, nullptr, 0, ALPHA, a.in[14] + l * D, a.in[15] + l * D, HB + (size_t)row * D, (size_t)NGW * D, nullptr, 0, lane);
            GRID_BAR();
        }
        if (IN(P_WQ)) {
            PHASE_BASES(); unsigned char* wb = ws + WS_WB;
            pg8::Gemm g{HB, (const bf16*)(wb + WB_WQ), D, 0, 0}; pg8::DenseOrder S; S.init(NTOK, D, 1, F.G, (int)blockIdx.x);
            pg8::EpiBf16 E{(bf16*)(ws + WS_QM), D, 0, 0, 0};
            pg8::gemm_phase<pg8::EpiBf16, pg8::DenseOrder, false>(F.lds + LDS_STAGE, g, S, E, nullptr, F.wave);
            asm volatile("s_waitcnt vmcnt(0)" ::: "memory");
            __syncthreads();
#pragma unroll 1
            for (int i = 0; ; ++i) { pg8::Unit u; if (!S.next(i, u)) break;
#pragma unroll 1
                for (int hb = 0; hb < 2; ++hb)
                    mem_attn_unit(F.lds + LDS_STAGE, (const bf16*)(ws + WS_QM), (const bf16*)(ws + WS_KM) + (size_t)l * 2048 * KM_LD, (const bf16*)(ws + WS_VTM) + (size_t)l * 1024 * VTM_LD, (bf16*)(ws + WS_OM), (u.r0 >> 7) + hb, u.pn, F.wave); }
            GRID_BAR();
        }
        if (IN(P_WMO)) {
            PHASE_BASES(); unsigned char* wb = ws + WS_WB;
            pg8::Gemm g{(const bf16*)(ws + WS_OM), (const bf16*)(wb + WB_WMO), D, 0, 0}; pg8::DenseOrder S; S.init(NTOK, D, 1, F.G, (int)blockIdx.x);
            pg8::EpiBf16 E{(bf16*)(ws + WS_Y), D, 0, 0, 0};
            pg8::gemm_phase<pg8::EpiBf16, pg8::DenseOrder, false>(F.lds + LDS_STAGE, g, S, E, nullptr, F.wave);
            GRID_BAR();
        }
        if (IN(P_LN2)) {
            PHASE_BASES();
            const int lane = lane_id(); const bf16* Y = (const bf16*)(ws + WS_Y);
            for (int row = gw; row < NTOK; row += 2 * NGW) ln_res_rows<2, true, false, false>(HB + (size_t)row * D, (size_t)NGW * D, Y + (size_t)row * D, (size_t)NGW * D, nullptr, 0, nullptr, 0, ALPHA, a.in[19] + l * D, a.in[20] + l * D, HB + (size_t)row * D, (size_t)NGW * D, nullptr, 0, lane);
            GRID_BAR();
        }
        if (IN(P_RGEMM) && NTOK / F.G != 128) {
            PHASE_BASES(); unsigned char* wb = ws + WS_WB;
            pg8::Gemm g{HB, (const bf16*)(wb + WB_RW), D, 0, 0}; pg8::DenseOrder S; S.init(NTOK, 256, 1, F.G, (int)blockIdx.x);
            pg8::EpiLogit E{(float*)(ws + WS_LOGIT)};
            pg8::gemm_phase<pg8::EpiLogit, pg8::DenseOrder, false>(F.lds + LDS_STAGE, g, S, E, nullptr, F.wave);
            GRID_BAR();
        }
        if (IN(P_ROUTE)) {
            PHASE_BASES(); unsigned char* wb = ws + WS_WB;
            const int lane = lane_id(), w = F.wave, tidp = w * 64 + lane;
            const float* LOGIT = (const float*)(ws + WS_LOGIT); float* GATEw = (float*)(ws + WS_ROUTE + 1 * MiB); int* LISTE = (int*)(ws + WS_LISTE);
            LAS int* lcnt = (LAS int*)(F.lds + LDS_TAB);
            LAS int* lsel = lcnt + 64;
            const int T = NTOK / F.G, t0 = (int)blockIdx.x * T, chunk = t0 / MOE_TOK;
            int* gcnt = (int*)(ws + WS_CTL) + CW_MOE + (l * MOE_CHUNKS + chunk) * 256;
            LAS float* LG = (LAS float*)(F.lds + LDS_STAGE);
            const bool fusedlg = (T == 128);
            if (fusedlg) {
                LAS unsigned char* wl = F.lds + LDS_STAGE;
                { const bf16* RW = (const bf16*)(wb + WB_RW); u32x4 st[16];
#pragma unroll
                  for (int i = 0; i < 16; ++i) { const int p = tidp + 512 * i; st[i] = *(const u32x4*)(RW + (size_t)(p >> 7) * D + (p & 127) * 8); }
#pragma unroll
                  for (int i = 0; i < 16; ++i) { const int p = tidp + 512 * i, e = p >> 7, c = p & 127; *(LAS u32x4*)(wl + e * 2048 + ((c ^ (e & 15)) * 16)) = st[i]; } }
                const int n = lane & 15, kq = lane >> 4;
                const bf16* arow = HB + (size_t)(t0 + 16 * w + n) * D + 8 * kq;
                f32x4 acc[4];
#pragma unroll
                for (int nt = 0; nt < 4; ++nt) acc[nt] = (f32x4){0.f, 0.f, 0.f, 0.f};
                __syncthreads();
#pragma unroll 1
                for (int kb = 0; kb < 4; ++kb) { bf16x8 af[8];
#pragma unroll
                    for (int j = 0; j < 8; ++j) af[j] = *(const bf16x8*)(arow + 32 * (8 * kb + j));
#pragma unroll
                    for (int j = 0; j < 8; ++j) { const int c = 4 * (8 * kb + j) + kq;
#pragma unroll
                        for (int nt = 0; nt < 4; ++nt) acc[nt] = mfma16(af[j], *(const LAS bf16x8*)(wl + (16 * nt + n) * 2048 + ((c ^ n) * 16)), acc[nt]); } }
                __syncthreads();
#pragma unroll
                for (int nt = 0; nt < 4; ++nt)
#pragma unroll
                    for (int i = 0; i < 4; ++i) LG[(16 * w + 4 * kq + i) * 64 + 16 * nt + n] = acc[nt][i];
            }
            if (tidp < 64) lcnt[tidp] = 0;
            __syncthreads();
            const float bias = a.in[22][l * N_EXP + lane];
            for (int tt0 = w; tt0 < T; tt0 += 8 * NWAVES) {
                float sc[8], key[8], ssum[8], mys[8]; int mye[8];
#pragma unroll
                for (int u = 0; u < 8; ++u) { const int tt = tt0 + u * NWAVES, t = t0 + (tt < T ? tt : tt0);
                    const float lg = fusedlg ? LG[(tt < T ? tt : tt0) * 64 + lane] : LOGIT[(size_t)t * N_EXP + lane];
                    sc[u] = 1.0f / (1.0f + __expf(-lg)); key[u] = sc[u] + bias; ssum[u] = 0.f; mys[u] = 0.f; mye[u] = 0; }
#pragma unroll 1
                for (int j = 0; j < TOP_E; ++j) {
                    float best[8]; int bi[8];
#pragma unroll
                    for (int u = 0; u < 8; ++u) { best[u] = key[u]; bi[u] = lane; }
#define ROUTE_STEP(GETF, GETI) do { float ob[8]; int oi[8]; \
                        _Pragma("unroll") for (int u = 0; u < 8; ++u) { ob[u] = GETF(best[u]); oi[u] = GETI(bi[u]); } \
                        _Pragma("unroll") for (int u = 0; u < 8; ++u) if (ob[u] > best[u] || (ob[u] == best[u] && oi[u] < bi[u])) { best[u] = ob[u]; bi[u] = oi[u]; } } while (0)
#define DPPF(ctrl) [&](float x) { return __int_as_float(__builtin_amdgcn_update_dpp(__float_as_int(x), __float_as_int(x), ctrl, 0xf, 0xf, false)); }
#define DPPI(ctrl) [&](int x) { return __builtin_amdgcn_update_dpp(x, x, ctrl, 0xf, 0xf, false); }
                    ROUTE_STEP(DPPF(0xB1), DPPI(0xB1));
                    ROUTE_STEP(DPPF(0x4E), DPPI(0x4E));
                    ROUTE_STEP(DPPF(0x141), DPPI(0x141));
                    ROUTE_STEP(DPPF(0x140), DPPI(0x140));
#pragma unroll
                    for (int o = 16; o < 64; o <<= 1) {
                        float ob[8]; int oi[8];
#pragma unroll
                        for (int u = 0; u < 8; ++u) { ob[u] = shx(best[u], lane, o); oi[u] = __builtin_amdgcn_ds_bpermute((lane ^ o) << 2, bi[u]); }
#pragma unroll
                        for (int u = 0; u < 8; ++u) if (ob[u] > best[u] || (ob[u] == best[u] && oi[u] < bi[u])) { best[u] = ob[u]; bi[u] = oi[u]; }
                    }
#undef ROUTE_STEP
#undef DPPF
#undef DPPI
#pragma unroll
                    for (int u = 0; u < 8; ++u) { const float ssel = __int_as_float(__builtin_amdgcn_ds_bpermute(bi[u] << 2, __float_as_int(sc[u])));
                        ssum[u] += ssel; if (lane == j) { mye[u] = bi[u]; mys[u] = ssel; } if (lane == bi[u]) key[u] = -INFINITY; }
                }
#pragma unroll
                for (int u = 0; u < 8; ++u) { const int tt = tt0 + u * NWAVES, t = t0 + tt;
                    if (tt < T && lane < TOP_E) { GATEw[(size_t)t * 8 + lane] = mys[u] / ssum[u] * 2.5f; const int lp = atomicAdd((int*)(lcnt + mye[u]), 1); lsel[tt * 8 + lane] = (mye[u] << 16) | lp; } }
            }
            __syncthreads();
            if (tidp < 64) { const int nloc = lcnt[tidp]; lcnt[tidp] = nloc ? atomicAdd(gcnt + tidp, nloc) : 0; }
            __syncthreads();
            for (int i = tidp; i < T * 8; i += NTHR) { const int v = lsel[i], e = v >> 16, lp = v & 0xffff; const int aid = ((t0 - chunk * MOE_TOK) + (i >> 3)) * 8 + (i & 7);
                LISTE[((size_t)chunk * N_EXP + e) * LIST_CAP + lcnt[e] + lp] = aid; }
            GRID_BAR();
        }
#pragma unroll 1
        for (int c = a.c_lo; c < a.c_hi; ++c) {
            const int tok0 = c * MOE_TOK;
#define MOE_BASES() PHASE_BASES(); unsigned char* wb = ws + WS_WB; const int* rec = (const int*)(ws + WS_CTL) + CW_MOE + (l * MOE_CHUNKS + c) * 256; \
            const int* LIST = (const int*)(ws + WS_LISTE) + (size_t)c * N_EXP * LIST_CAP; const float* GATE = (const float*)(ws + WS_ROUTE + 1 * MiB) + (size_t)tok0 * 8; (void)rec; (void)LIST; (void)GATE; (void)wb
            if (IN(P_GU)) {
                MOE_BASES();
#if USE_MK_EXPERT
                LAS int* cum = (LAS int*)(F.lds + LDS_CUM); LAS int* offl = cum + 80; LAS int* tab = (LAS int*)(F.lds + LDS_TAB);
                const int tidm = F.wave * 64 + lane_id();
                if (F.wave == 0) { const int ln = tidm & 63, ce = rec[ln], nb = (ce + 255) >> 8;
                    const int ib = wave_incl_scan(nb, ln), io = wave_incl_scan(ce, ln);
                    cum[ln] = ib - nb; offl[ln] = io - ce; if (ln == 63) { cum[N_EXP] = ib; offl[N_EXP] = io; } }
                __syncthreads();
                LAS int* ut = (LAS int*)(F.lds + LDS_UT);
                pg8::GroupedOrder S{cum, offl, 2, F.G, (int)blockIdx.x, ut};
                if (F.wave == 0) S.fill_table(ut, tidm);
                __syncthreads();
                for (int i = F.wave; i < 8; i += NWAVES) { const int nvv = ut[8 * i + 2], lr = ut[8 * i + 4]; const int ln = tidm & 63;
#pragma unroll
                    for (int k = 0; k < 4; ++k) { const int r = ln + 64 * k; tab[i * 256 + r] = tok0 + ((r < nvv) ? (LIST[lr + r] >> 3) : 0); } }
                __syncthreads();
                { pg8::Gemm g{HB, (const bf16*)(wb + WB_GU), D, 0, (size_t)512 * D};
                  pg8::EpiSwiglu E{(bf16*)(ws + WS_HID)};
                  pg8::gemm_phase<pg8::EpiSwiglu, pg8::GroupedOrder, true>(F.lds + LDS_STAGE, g, S, E, tab, F.wave); }
#endif
                { pg8::Gemm g{HB + (size_t)tok0 * D, (const bf16*)(wb + WB_SGU), D, 0, 0}; pg8::DenseOrder S2; S2.init(MOE_TOK, 512, 1, F.G, (int)((blockIdx.x + 64) % F.G));
                  pg8::EpiSwiglu E{(bf16*)(ws + WS_SHH)};
                  pg8::gemm_phase<pg8::EpiSwiglu, pg8::DenseOrder, false>(F.lds + LDS_STAGE, g, S2, E, nullptr, F.wave); }
                GRID_BAR();
            }
            if (IN(P_DN)) {
                MOE_BASES();
#if USE_MK_EXPERT
                LAS int* cum = (LAS int*)(F.lds + LDS_CUM); LAS int* offl = cum + 80;
                const int tidm = F.wave * 64 + lane_id();
                if (F.wave == 0) { const int ln = tidm & 63, ce = rec[ln], nb = (ce + 255) >> 8;
                    const int ib = wave_incl_scan(nb, ln), io = wave_incl_scan(ce, ln);
                    cum[ln] = ib - nb; offl[ln] = io - ce; if (ln == 63) { cum[N_EXP] = ib; offl[N_EXP] = io; } }
                __syncthreads();
                { LAS int* ut = (LAS int*)(F.lds + LDS_UT); LAS int* ag = (LAS int*)(F.lds + LDS_AG);
                  pg8::GroupedOrder S{cum, offl, 4, F.G, (int)blockIdx.x, ut};
                  if (F.wave == 0) S.fill_table(ut, tidm);
                  __syncthreads();
                  for (int i = F.wave; i < MOE_AGU; i += NWAVES) { const int nvv = ut[8 * i + 2], lr = ut[8 * i + 4]; const int ln = tidm & 63;
#pragma unroll
                      for (int k = 0; k < 4; ++k) { const int r = ln + 64 * k; if (r < nvv) { const int aid = LIST[lr + r]; *(LAS i32x2*)(ag + (i * 256 + r) * 2) = (i32x2){aid, __float_as_int(GATE[aid])}; } } }
                  __syncthreads();
                  pg8::Gemm g{(const bf16*)(ws + WS_HID), (const bf16*)(wb + WB_DN), EXP_DIM, 0, (size_t)D * EXP_DIM};
                  pg8::EpiSlot E{(bf16*)(ws + WS_SLOT), LIST, GATE, ag};
                  pg8::gemm_phase<pg8::EpiSlot, pg8::GroupedOrder, false>(F.lds + LDS_STAGE, g, S, E, nullptr, F.wave); }
#endif
                { pg8::Gemm g{(const bf16*)(ws + WS_SHH), (const bf16*)(wb + WB_SD), SH_DIM, 0, 0}; pg8::DenseOrder S2; S2.init(MOE_TOK, D, 1, F.G, (int)blockIdx.x);
                  pg8::EpiBf16 E{(bf16*)(ws + WS_SHY), D, 0, 0, 0};
                  pg8::gemm_phase<pg8::EpiBf16, pg8::DenseOrder, false>(F.lds + LDS_STAGE, g, S2, E, nullptr, F.wave); }
                GRID_BAR();
            }
            if (IN(P_COMB)) {
                PHASE_BASES();
                const int lane = lane_id(); const bf16* SLOTp = (const bf16*)(ws + WS_SLOT);
                for (int tl = gw; tl < MOE_TOK; tl += NGW) { const int row = tok0 + tl;
                    ln_res_rows<1, false, true, true>(HB + (size_t)row * D, 0, nullptr, 0, (const bf16*)(ws + WS_SHY) + (size_t)tl * D, 0, SLOTp + (size_t)tl * 8 * D, 0, ALPHA, a.in[29] + l * D, a.in[30] + l * D, HB + (size_t)row * D, 0, (l == DEPTH - 1) ? H + (size_t)row * D : nullptr, 0, lane); }
            }
        }
    }
#undef IN
#undef GRID_BAR
}

static Args g_args;
static int g_grid = 0;
#ifndef PROBE_MASK
#define PROBE_MASK 0u
#endif
static void launch_mk(hipStream_t stream, int ph, int l, int c) {
    const int reps = ((PROBE_MASK >> ph) & 1u) ? 3 : 1;
    for (int rr = 0; rr < reps; ++rr) {
    Args a = g_args; a.ph_lo = ph; a.ph_hi = ph + 1; a.l_lo = l; a.l_hi = l + 1; a.c_lo = c; a.c_hi = c + 1; a.use_bar = 0; a.pad = 0;
    hipLaunchKernelGGL(mk_fwd, dim3(g_grid), dim3(NTHR), LDS_BYTES, stream, a);
    }
}
extern "C" void kernel_launch(void* const* d_in, const int* in_sizes, int n_in, void* d_out, int out_size, void* d_ws, size_t ws_size, hipStream_t stream) {
    static int inited = 0;
    if (!inited) {
        inited = 1;
        if (n_in != 31 || out_size != NTOK * D || ws_size < WS_END) { fprintf(stderr, "kernel_launch: unexpected sizes n_in %d out %d ws %zu (need %zu)\n", n_in, out_size, ws_size, (size_t)WS_END); inited = -1; }
        if (hipFuncSetAttribute((const void*)mk_fwd, hipFuncAttributeMaxDynamicSharedMemorySize, LDS_BYTES) != hipSuccess) { fprintf(stderr, "kernel_launch: hipFuncSetAttribute(mk_fwd) failed\n"); inited = -1; }
        int dev = 0, cus = 0, per_cu = 0;
        (void)hipGetDevice(&dev); (void)hipDeviceGetAttribute(&cus, hipDeviceAttributeMultiprocessorCount, dev);
        (void)hipOccupancyMaxActiveBlocksPerMultiprocessor(&per_cu, (const void*)mk_fwd, NTHR, LDS_BYTES);
        if (per_cu < 1) fprintf(stderr, "kernel_launch: occupancy query says %d blocks per CU for mk_fwd\n", per_cu);
        (void)hipGetLastError();
        g_grid = cus > 0 ? cus : 256;
    }
    if (inited < 0) return;
    const float* ln1_g = (const float*)d_in[14]; const float* ln1_b = (const float*)d_in[15];
    const float* ln2_g = (const float*)d_in[19]; const float* ln2_b = (const float*)d_in[20];
    const float* ln3_g = (const float*)d_in[29]; const float* ln3_b = (const float*)d_in[30];
    const float* a_kv_norm = (const float*)d_in[5]; const float* a_w_uk = (const float*)d_in[6]; const float* a_w_uv = (const float*)d_in[7];
    const float* b_lq1 = (const float*)d_in[8]; const float* b_lk1 = (const float*)d_in[9]; const float* b_lq2 = (const float*)d_in[10]; const float* b_lk2 = (const float*)d_in[11];
    const float* b_subln = (const float*)d_in[12];
    const float* router_w = (const float*)d_in[21]; const float* router_bias = (const float*)d_in[22];
    const float* e_w_gate = (const float*)d_in[23]; const float* e_w_up = (const float*)d_in[24]; const float* e_w_down = (const float*)d_in[25];
    unsigned char* ws = (unsigned char*)d_ws;
    float* H = (float*)d_out;
    bf16* HB = (bf16*)(ws + WS_HB);
    bf16* PROJ5 = (bf16*)(ws + WS_PROJ5); bf16* MISC = (bf16*)(ws + WS_MISC10); float* WIDX = (float*)(ws + WS_WIDX); bf16* CKV = (bf16*)(ws + WS_CKV);
    int* SEL = (int*)(ws + WS_SEL); bf16* CAT = (bf16*)(ws + WS_CAT); bf16* Y = (bf16*)(ws + WS_Y);
    bf16* QM = (bf16*)(ws + WS_QM); bf16* OM = (bf16*)(ws + WS_OM);
    int* TOPE = (int*)(ws + WS_ROUTE); float* GATE = (float*)(ws + WS_ROUTE + 1 * MiB); int* LIST = (int*)(ws + WS_ROUTE + 2 * MiB);
    bf16* SLOT = (bf16*)(ws + WS_SLOT);
    int* CNT = (int*)(ws + WS_CTL) + CW_MOE;
    const size_t PS = (size_t)NTOK * 512;
    Args a{};
    for (int i = 0; i < 31; ++i) a.in[i] = (const float*)d_in[i];
    a.out = (float*)d_out; a.ws = ws;
    g_args = a;

    (void)hipMemsetAsync(ws + WS_CTL, 0, 128 * 1024, stream);
#if SINGLE_LAUNCH
    { Args b = g_args; b.ph_lo = 0; b.ph_hi = P_NUM; b.l_lo = 0; b.l_hi = DEPTH; b.c_lo = 0; b.c_hi = MOE_CHUNKS; b.use_bar = 1; b.pad = 0;
      hipLaunchKernelGGL(mk_fwd, dim3(g_grid), dim3(NTHR), LDS_BYTES, stream, b); }
#else
    launch_mk(stream, P_PRO0, 0, 0);
    launch_mk(stream, P_PRO1, 0, 0);
    for (int l = 0; l < DEPTH; ++l) {
        launch_mk(stream, P_CVT, l, 0);
        launch_mk(stream, P_WIN, l, 0);
        launch_mk(stream, P_CKVN, l, 0);
        launch_mk(stream, P_ATTN, l, 0);
        launch_mk(stream, P_DIFF, l, 0);
        launch_mk(stream, P_WO, l, 0);
        launch_mk(stream, P_LN1, l, 0);
        launch_mk(stream, P_WQ, l, 0);
        launch_mk(stream, P_MEMATT, l, 0);
        launch_mk(stream, P_WMO, l, 0);
        launch_mk(stream, P_LN2, l, 0);
        launch_mk(stream, P_RGEMM, l, 0);
        launch_mk(stream, P_ROUTE, l, 0);
        for (int c = 0; c < MOE_CHUNKS; ++c) {
            launch_mk(stream, P_GU, l, c);
            launch_mk(stream, P_DN, l, c);
            launch_mk(stream, P_COMB, l, c);
        }
    }
#endif
}
```

```cpp
#include <hip/hip_runtime.h>
#include <cstdio>
#include <cstdint>

typedef unsigned short bf16;
typedef float f32x4 __attribute__((ext_vector_type(4)));

constexpr int D = 1024, BATCH = 8, SEQ = 4096, NTOK = BATCH * SEQ, DEPTH = 2;
constexpr int CHUNK = 64, TOPK = 256;
constexpr int KV_LORA = 128, A_HEADS = 8, IDX_DIM = 64;
constexpr int B_HEADS = 4;
constexpr int MEM_TOK = 256, MEM_HEADS = 4, MEM_HD = 256;
constexpr int N_EXP = 64, TOP_E = 8, EXP_DIM = 256, SH_DIM = 256;
constexpr int WIN_COLS = 2760;
constexpr float ALPHA = 1.41421356237309515f;
constexpr float LN_EPS = 1e-5f, RMS_EPS = 1e-6f;
constexpr int MOE_CHUNKS = 2, MOE_TOK = NTOK / MOE_CHUNKS;

constexpr size_t MiB = 1u << 20;
constexpr size_t WS_CTL = 0;
constexpr size_t WS_WB = 1 * MiB;
constexpr size_t WS_KVM = 113 * MiB;
constexpr size_t WS_HB = 129 * MiB;
constexpr size_t WS_A = 193 * MiB;
constexpr size_t WS_PROJ5 = WS_A;
constexpr size_t WS_MISC10 = WS_A + 160 * MiB;
constexpr size_t WS_WIDX = WS_A + 176 * MiB;
constexpr size_t WS_CKV = WS_A + 177 * MiB;
constexpr size_t WS_SEL = WS_A + 185 * MiB;
constexpr size_t WS_CAT = WS_A + 217 * MiB;
constexpr size_t WS_Y = WS_A + 281 * MiB;
constexpr size_t WS_MEMB = WS_A + 345 * MiB;
constexpr size_t WS_QM = WS_A;
constexpr size_t WS_OM = WS_A + 64 * MiB;
constexpr size_t WS_ROUTE = WS_A + 336 * MiB;
constexpr int LIST_CAP = MOE_TOK;
constexpr size_t WS_SHY = WS_ROUTE + 10 * MiB;
constexpr size_t WS_LISTE = WS_ROUTE + 2 * MiB;
constexpr size_t WS_LOGIT = WS_ROUTE + 10 * MiB;
constexpr size_t WS_SLOT = WS_A;
constexpr size_t WS_HID = WS_A + 256 * MiB;
constexpr size_t WS_SHH = WS_A + 320 * MiB;
constexpr int VTD_LD = NTOK + 128, VTM_LD = 2048 + 128, KM_LD = 1024 + 128;
constexpr size_t WS_VTD = WS_A + 349 * MiB;
constexpr size_t WS_VTM = WS_A + 382 * MiB;
constexpr size_t WS_END = WS_A + 391 * MiB;
static_assert(WS_SLOT + (size_t)MOE_TOK * 8 * 1024 * 2 <= WS_HID && WS_HID + (size_t)MOE_TOK * 8 * 256 * 2 <= WS_SHH && WS_SHH + (size_t)MOE_TOK * 512 * 2 <= WS_ROUTE && WS_LISTE + (size_t)MOE_CHUNKS * N_EXP * LIST_CAP * 4 <= WS_SHY && WS_SHY + (size_t)MOE_TOK * 1024 * 2 <= WS_VTM, "MoE-stage workspace map: no two live buffers overlap");

__device__ __forceinline__ float bf2f(bf16 v) { return __uint_as_float((unsigned)v << 16); }
__device__ __forceinline__ bf16 f2bf(float f) { unsigned u = __float_as_uint(f); u += 0x7fffu + ((u >> 16) & 1u); return (bf16)(u >> 16); }
__device__ __forceinline__ float wave_sum(float v) {
#pragma unroll
    for (int o = 1; o < 64; o <<= 1) v += __shfl_xor(v, o);
    return v;
}
__device__ __forceinline__ float wave_max(float v) {
#pragma unroll
    for (int o = 1; o < 64; o <<= 1) v = fmaxf(v, __shfl_xor(v, o));
    return v;
}
__device__ __forceinline__ float block_sum(float v, float* scr) {
    v = wave_sum(v); __syncthreads();
    if ((threadIdx.x & 63) == 0) scr[threadIdx.x >> 6] = v;
    __syncthreads();
    float r = scr[0] + scr[1] + scr[2] + scr[3]; __syncthreads(); return r;
}
__device__ __forceinline__ float block_max(float v, float* scr) {
    v = wave_max(v); __syncthreads();
    if ((threadIdx.x & 63) == 0) scr[threadIdx.x >> 6] = v;
    __syncthreads();
    float r = fmaxf(fmaxf(scr[0], scr[1]), fmaxf(scr[2], scr[3])); __syncthreads(); return r;
}

#ifndef USE_MK_EXPERT
#define USE_MK_EXPERT 1
#endif
#ifndef MEMATT_V2
#define MEMATT_V2 1
#endif
#ifndef DIFF_V2
#define DIFF_V2 1
#endif
#ifndef SINGLE_LAUNCH
#define SINGLE_LAUNCH 1
#endif
#ifndef USE_MK_DIFF
#define USE_MK_DIFF 1
#endif
#ifndef USE_MK_TOPK
#define USE_MK_TOPK 1
#endif
#ifndef USE_MK_MEMATT
#define USE_MK_MEMATT 1
#endif

#define LAS __attribute__((address_space(3)))
#define GAS __attribute__((address_space(1)))
typedef short bf16x8 __attribute__((ext_vector_type(8)));
typedef unsigned u32x4 __attribute__((ext_vector_type(4)));
typedef unsigned u32x2 __attribute__((ext_vector_type(2)));
typedef int i32x4 __attribute__((ext_vector_type(4)));
typedef int i32x2 __attribute__((ext_vector_type(2)));
typedef float f32x2 __attribute__((ext_vector_type(2)));
typedef float f32x16 __attribute__((ext_vector_type(16)));

constexpr int NWAVES = 8, NTHR = 512;
constexpr int LDS_BYTES = 163840;
constexpr int LDS_STAGE = 0;
constexpr int LDS_TAB = 131072;
constexpr int LDS_CUM = 131072 + 8192;
constexpr int LDS_UT = LDS_CUM + 640;
constexpr int MOE_MAXU = 16;
constexpr int LDS_AG = LDS_UT + MOE_MAXU * 32;
constexpr int MOE_AGU = 9;
static_assert(LDS_AG + MOE_AGU * 2048 <= LDS_BYTES - 256, "MoE LDS tables");
constexpr int LDS_MISC = LDS_BYTES - 256;

constexpr size_t WB_WIN = 0, WB_WO = 6 * MiB, WB_WQ = 8 * MiB, WB_WMO = 10 * MiB, WB_SGU = 12 * MiB, WB_SD = 13 * MiB, WB_UK = 14 * MiB, WB_UV = 14 * MiB + 256 * 1024, WB_RW = 15 * MiB, WB_GU = 16 * MiB, WB_DN = 80 * MiB;
constexpr int WIN_PAD = 2304;
constexpr size_t WS_WKT = WS_Y, WS_WVT = WS_Y + 2 * MiB;
constexpr size_t WS_KM = WS_KVM, WS_VT = WS_KVM + 8 * MiB;
constexpr int CW_BAR = 4096;
constexpr int CW_MOE = 16384;

typedef float f32x2v __attribute__((ext_vector_type(2)));
typedef __bf16 bf16x2v __attribute__((ext_vector_type(2)));
__device__ __forceinline__ unsigned cvt_pk_bf16(float lo, float hi) { return __builtin_bit_cast(unsigned, __builtin_convertvector((f32x2v){lo, hi}, bf16x2v)); }
__device__ __forceinline__ unsigned pk2(float lo, float hi) { return cvt_pk_bf16(lo, hi); }
#define LDS_WAIT() asm volatile("s_waitcnt lgkmcnt(0)" ::: "memory")
#define VM_WAIT() asm volatile("s_waitcnt vmcnt(0)" ::: "memory")

#define XB_TMO      128
#define XB_XCNT(j)  (256  + 64 * (j))
#define XB_XSUB(j)  (1280 + 64 * (j))
#define XB_XGEN(j)  (2304 + 64 * (j))
#define XB_TOP      3328
#define XB_TOPGEN   3392
#define XCD_BAR_WORDS 3456
#define XB_SPIN_CAP (1u << 22)
__device__ __forceinline__ unsigned xb_ld(unsigned* p)              { return __hip_atomic_load(p, __ATOMIC_RELAXED, __HIP_MEMORY_SCOPE_AGENT); }
__device__ __forceinline__ unsigned xb_add(unsigned* p, unsigned v) { return __hip_atomic_fetch_add(p, v, __ATOMIC_RELAXED, __HIP_MEMORY_SCOPE_AGENT); }
__device__ __forceinline__ unsigned xb_xcc_id() { return (unsigned)__builtin_amdgcn_s_getreg((3 << 11) | 20) & 0xFu; }
#define XB_SPIN(cond, bar) do { unsigned _sp = 0; while (cond) { __builtin_amdgcn_s_sleep(1); \
    if ((++_sp & 255u) == 0u) { if (xb_ld(&(bar)[XB_TMO])) break; if (_sp > XB_SPIN_CAP) { atomicAdd(&(bar)[XB_TMO], 1u); break; } } } } while (0)
struct XcdBarrier { unsigned* bar; unsigned x; volatile LAS unsigned* st; };
__device__ __forceinline__ XcdBarrier xcd_barrier_post(unsigned* bar, volatile LAS unsigned* st) {
    XcdBarrier b; b.bar = bar; b.x = xb_xcc_id(); b.st = st;
    if (threadIdx.x == 0) (void)xb_add(&bar[XB_XCNT(b.x)], 1u);
    return b;
}
__device__ __forceinline__ void xcd_barrier_complete(unsigned* bar, unsigned x, unsigned& nloc, unsigned& nx) {
    const unsigned G = gridDim.x * gridDim.y * gridDim.z;
    unsigned sum, cnt, mine, sp = 0u;
    for (;;) {
        sum = 0u; cnt = 0u; mine = 0u;
#pragma unroll
        for (unsigned j = 0; j < 16; ++j) { const unsigned c = xb_ld(&bar[XB_XCNT(j)]); sum += c; cnt += (c > 0u) ? 1u : 0u; mine = (j == x) ? c : mine; }
        if (sum == G) break;
        __builtin_amdgcn_s_sleep(1);
        if ((++sp & 255u) == 0u) { if (xb_ld(&bar[XB_TMO])) break; if (sp > XB_SPIN_CAP) { atomicAdd(&bar[XB_TMO], 1u); break; } }
    }
    nloc = mine > 0u ? mine : 1u; nx = cnt > 0u ? cnt : 1u;
}
__device__ __forceinline__ void xcd_barrier(const XcdBarrier& b, int wave_s) {
    asm volatile("s_waitcnt vmcnt(0)" ::: "memory");
    __syncthreads();
    unsigned zb = 0u; asm volatile("" : "+s"(zb));
    if (wave_s == 0 && (int)__builtin_amdgcn_mbcnt_hi(~0u, __builtin_amdgcn_mbcnt_lo(~0u, zb)) == 0) {
        unsigned* bar = b.bar;
        __builtin_amdgcn_s_waitcnt(0);
        unsigned nloc = b.st[0], nx = b.st[1];
        if (nloc == 0u) { xcd_barrier_complete(bar, b.x, nloc, nx); b.st[0] = nloc; b.st[1] = nx; }
        const unsigned old = xb_add(&bar[XB_XSUB(b.x)], 1u);
        const unsigned gen = old / nloc;
        if (old + 1u == (gen + 1u) * nloc) {
            __builtin_amdgcn_fence(__ATOMIC_RELEASE, "agent");
            asm volatile("s_waitcnt vmcnt(0)" ::: "memory");
            const unsigned og = xb_add(&bar[XB_TOP], 1u);
            const unsigned tg = og / nx;
            if (og + 1u == (tg + 1u) * nx) xb_add(&bar[XB_TOPGEN], 1u);
            else XB_SPIN(xb_ld(&bar[XB_TOPGEN]) == tg, bar);
            __builtin_amdgcn_fence(__ATOMIC_ACQUIRE, "agent");
            xb_add(&bar[XB_XGEN(b.x)], 1u);
            asm volatile("s_waitcnt vmcnt(0)" ::: "memory");
        } else {
            XB_SPIN(xb_ld(&bar[XB_XGEN(b.x)]) == gen, bar);
            __builtin_amdgcn_fence(__ATOMIC_ACQUIRE, "agent");
            asm volatile("s_waitcnt vmcnt(0)" ::: "memory");
        }
    }
    __syncthreads();
}

namespace pg8 {
typedef unsigned short bf16_t;
constexpr int BM = 256, BK = 64, HALF = 128, HTB = HALF * BK * 2, STAGE_BYTES = 8 * HTB, NXCD = 8, WGM = 8;
__host__ __device__ __forceinline__ int lds_byte(int r, int c) { const int st = (r >> 4) * 2 + (c >> 5), rr = r & 15, cc = c & 31, ob = rr * 64 + cc * 2; return st * 1024 + (ob ^ (((ob >> 9) & 1) << 5)); }
__host__ __device__ __forceinline__ void stage_rc(int b, int& R, int& C) { const int st = b / 1024, sb = b % 1024, swz = sb ^ (((sb >> 9) & 1) << 5); R = (st >> 1) * 16 + swz / 64; C = (st & 1) * 32 + (swz % 64) / 2; }
__host__ __device__ __forceinline__ int perm32(int rho) { const int n = rho >> 4, i = rho & 15; return 8 * (i >> 2) + 4 * n + (i & 3); }

struct Unit { int g, r0, nv, pn, slot, lr0; };
struct Gemm { const bf16_t* A; const bf16_t* Bt; int K; size_t astride, bstride; };

struct DenseOrder {
    int nM, nN, nwg, ng, G, c;
    __device__ void init(int M, int N, int ngroups, int G_, int c_) { nM = M / BM; nN = N / BM; nwg = nM * nN; ng = ngroups; G = G_; c = c_; }
    __device__ __forceinline__ bool next(int i, Unit& u) const {
        const long L = (long)i * G + c; if (L >= (long)nwg * ng) return false;
        const int g = (int)(L / nwg); int wgid = (int)(L % nwg);
        { const int q = nwg / NXCD, r = nwg % NXCD, xcd = wgid % NXCD, off = wgid / NXCD; wgid = (xcd < r ? xcd * (q + 1) : r * (q + 1) + (xcd - r) * q) + off; }
        const int nig = WGM * nN, gid = wgid / nig, fm = gid * WGM, gsz = (nM - fm) < WGM ? (nM - fm) : WGM;
        u.g = g; u.r0 = (fm + ((wgid % nig) % gsz)) * BM; u.pn = (wgid % nig) / gsz; u.nv = BM; u.slot = i; u.lr0 = 0; return true;
    }
};
struct GroupedOrder {
    const LAS int* cum; const LAS int* off; int NT, G, c; const LAS int* ut;
    __device__ bool next(int i, Unit& u) const {
        if (i >= MOE_MAXU) return false;
        const i32x4 a = *(const LAS i32x4*)(ut + 8 * i); const i32x4 b = *(const LAS i32x4*)(ut + 8 * i + 4);
        if (__builtin_amdgcn_readfirstlane(b.w) == 0) return false;
        u.g = __builtin_amdgcn_readfirstlane(a.x); u.r0 = __builtin_amdgcn_readfirstlane(a.y); u.nv = __builtin_amdgcn_readfirstlane(a.z); u.pn = __builtin_amdgcn_readfirstlane(a.w);
        u.lr0 = __builtin_amdgcn_readfirstlane(b.x); u.slot = i; return true;
    }
    __device__ __forceinline__ void peek(int i, int& g, int& r0, int& nv, int& pn, int& lr0) const {
        const int L = i * G + c; const int total = cum[N_EXP] * NT; const bool ok = L < total;
        const int blk = ok ? L / NT : 0; pn = ok ? L - blk * NT : 0;
        int lo = 0, hi = N_EXP;
#pragma unroll
        for (int s = 0; s < 6; ++s) { const int mid = (lo + hi) >> 1; const bool le = cum[mid] <= blk; lo = le ? mid : lo; hi = le ? hi : mid; }
        g = lo; r0 = off[lo] + (blk - cum[lo]) * BM; const int rem = off[lo + 1] - r0; nv = ok ? (rem < BM ? rem : BM) : 0; lr0 = lo * LIST_CAP + (blk - cum[lo]) * BM;
    }
    __device__ __forceinline__ void fill_table(LAS int* utw, int lane) const {
        if (lane < MOE_MAXU) { int g, r0, nv, pn, lr0; peek(lane, g, r0, nv, pn, lr0);
            *(LAS i32x4*)(utw + 8 * lane) = (i32x4){g, r0, nv, pn}; *(LAS i32x4*)(utw + 8 * lane + 4) = (i32x4){lr0, 0, 0, nv > 0 ? 1 : 0}; }
    }
};

#define PG8_SA(b, h) (((b) * 2 + (h)) * HTB)
#define PG8_SB(b, h) ((4 + (b) * 2 + (h)) * HTB)
#define PG8_STAGE(bufoff, gbase, voff) do { _Pragma("unroll") for (int _i = 0; _i < 2; ++_i) \
        __builtin_amdgcn_global_load_lds((const unsigned*)((const char*)(gbase) + (voff)[_i]), (LAS unsigned*)(lds + (bufoff) + ldsw + _i * 8192), 16, 0, 0); } while (0)
#define PG8_LDA(dst, b, h) do { _Pragma("unroll") for (int m = 0; m < 4; ++m) _Pragma("unroll") for (int k = 0; k < 2; ++k) dst[m][k] = *(const LAS bf16x8*)(lds + PG8_SA(b, h) + aoff + m * 2048 + k * 1024); } while (0)
#define PG8_LDB(dst, b, h) do { _Pragma("unroll") for (int n = 0; n < 2; ++n) _Pragma("unroll") for (int k = 0; k < 2; ++k) dst[n][k] = *(const LAS bf16x8*)(lds + PG8_SB(b, h) + boff + n * 2048 + k * 1024); } while (0)
#define PG8_MMA(ai, bj, At, Bt) do { __builtin_amdgcn_s_setprio(1); _Pragma("unroll") for (int m = 0; m < 4; ++m) _Pragma("unroll") for (int n = 0; n < 2; ++n) _Pragma("unroll") for (int k = 0; k < 2; ++k) \
        acc[ai][bj][m][n] = __builtin_amdgcn_mfma_f32_16x16x32_bf16(Bt[n][k], At[m][k], acc[ai][bj][m][n], 0, 0, 0); __builtin_amdgcn_s_setprio(0); } while (0)
#define PG8_WAIT_V(n) asm volatile("s_waitcnt vmcnt(" #n ")" ::: "memory")
#define PG8_WAIT_L(n) asm volatile("s_waitcnt lgkmcnt(" #n ")" ::: "memory")
#define PG8_BAR __builtin_amdgcn_s_barrier()
#define PG8_SCHED __builtin_amdgcn_sched_barrier(0)

template <class Epi, class Sched, bool GATHER>
__device__ __forceinline__ void gemm_phase(LAS unsigned char* lds, const Gemm g, const Sched& S, const Epi& E, const LAS int* tab, int wave_s) {
    unsigned zz = 0u; asm volatile("" : "+s"(zz)); const int lane = (int)__builtin_amdgcn_mbcnt_hi(~0u, __builtin_amdgcn_mbcnt_lo(~0u, zz));
    const int wid = wave_s, tid = wid * 64 + lane, wr = wid >> 2, wc = wid & 3, fr = lane & 15, fq = lane >> 4;
    const int K = g.K, nt = K / BK;
    unsigned voffA[2], voffB[2]; unsigned gvA[2][2];
#pragma unroll
    for (int i = 0; i < 2; ++i) { int R, C; stage_rc(tid * 16 + i * 8192, R, C); const int Rb = Epi::PERM ? ((R & ~31) + perm32(R & 31)) : R;
        voffA[i] = (unsigned)(R * K + C) * 2u; voffB[i] = (unsigned)(Rb * K + C) * 2u; }
#define PG8_GATHER_OFFS(slot_) do { unsigned zq = 0u; asm volatile("" : "+s"(zq)); const int lq = (int)__builtin_amdgcn_mbcnt_hi(~0u, __builtin_amdgcn_mbcnt_lo(~0u, zq)); \
        _Pragma("unroll") for (int i_ = 0; i_ < 2; ++i_) { int R_, C_; stage_rc((wid * 64 + lq) * 16 + i_ * 8192, R_, C_); \
            _Pragma("unroll") for (int h_ = 0; h_ < 2; ++h_) gvA[h_][i_] = (unsigned)(tab[(slot_) * 256 + h_ * HALF + R_] * K + C_) * 2u; } } while (0)
    const size_t kstep = (size_t)(BK * 2);
    const size_t hstep = (size_t)HALF * K * 2;
    const unsigned ldsw = (unsigned)wid * 1024u;
    const int aoff = lds_byte(wr * 64 + fr, fq * 8), boff = lds_byte(wc * 32 + fr, fq * 8);
    Unit cur, nxt; int ui = 0;
    if (!S.next(0, cur)) return;
    f32x4 acc[2][2][4][2];
#pragma unroll
    for (int a = 0; a < 2; ++a)
#pragma unroll
        for (int b = 0; b < 2; ++b)
#pragma unroll
            for (int m = 0; m < 4; ++m)
#pragma unroll
                for (int n = 0; n < 2; ++n) acc[a][b][m][n] = (f32x4){0.f, 0.f, 0.f, 0.f};
    bf16x8 At[4][2], B0[2][2], B1[2][2];
    const char* cA; const char* cB;
    if (GATHER) {
        cA = (const char*)g.A;
        PG8_GATHER_OFFS(cur.slot);
    } else cA = (const char*)(g.A + (size_t)cur.g * g.astride) + (size_t)cur.r0 * K * 2;
    cB = (const char*)(g.Bt + (size_t)cur.g * g.bstride) + (size_t)cur.pn * BM * K * 2;
#define PG8_STAGE_A(bufoff, base, h, gv) do { if (GATHER) PG8_STAGE(bufoff, base, gv[h]); else PG8_STAGE(bufoff, (base) + (h) * hstep, voffA); } while (0)
    PG8_STAGE(PG8_SB(0, 0), cB, voffB); PG8_STAGE_A(PG8_SA(0, 0), cA, 0, gvA); PG8_STAGE(PG8_SB(0, 1), cB + hstep, voffB); PG8_STAGE_A(PG8_SA(0, 1), cA, 1, gvA);
    if (wr == 1) PG8_BAR;
    PG8_WAIT_V(4); PG8_BAR;
    PG8_STAGE(PG8_SB(1, 0), cB + kstep, voffB); PG8_STAGE_A(PG8_SA(1, 0), cA + kstep, 0, gvA); PG8_STAGE(PG8_SB(1, 1), cB + hstep + kstep, voffB);
    PG8_WAIT_V(6); PG8_BAR;
    for (;;) {
        const bool has_next = S.next(ui + 1, nxt);
        const char* nA; const char* nB;
        if (has_next) {
            nA = GATHER ? (const char*)g.A : (const char*)(g.A + (size_t)nxt.g * g.astride) + (size_t)nxt.r0 * K * 2;
            nB = (const char*)(g.Bt + (size_t)nxt.g * g.bstride) + (size_t)nxt.pn * BM * K * 2;
        } else { nA = cA; nB = cB; }
        for (int t = 0; t < nt; t += 2) {
            const bool last = (t == nt - 2);
            const char* a1 = cA + (size_t)(t + 1) * kstep;
            const char* a2 = last ? nA : cA + (size_t)(t + 2) * kstep; const char* b2 = last ? nB : cB + (size_t)(t + 2) * kstep;
            const char* a3 = a2 + kstep; const char* b3 = b2 + kstep;
            PG8_LDB(B0, 0, 0); PG8_SCHED; PG8_LDA(At, 0, 0); PG8_STAGE_A(PG8_SA(1, 1), a1, 1, gvA);
            PG8_WAIT_L(8); PG8_BAR; PG8_WAIT_L(0); PG8_MMA(0, 0, At, B0); PG8_BAR; PG8_SCHED;
            if (GATHER && last && has_next) PG8_GATHER_OFFS(nxt.slot);
            PG8_LDB(B1, 0, 1); PG8_STAGE(PG8_SB(0, 0), b2, voffB);
            PG8_BAR; PG8_WAIT_L(0); PG8_MMA(0, 1, At, B1); PG8_BAR;
            PG8_LDA(At, 0, 1); PG8_STAGE_A(PG8_SA(0, 0), a2, 0, gvA);
            PG8_BAR; PG8_WAIT_L(0); PG8_MMA(1, 0, At, B0); PG8_BAR; PG8_SCHED;
            PG8_STAGE(PG8_SB(0, 1), b2 + hstep, voffB);
            PG8_WAIT_V(6); PG8_BAR; PG8_MMA(1, 1, At, B1); PG8_BAR;
            PG8_LDB(B0, 1, 0); PG8_SCHED; PG8_LDA(At, 1, 0); PG8_STAGE_A(PG8_SA(0, 1), a2, 1, gvA);
            PG8_WAIT_L(8); PG8_BAR; PG8_WAIT_L(0); PG8_MMA(0, 0, At, B0); PG8_BAR; PG8_SCHED;
            PG8_LDB(B1, 1, 1); PG8_STAGE(PG8_SB(1, 0), b3, voffB);
            PG8_BAR; PG8_WAIT_L(0); PG8_MMA(0, 1, At, B1); PG8_BAR;
            PG8_LDA(At, 1, 1); PG8_STAGE_A(PG8_SA(1, 0), a3, 0, gvA);
            PG8_BAR; PG8_WAIT_L(0); PG8_MMA(1, 0, At, B0); PG8_BAR; PG8_SCHED;
            PG8_STAGE(PG8_SB(1, 1), b3 + hstep, voffB);
            PG8_WAIT_V(6); PG8_BAR; PG8_MMA(1, 1, At, B1); PG8_BAR;
        }
        { unsigned z2 = 0u; asm volatile("" : "+s"(z2)); const int lz = (int)__builtin_amdgcn_mbcnt_hi(~0u, __builtin_amdgcn_mbcnt_lo(~0u, z2));
          E(acc, cur, wr, wc, lz & 15, lz >> 4); }
        if (!has_next) break;
#pragma unroll
        for (int a = 0; a < 2; ++a)
#pragma unroll
            for (int b = 0; b < 2; ++b)
#pragma unroll
                for (int m = 0; m < 4; ++m)
#pragma unroll
                    for (int n = 0; n < 2; ++n) acc[a][b][m][n] = (f32x4){0.f, 0.f, 0.f, 0.f};
        cur = nxt; cA = nA; cB = nB; ++ui;
    }
    PG8_WAIT_V(0);
    if (wr == 0) PG8_BAR;
    PG8_BAR;
#undef PG8_STAGE_A
#undef PG8_GATHER_OFFS
}

struct EpiBf16 {
    static constexpr bool PERM = true;
    bf16_t* O; int ldc; size_t ostride; int split_cols; size_t split_stride;
    __device__ __forceinline__ void operator()(const f32x4 (&acc)[2][2][4][2], const Unit& u, int wr, int wc, int fr, int fq) const {
        const int row0 = u.r0 + wr * 64 + fr; int colt = u.pn * BM; bf16_t* base = O + (size_t)u.g * ostride;
        if (split_cols) { const int t = colt / split_cols; base += (size_t)t * split_stride; colt -= t * split_cols; }
        const int col0 = colt + wc * 32 + 8 * fq;
#pragma unroll
        for (int ai = 0; ai < 2; ++ai)
#pragma unroll
            for (int m = 0; m < 4; ++m) { bf16_t* rowp = base + (size_t)(row0 + ai * HALF + m * 16) * ldc + col0;
#pragma unroll
                for (int bj = 0; bj < 2; ++bj) { const f32x4 v0 = acc[ai][bj][m][0], v1 = acc[ai][bj][m][1];
                    u32x4 w; w.x = cvt_pk_bf16(v0[0], v0[1]); w.y = cvt_pk_bf16(v0[2], v0[3]); w.z = cvt_pk_bf16(v1[0], v1[1]); w.w = cvt_pk_bf16(v1[2], v1[3]);
                    *(u32x4*)(rowp + bj * HALF) = w; } }
    }
};
struct EpiProjMk {
    static constexpr bool PERM = true;
    bf16_t* proj5; bf16_t* misc; float* widx; bf16_t* kidxf;
    __device__ __forceinline__ void operator()(const f32x4 (&acc)[2][2][4][2], const Unit& u, int wr, int wc, int fr, int fq) const {
        const int row0 = u.r0 + wr * 64 + fr; const bool m10 = (u.pn == 8);
        bf16_t* base = m10 ? misc : proj5 + (size_t)(u.pn >> 1) * ((size_t)NTOK * 512) + (u.pn & 1) * 256;
        const int ldc = m10 ? 256 : 512; const int col0 = wc * 32 + 8 * fq;
#pragma unroll
        for (int ai = 0; ai < 2; ++ai)
#pragma unroll
            for (int m = 0; m < 4; ++m) { const int row = row0 + ai * HALF + m * 16; bf16_t* rowp = base + (size_t)row * ldc + col0;
#pragma unroll
                for (int bj = 0; bj < 2; ++bj) { const f32x4 v0 = acc[ai][bj][m][0], v1 = acc[ai][bj][m][1];
                    u32x4 w; w.x = cvt_pk_bf16(v0[0], v0[1]); w.y = cvt_pk_bf16(v0[2], v0[3]); w.z = cvt_pk_bf16(v1[0], v1[1]); w.w = cvt_pk_bf16(v1[2], v1[3]);
                    *(u32x4*)(rowp + bj * HALF) = w;
                    if (m10 && bj == 1 && col0 == 64) { const float s = 0.35355339059327373f; float* wp = widx + (size_t)row * 8;
                        *(f32x4*)wp = v0 * s; *(f32x4*)(wp + 4) = v1 * s; }
                    if (m10 && bj == 1 && col0 < 64) *(u32x4*)(kidxf + ((size_t)(row >> 5) * 4 + (col0 >> 4)) * 512 + ((col0 >> 3) & 1) * 256 + (row & 31) * 8) = w; } }
    }
};
struct EpiSwiglu {
    static constexpr bool PERM = true;
    bf16_t* O;
    __device__ __forceinline__ void operator()(const f32x4 (&acc)[2][2][4][2], const Unit& u, int wr, int wc, int fr, int fq) const {
        const int col0 = u.pn * 128 + wc * 32 + 8 * fq;
#pragma unroll
        for (int ai = 0; ai < 2; ++ai)
#pragma unroll
            for (int m = 0; m < 4; ++m) { const int r = ai * HALF + wr * 64 + m * 16 + fr;
                float h[8];
#pragma unroll
                for (int n = 0; n < 2; ++n)
#pragma unroll
                    for (int j = 0; j < 4; ++j) { const float gv = acc[ai][0][m][n][j], uv = acc[ai][1][m][n][j]; h[n * 4 + j] = gv * __builtin_amdgcn_rcpf(1.0f + __expf(-gv)) * uv; }
                u32x4 w; w.x = cvt_pk_bf16(h[0], h[1]); w.y = cvt_pk_bf16(h[2], h[3]); w.z = cvt_pk_bf16(h[4], h[5]); w.w = cvt_pk_bf16(h[6], h[7]);
                if (r < u.nv) *(u32x4*)(O + (size_t)(u.r0 + r) * 256 + col0) = w; }
    }
};
struct EpiAxpyHMk {
    static constexpr bool PERM = false;
    float* H;
    __device__ __forceinline__ void operator()(const f32x4 (&acc)[2][2][4][2], const Unit& u, int wr, int wc, int fr, int fq) const {
        const int row0 = u.r0 + wr * 64 + fr, col0 = u.pn * BM + wc * 32 + 4 * fq;
#pragma unroll
        for (int ai = 0; ai < 2; ++ai)
#pragma unroll
            for (int m = 0; m < 4; ++m) { float* rowp = H + (size_t)(row0 + ai * HALF + m * 16) * D + col0;
#pragma unroll
                for (int bj = 0; bj < 2; ++bj)
#pragma unroll
                    for (int n = 0; n < 2; ++n) { f32x4* p = (f32x4*)(rowp + bj * HALF + n * 16); const f32x4 h = *p; *p = h * ALPHA + acc[ai][bj][m][n]; }
                asm volatile("" ::: "memory"); }
    }
};
struct EpiLogit {
    static constexpr bool PERM = false;
    float* L;
    __device__ __forceinline__ void operator()(const f32x4 (&acc)[2][2][4][2], const Unit& u, int wr, int wc, int fr, int fq) const {
        if (wc < 2) {
            const int row0 = u.r0 + wr * 64 + fr, col0 = wc * 32 + 4 * fq;
#pragma unroll
            for (int ai = 0; ai < 2; ++ai)
#pragma unroll
                for (int m = 0; m < 4; ++m) { float* rowp = L + (size_t)(row0 + ai * HALF + m * 16) * N_EXP + col0;
#pragma unroll
                    for (int n = 0; n < 2; ++n) *(f32x4*)(rowp + n * 16) = acc[ai][0][m][n]; }
        }
    }
};
struct EpiSlot {
    static constexpr bool PERM = true;
    bf16_t* slot; const int* list; const float* gate;
    const LAS int* ag;
    __device__ __forceinline__ void operator()(const f32x4 (&acc)[2][2][4][2], const Unit& u, int wr, int wc, int fr, int fq) const {
        const int col0 = u.pn * BM + wc * 32 + 8 * fq;
#pragma unroll
        for (int ai = 0; ai < 2; ++ai)
#pragma unroll
            for (int m = 0; m < 4; ++m) { const int r = ai * HALF + wr * 64 + m * 16 + fr;
                if (r < u.nv) { int aid; float gt;
                    if (u.slot < MOE_AGU) { const i32x2 t = *(const LAS i32x2*)(ag + (u.slot * 256 + r) * 2); aid = t.x; gt = __int_as_float(t.y); }
                    else { aid = list[u.lr0 + r]; gt = gate[aid]; }
                    bf16_t* rowp = slot + (size_t)aid * D + col0;
#pragma unroll
                    for (int bj = 0; bj < 2; ++bj) { const f32x4 v0 = acc[ai][bj][m][0] * gt, v1 = acc[ai][bj][m][1] * gt;
                        u32x4 w; w.x = cvt_pk_bf16(v0[0], v0[1]); w.y = cvt_pk_bf16(v0[2], v0[3]); w.z = cvt_pk_bf16(v1[0], v1[1]); w.w = cvt_pk_bf16(v1[2], v1[3]);
                        *(u32x4*)(rowp + bj * HALF) = w; } } }
    }
};
struct EpiVT {
    static constexpr bool PERM = true;
    bf16_t* O; int ldc; size_t ostride;
    __device__ __forceinline__ void operator()(const f32x4 (&acc)[2][2][4][2], const Unit& u, int wr, int wc, int fr, int fq) const {
        const int row0 = u.r0 + wr * 64 + fr; bf16_t* base = O + (size_t)u.g * ostride;
        const int c0 = wc * 32 + 8 * fq, n32 = c0 & 31, pos0 = 8 * ((n32 >> 2) & 3) + 4 * (n32 >> 4);
        const int col0 = u.pn * BM + (c0 & ~31) + pos0;
#pragma unroll
        for (int ai = 0; ai < 2; ++ai)
#pragma unroll
            for (int m = 0; m < 4; ++m) { bf16_t* rowp = base + (size_t)(row0 + ai * HALF + m * 16) * ldc + col0;
#pragma unroll
                for (int bj = 0; bj < 2; ++bj) { const f32x4 v0 = acc[ai][bj][m][0], v1 = acc[ai][bj][m][1];
                    u32x2 w0, w1; w0.x = cvt_pk_bf16(v0[0], v0[1]); w0.y = cvt_pk_bf16(v0[2], v0[3]); w1.x = cvt_pk_bf16(v1[0], v1[1]); w1.y = cvt_pk_bf16(v1[2], v1[3]);
                    *(u32x2*)(rowp + bj * HALF) = w0; *(u32x2*)(rowp + bj * HALF + 8) = w1; } }
    }
};
}

__device__ __forceinline__ f32x4 mfma16(bf16x8 a, bf16x8 b, f32x4 c) { return __builtin_amdgcn_mfma_f32_16x16x32_bf16(a, b, c, 0, 0, 0); }
__device__ __forceinline__ bf16x8 pack8(const f32x4& a, const f32x4& b) {
    u32x4 w; w.x = cvt_pk_bf16(a[0], a[1]); w.y = cvt_pk_bf16(a[2], a[3]); w.z = cvt_pk_bf16(b[0], b[1]); w.w = cvt_pk_bf16(b[2], b[3]);
    return __builtin_bit_cast(bf16x8, w);
}
__device__ __forceinline__ int lane_id() { unsigned z = 0u; asm volatile("" : "+s"(z)); return (int)__builtin_amdgcn_mbcnt_hi(~0u, __builtin_amdgcn_mbcnt_lo(~0u, z)); }
__device__ __forceinline__ float relu_f(float x) { const int b = __float_as_int(x); return __int_as_float(b > 0 ? b : 0); }
__device__ __forceinline__ float negbig() { float v; asm volatile("v_mov_b32 %0, 0xf149f2ca" : "=v"(v)); return v; }
__device__ __forceinline__ float shx(float v, int lane, int mask) { return __int_as_float(__builtin_amdgcn_ds_bpermute((lane ^ mask) << 2, __float_as_int(v))); }
__device__ __forceinline__ float xmax16_32(float v, int lane) { v = fmaxf(v, shx(v, lane, 16)); return fmaxf(v, shx(v, lane, 32)); }
__device__ __forceinline__ float xsum16_32(float v, int lane) { v += shx(v, lane, 16); return v + shx(v, lane, 32); }
__device__ __forceinline__ float wave_total(float v) {
    v += __int_as_float(__builtin_amdgcn_update_dpp(0, __float_as_int(v), 0x111, 0xf, 0xf, true));
    v += __int_as_float(__builtin_amdgcn_update_dpp(0, __float_as_int(v), 0x112, 0xf, 0xf, true));
    v += __int_as_float(__builtin_amdgcn_update_dpp(0, __float_as_int(v), 0x114, 0xf, 0xf, true));
    v += __int_as_float(__builtin_amdgcn_update_dpp(0, __float_as_int(v), 0x118, 0xf, 0xf, true));
    v += __int_as_float(__builtin_amdgcn_update_dpp(0, __float_as_int(v), 0x142, 0xa, 0xf, false));
    v += __int_as_float(__builtin_amdgcn_update_dpp(0, __float_as_int(v), 0x143, 0xc, 0xf, false));
    return __int_as_float(__builtin_amdgcn_readlane(__float_as_int(v), 63));
}
__device__ __forceinline__ float wsum(float v, int lane) { (void)lane; return wave_total(v); }
typedef __attribute__((address_space(8))) void* rsrc_t;
typedef __amdgpu_buffer_rsrc_t brsrc_t;
__device__ __forceinline__ brsrc_t make_rsrc(const void* p, unsigned bytes) { return __builtin_amdgcn_make_buffer_rsrc((void*)p, 0, (int)bytes, 0x00020000); }
__device__ __forceinline__ bf16x8 bld16(brsrc_t r, unsigned voff, unsigned soff) { return __builtin_bit_cast(bf16x8, __builtin_amdgcn_raw_buffer_load_b128(r, (int)voff, (int)soff, 0)); }
constexpr float LOG2E = 1.4426950408889634f;
constexpr float SM_THR = 8.0f;

#define MEMFENCE() asm volatile("" ::: "memory")
__device__ __forceinline__ void diff_attn_wave(const bf16* QB, brsrc_t rK, brsrc_t rV, bf16* CAT, int b, int h, int q0, float lam, float lambda_init, const float* subln, int lane) {
    const int qi = lane & 15, g = lane >> 4, tq = q0 + qi, cq = q0 >> 6;
    const float slope = exp2f(-2.0f * (float)(h + 1)), c1 = 0.125f * LOG2E, kb = slope * 8.0f;
    const bf16* qrow = QB + (size_t)(b * SEQ + tq) * 512 + h * 128;
    bf16x8 qf[2][2];
#pragma unroll
    for (int m = 0; m < 2; ++m)
#pragma unroll
        for (int s = 0; s < 2; ++s) qf[m][s] = *(const bf16x8*)(qrow + m * 64 + 32 * s + 8 * g);
    f32x4 o1[8], o2[8];
#pragma unroll
    for (int i = 0; i < 8; ++i) { o1[i] = (f32x4){0.f, 0.f, 0.f, 0.f}; o2[i] = (f32x4){0.f, 0.f, 0.f, 0.f}; }
    float m1 = negbig(), m2 = negbig(), l1 = 0.f, l2 = 0.f;
    const unsigned kvo = (unsigned)(((lane & 15) * 512 + h * 128 + 8 * g) * 2);
    const unsigned vvo = (unsigned)(((h * 128 + (lane & 15)) * VTD_LD + 8 * g) * 2);
    bf16x8 kf[2][4];
    { const int base = 32 * (2 * cq + 1);
#pragma unroll
      for (int sub = 0; sub < 2; ++sub) { const unsigned so = (unsigned)(b * SEQ + base + 16 * sub) * 1024u;
#pragma unroll
          for (int j = 0; j < 4; ++j) kf[sub][j] = bld16(rK, kvo + 64 * j, so); } }
    MEMFENCE();
#pragma unroll 1
    for (int grp = 2 * cq + 1; grp >= 0; --grp) {
        const int base = 32 * grp;
        bf16x8 vf[8];
        { const unsigned sv = (unsigned)(b * SEQ + base) * 2u;
#pragma unroll
          for (int ds = 0; ds < 8; ++ds) vf[ds] = bld16(rV, vvo, sv + (unsigned)ds * (16u * VTD_LD * 2u)); }
        MEMFENCE();
        f32x4 s1[2], s2[2];
#pragma unroll
        for (int sub = 0; sub < 2; ++sub) {
            f32x4 init;
#pragma unroll
            for (int i = 0; i < 4; ++i) { const int key = base + 16 * sub + 4 * g + i; const int kk = key < 2 * tq - key ? key : 2 * tq - key; init[i] = kb * (float)(kk - 64 * cq); }
            s1[sub] = mfma16(kf[sub][0], qf[0][0], init); s1[sub] = mfma16(kf[sub][1], qf[0][1], s1[sub]);
            s2[sub] = mfma16(kf[sub][2], qf[1][0], init); s2[sub] = mfma16(kf[sub][3], qf[1][1], s2[sub]);
        }
        { const int nb = (grp > 0) ? base - 32 : base;
#pragma unroll
          for (int sub = 0; sub < 2; ++sub) { const unsigned so = (unsigned)(b * SEQ + nb + 16 * sub) * 1024u;
#pragma unroll
              for (int j = 0; j < 4; ++j) kf[sub][j] = bld16(rK, kvo + 64 * j, so); } }
        MEMFENCE();
        float mx1 = fmaxf(fmaxf(fmaxf(s1[0][0], s1[0][1]), fmaxf(s1[0][2], s1[0][3])), fmaxf(fmaxf(s1[1][0], s1[1][1]), fmaxf(s1[1][2], s1[1][3])));
        float mx2 = fmaxf(fmaxf(fmaxf(s2[0][0], s2[0][1]), fmaxf(s2[0][2], s2[0][3])), fmaxf(fmaxf(s2[1][0], s2[1][1]), fmaxf(s2[1][2], s2[1][3])));
        const float t1 = c1 * xmax16_32(mx1, lane), t2 = c1 * xmax16_32(mx2, lane);
        if (__any((t1 > m1 + SM_THR) || (t2 > m2 + SM_THR))) {
            const float n1 = fmaxf(m1, t1), n2 = fmaxf(m2, t2), a1 = __builtin_amdgcn_exp2f(m1 - n1), a2 = __builtin_amdgcn_exp2f(m2 - n2);
            l1 *= a1; l2 *= a2; m1 = n1; m2 = n2;
#pragma unroll
            for (int i = 0; i < 8; ++i) { o1[i] *= a1; o2[i] *= a2; }
        }
#pragma unroll
        for (int sub = 0; sub < 2; ++sub)
#pragma unroll
            for (int i = 0; i < 4; ++i) { s1[sub][i] = __builtin_amdgcn_exp2f(c1 * s1[sub][i] - m1); s2[sub][i] = __builtin_amdgcn_exp2f(c1 * s2[sub][i] - m2); l1 += s1[sub][i]; l2 += s2[sub][i]; }
        const bf16x8 p1 = pack8(s1[0], s1[1]), p2 = pack8(s2[0], s2[1]);
#pragma unroll
        for (int ds = 0; ds < 8; ++ds) { o1[ds] = mfma16(vf[ds], p1, o1[ds]); o2[ds] = mfma16(vf[ds], p2, o2[ds]); }
    }
    l1 = xsum16_32(l1, lane); l2 = xsum16_32(l2, lane);
    const float i1 = __builtin_amdgcn_rcpf(l1), i2 = lam * __builtin_amdgcn_rcpf(l2); float ss = 0.f;
#pragma unroll
    for (int ds = 0; ds < 8; ++ds)
#pragma unroll
        for (int i = 0; i < 4; ++i) { const float v = o1[ds][i] * i1 - o2[ds][i] * i2; o1[ds][i] = v; ss += v * v; }
    ss = xsum16_32(ss, lane);
    const float r = __builtin_amdgcn_rsqf(ss * (1.0f / 128.0f) + RMS_EPS) * (1.0f - lambda_init);
    bf16* orow = CAT + (size_t)(b * SEQ + tq) * D + 512 + h * 128 + 4 * g;
#pragma unroll
    for (int ds = 0; ds < 8; ++ds) { const f32x4 sl = *(const f32x4*)(subln + 16 * ds + 4 * g); const f32x4 y = o1[ds] * r * sl;
        u32x2 w; w.x = cvt_pk_bf16(y[0], y[1]); w.y = cvt_pk_bf16(y[2], y[3]); *(u32x2*)(orow + 16 * ds) = w; }
}

__device__ __forceinline__ void diff_attn_unit(LAS unsigned char* lds, const bf16* QB, const bf16* KB, const bf16* VT, bf16* CAT, int b, int h, int ub, int wave, float lam, float lambda_init, const float* subln) {
    const int lane = lane_id(), tid = wave * 64 + lane;
    const int qi = lane & 15, g = lane >> 4, q0 = 128 * ub + 16 * wave, tq = q0 + qi, cq = q0 >> 6;
    float c1 = 0.125f * LOG2E; asm volatile("" : "+v"(c1));
    const float kb2 = exp2f(-2.0f * (float)(h + 1)) * LOG2E;
    const bf16* qrow = QB + (size_t)(b * SEQ + tq) * 512 + h * 128;
    bf16x8 qf[2][2];
#pragma unroll
    for (int m = 0; m < 2; ++m)
#pragma unroll
        for (int s = 0; s < 2; ++s) { const u32x4 r = *(const u32x4*)(qrow + m * 64 + 32 * s + 8 * g); u32x4 w;
            w.x = cvt_pk_bf16(__uint_as_float(r.x << 16) * c1, __uint_as_float(r.x & 0xffff0000u) * c1); w.y = cvt_pk_bf16(__uint_as_float(r.y << 16) * c1, __uint_as_float(r.y & 0xffff0000u) * c1);
            w.z = cvt_pk_bf16(__uint_as_float(r.z << 16) * c1, __uint_as_float(r.z & 0xffff0000u) * c1); w.w = cvt_pk_bf16(__uint_as_float(r.w << 16) * c1, __uint_as_float(r.w & 0xffff0000u) * c1);
            qf[m][s] = __builtin_bit_cast(bf16x8, w); }
    unsigned one2 = 0x3f803f80u; asm volatile("" : "+v"(one2));
    const bf16x8 ones = __builtin_bit_cast(bf16x8, (u32x4){one2, one2, one2, one2});
    f32x4 o1[8], o2[8], ol1, ol2;
    { float z = 0.f; asm volatile("" : "+v"(z));
#pragma unroll
      for (int i = 0; i < 8; ++i) { o1[i] = (f32x4){z, z, z, z}; o2[i] = (f32x4){z, z, z, z}; }
      ol1 = (f32x4){z, z, z, z}; ol2 = (f32x4){z, z, z, z}; }
    float m1 = 0.f, m2 = 0.f; bool first = true;
    float ib[2][4];
#pragma unroll
    for (int sub = 0; sub < 2; ++sub)
#pragma unroll
        for (int i = 0; i < 4; ++i) ib[sub][i] = kb2 * (float)(16 * sub + 4 * g + i);
    const int skey = tid >> 4, sch = tid & 15, sd = tid >> 2, svc = tid & 3;
    const bf16* kg = KB + (size_t)(b * SEQ + skey) * 512 + h * 128 + sch * 8;
    const bf16* vg = VT + (size_t)(h * 128 + sd) * VTD_LD + (size_t)b * SEQ + 8 * svc;
    const unsigned kdst = (unsigned)(skey * 256 + ((sch ^ (skey & 15)) * 16)), vdst = (unsigned)(8192 + sd * 64 + (((svc + (sd >> 2)) & 3) * 16));
    unsigned ka[2][4], va[8];
#pragma unroll
    for (int sub = 0; sub < 2; ++sub)
#pragma unroll
        for (int j = 0; j < 4; ++j) { const int row = 16 * sub + qi; ka[sub][j] = (unsigned)(row * 256 + (((4 * j + g) ^ (row & 15)) * 16)); }
#pragma unroll
    for (int ds = 0; ds < 8; ++ds) { const int d = 16 * ds + qi; va[ds] = (unsigned)(8192 + d * 64 + (((g + (d >> 2)) & 3) * 16)); }
    const int gmax = 4 * ub + 3, gmine = 2 * cq + 1;
    u32x4 kregA = *(const u32x4*)(kg + (size_t)(32 * gmax) * 512), vregA = *(const u32x4*)(vg + 32 * gmax);
    u32x4 kregB = *(const u32x4*)(kg + (size_t)(32 * (gmax - 1)) * 512), vregB = *(const u32x4*)(vg + 32 * (gmax - 1));
#pragma unroll 1
    for (int gp = gmax; gp >= 1; gp -= 2) {
      LAS unsigned char* sb = lds + (((gp >> 1) & 1) ? 32768 : 0);
      *(LAS u32x4*)(sb + 16384 + kdst) = kregA; *(LAS u32x4*)(sb + 16384 + vdst) = vregA; *(LAS u32x4*)(sb + kdst) = kregB; *(LAS u32x4*)(sb + vdst) = vregB;
      { const int na = gp > 1 ? gp - 2 : 1, nb = na - 1;
        kregA = *(const u32x4*)(kg + (size_t)(32 * na) * 512); vregA = *(const u32x4*)(vg + 32 * na); kregB = *(const u32x4*)(kg + (size_t)(32 * nb) * 512); vregB = *(const u32x4*)(vg + 32 * nb); }
      MEMFENCE();
      __syncthreads();
      if (gp <= gmine) {
        f32x4 s1[2][2], s2[2][2];
#pragma unroll
        for (int half = 0; half < 2; ++half) {
            const int grp = gp - half, base = 32 * grp;
            LAS unsigned char* buf = sb + ((grp & 1) ? 16384 : 0);
            bf16x8 kf[2][4];
#pragma unroll
            for (int sub = 0; sub < 2; ++sub)
#pragma unroll
                for (int j = 0; j < 4; ++j) kf[sub][j] = *(const LAS bf16x8*)(buf + ka[sub][j]);
            __builtin_amdgcn_sched_barrier(0);
            if (base + 31 <= q0) {
                const float gb = kb2 * (float)(base - 64 * cq), g1 = gb - m1, g2 = gb - m2;
#pragma unroll
                for (int sub = 0; sub < 2; ++sub)
#pragma unroll
                    for (int i = 0; i < 4; ++i) { s1[half][sub][i] = ib[sub][i] + g1; s2[half][sub][i] = ib[sub][i] + g2; }
            } else {
#pragma unroll
                for (int sub = 0; sub < 2; ++sub)
#pragma unroll
                    for (int i = 0; i < 4; ++i) { const int key = base + 16 * sub + 4 * g + i; const int kk = key < 2 * tq - key ? key : 2 * tq - key; const float bv = kb2 * (float)(kk - 64 * cq); s1[half][sub][i] = bv - m1; s2[half][sub][i] = bv - m2; }
            }
#pragma unroll
            for (int sub = 0; sub < 2; ++sub) {
                s1[half][sub] = mfma16(kf[sub][0], qf[0][0], s1[half][sub]); s2[half][sub] = mfma16(kf[sub][2], qf[1][0], s2[half][sub]);
                s1[half][sub] = mfma16(kf[sub][1], qf[0][1], s1[half][sub]); s2[half][sub] = mfma16(kf[sub][3], qf[1][1], s2[half][sub]);
            }
        }
#pragma unroll
        for (int half = 0; half < 2; ++half) {
            const int grp = gp - half;
            LAS unsigned char* buf = sb + ((grp & 1) ? 16384 : 0);
            const float mx1 = fmaxf(fmaxf(fmaxf(s1[half][0][0], s1[half][0][1]), fmaxf(s1[half][0][2], s1[half][0][3])), fmaxf(fmaxf(s1[half][1][0], s1[half][1][1]), fmaxf(s1[half][1][2], s1[half][1][3])));
            const float mx2 = fmaxf(fmaxf(fmaxf(s2[half][0][0], s2[half][0][1]), fmaxf(s2[half][0][2], s2[half][0][3])), fmaxf(fmaxf(s2[half][1][0], s2[half][1][1]), fmaxf(s2[half][1][2], s2[half][1][3])));
            if (first || __any((mx1 > -30.0f) || (mx2 > -30.0f))) {
                bf16x8 vf[8];
#pragma unroll
                for (int ds = 0; ds < 8; ++ds) vf[ds] = *(const LAS bf16x8*)(buf + va[ds]);
                __builtin_amdgcn_sched_barrier(0);
                if (first || __any((mx1 > SM_THR) || (mx2 > SM_THR))) {
                    const float t1 = xmax16_32(mx1, lane), t2 = xmax16_32(mx2, lane);
                    const float d1 = first ? t1 : fmaxf(t1, 0.f), d2 = first ? t2 : fmaxf(t2, 0.f);
                    m1 += d1; m2 += d2;
                    if (!first) { const float a1 = __builtin_amdgcn_exp2f(-d1), a2 = __builtin_amdgcn_exp2f(-d2);
#pragma unroll
                        for (int i = 0; i < 8; ++i) { o1[i] *= a1; o2[i] *= a2; }
                        ol1 *= a1; ol2 *= a2; }
#pragma unroll
                    for (int hh2 = half; hh2 < 2; ++hh2)
#pragma unroll
                        for (int sub = 0; sub < 2; ++sub)
#pragma unroll
                            for (int i = 0; i < 4; ++i) { s1[hh2][sub][i] -= d1; s2[hh2][sub][i] -= d2; }
                    first = false;
                }
#pragma unroll
                for (int sub = 0; sub < 2; ++sub)
#pragma unroll
                    for (int i = 0; i < 4; ++i) { s1[half][sub][i] = __builtin_amdgcn_exp2f(s1[half][sub][i]); s2[half][sub][i] = __builtin_amdgcn_exp2f(s2[half][sub][i]); }
                const bf16x8 p1 = pack8(s1[half][0], s1[half][1]), p2 = pack8(s2[half][0], s2[half][1]);
#pragma unroll
                for (int ds = 0; ds < 8; ++ds) { o1[ds] = mfma16(vf[ds], p1, o1[ds]); o2[ds] = mfma16(vf[ds], p2, o2[ds]); }
                ol1 = mfma16(ones, p1, ol1); ol2 = mfma16(ones, p2, ol2);
            }
        }
      }
    }
    const float i1 = __builtin_amdgcn_rcpf(ol1[0]), i2 = lam * __builtin_amdgcn_rcpf(ol2[0]); float ss = 0.f;
    f32x4 sl[8];
#pragma unroll
    for (int ds = 0; ds < 8; ++ds) sl[ds] = *(const f32x4*)(subln + 16 * ds + 4 * g);
#pragma unroll
    for (int ds = 0; ds < 8; ++ds)
#pragma unroll
        for (int i = 0; i < 4; ++i) { const float v = o1[ds][i] * i1 - o2[ds][i] * i2; o1[ds][i] = v; ss += v * v; }
    ss = xsum16_32(ss, lane);
    const float r = __builtin_amdgcn_rsqf(ss * (1.0f / 128.0f) + RMS_EPS) * (1.0f - lambda_init);
    bf16* orow = CAT + (size_t)(b * SEQ + tq) * D + 512 + h * 128 + 4 * g;
#pragma unroll
    for (int ds = 0; ds < 8; ++ds) { const f32x4 y = o1[ds] * r * sl[ds];
        u32x2 w; w.x = cvt_pk_bf16(y[0], y[1]); w.y = cvt_pk_bf16(y[2], y[3]); *(u32x2*)(orow + 16 * ds) = w; }
    __syncthreads();
}

__device__ __forceinline__ void mem_attn_wave(const bf16* QM, brsrc_t rK, brsrc_t rV, bf16* OM, int b, int h, int t0, int lane) {
    const int qi = lane & 15, g = lane >> 4; const float c1 = 0.0625f * LOG2E;
    const bf16* qrow = QM + (size_t)(t0 + qi) * D + h * 256 + 8 * g;
    bf16x8 qf[8];
#pragma unroll
    for (int s = 0; s < 8; ++s) qf[s] = *(const bf16x8*)(qrow + 32 * s);
    f32x4 o[16];
#pragma unroll
    for (int i = 0; i < 16; ++i) o[i] = (f32x4){0.f, 0.f, 0.f, 0.f};
    float mm = negbig(), ll = 0.f;
    const unsigned kvo = (unsigned)(((lane & 15) * KM_LD + h * 256 + 8 * g) * 2);
    const unsigned vvo = (unsigned)(((h * 256 + (lane & 15)) * VTM_LD + 8 * g) * 2);
    bf16x8 kf[8];
    { const unsigned so = (unsigned)(b * MEM_TOK) * (unsigned)(KM_LD * 2);
#pragma unroll
      for (int s = 0; s < 8; ++s) kf[s] = bld16(rK, kvo + 64 * s, so); }
    MEMFENCE();
#pragma unroll 1
    for (int grp = 0; grp < 8; ++grp) {
        const int base = 32 * grp;
        f32x4 sc[2];
#pragma unroll
        for (int sub = 0; sub < 2; ++sub) {
            f32x4 a = (f32x4){0.f, 0.f, 0.f, 0.f};
#pragma unroll
            for (int s = 0; s < 8; ++s) a = mfma16(kf[s], qf[s], a);
            sc[sub] = a;
            { const int nk = base + 16 * sub + 16; const unsigned so = (unsigned)(b * MEM_TOK + (nk < MEM_TOK ? nk : 0)) * (unsigned)(KM_LD * 2);
#pragma unroll
              for (int s = 0; s < 8; ++s) kf[s] = bld16(rK, kvo + 64 * s, so); }
            MEMFENCE();
        }
        bf16x8 vf[8];
        const unsigned sv = (unsigned)(b * MEM_TOK + base) * 2u;
#pragma unroll
        for (int ds = 0; ds < 8; ++ds) vf[ds] = bld16(rV, vvo, sv + (unsigned)ds * (16u * VTM_LD * 2u));
        MEMFENCE();
        const float mx = fmaxf(fmaxf(fmaxf(sc[0][0], sc[0][1]), fmaxf(sc[0][2], sc[0][3])), fmaxf(fmaxf(sc[1][0], sc[1][1]), fmaxf(sc[1][2], sc[1][3])));
        const float t = c1 * xmax16_32(mx, lane);
        if (__any(t > mm + SM_THR)) { const float n = fmaxf(mm, t), a = __builtin_amdgcn_exp2f(mm - n); ll *= a; mm = n;
#pragma unroll
            for (int i = 0; i < 16; ++i) o[i] *= a; }
#pragma unroll
        for (int sub = 0; sub < 2; ++sub)
#pragma unroll
            for (int i = 0; i < 4; ++i) { sc[sub][i] = __builtin_amdgcn_exp2f(c1 * sc[sub][i] - mm); ll += sc[sub][i]; }
        const bf16x8 pf = pack8(sc[0], sc[1]);
#pragma unroll
        for (int ds = 0; ds < 8; ++ds) o[ds] = mfma16(vf[ds], pf, o[ds]);
#pragma unroll
        for (int ds = 0; ds < 8; ++ds) vf[ds] = bld16(rV, vvo, sv + (unsigned)(ds + 8) * (16u * VTM_LD * 2u));
        MEMFENCE();
#pragma unroll
        for (int ds = 0; ds < 8; ++ds) o[ds + 8] = mfma16(vf[ds], pf, o[ds + 8]);
    }
    ll = xsum16_32(ll, lane); const float inv = __builtin_amdgcn_rcpf(ll);
    bf16* orow = OM + (size_t)(t0 + qi) * D + h * 256 + 4 * g;
#pragma unroll
    for (int ds = 0; ds < 16; ++ds) { const f32x4 y = o[ds] * inv; u32x2 w; w.x = cvt_pk_bf16(y[0], y[1]); w.y = cvt_pk_bf16(y[2], y[3]); *(u32x2*)(orow + 16 * ds) = w; }
}

__device__ __forceinline__ void mem_attn_unit(LAS unsigned char* lds, const bf16* QM, const bf16* KM, const bf16* VT, bf16* OM, int tb, int h, int wave) {
    const int lane = lane_id(), tid = wave * 64 + lane;
    const int qi = lane & 15, g = lane >> 4, t0 = 128 * tb + 16 * wave, b = (128 * tb) / SEQ;
    float c1 = 0.0625f * LOG2E; asm volatile("" : "+v"(c1));
    const bf16* qrow = QM + (size_t)(t0 + qi) * D + h * 256 + 8 * g;
    bf16x8 qf[8];
#pragma unroll
    for (int s = 0; s < 8; ++s) { const u32x4 r = *(const u32x4*)(qrow + 32 * s); u32x4 w;
        w.x = cvt_pk_bf16(__uint_as_float(r.x << 16) * c1, __uint_as_float(r.x & 0xffff0000u) * c1); w.y = cvt_pk_bf16(__uint_as_float(r.y << 16) * c1, __uint_as_float(r.y & 0xffff0000u) * c1);
        w.z = cvt_pk_bf16(__uint_as_float(r.z << 16) * c1, __uint_as_float(r.z & 0xffff0000u) * c1); w.w = cvt_pk_bf16(__uint_as_float(r.w << 16) * c1, __uint_as_float(r.w & 0xffff0000u) * c1);
        qf[s] = __builtin_bit_cast(bf16x8, w); }
    unsigned one2 = 0x3f803f80u; asm volatile("" : "+v"(one2));
    const bf16x8 ones = __builtin_bit_cast(bf16x8, (u32x4){one2, one2, one2, one2});
    f32x4 o[16], ol;
    { float z = 0.f; asm volatile("" : "+v"(z));
#pragma unroll
      for (int i = 0; i < 16; ++i) o[i] = (f32x4){z, z, z, z};
      ol = (f32x4){z, z, z, z}; }
    float mm = 0.f;
    const bf16* kg[2]; const bf16* vg[2]; unsigned kdst[2], vdst[2];
#pragma unroll
    for (int i = 0; i < 2; ++i) { const int n = tid + 512 * i, key = n >> 5, ch = n & 31, d = n >> 2, c = n & 3;
        kg[i] = KM + (size_t)(b * MEM_TOK + key) * KM_LD + h * 256 + ch * 8; kdst[i] = (unsigned)(key * 512 + (((ch & 16) | ((ch ^ key) & 15)) * 16));
        vg[i] = VT + (size_t)(h * 256 + d) * VTM_LD + b * MEM_TOK + 8 * c; vdst[i] = (unsigned)(16384 + d * 64 + (((c + (d >> 2)) & 3) * 16)); }
    unsigned ka[2][8], va[16];
#pragma unroll
    for (int sub = 0; sub < 2; ++sub)
#pragma unroll
        for (int s = 0; s < 8; ++s) { const int row = 16 * sub + qi, ch = 4 * s + g; ka[sub][s] = (unsigned)(row * 512 + (((ch & 16) | ((ch ^ row) & 15)) * 16)); }
#pragma unroll
    for (int ds = 0; ds < 16; ++ds) { const int d = 16 * ds + qi; va[ds] = (unsigned)(16384 + d * 64 + (((g + (d >> 2)) & 3) * 16)); }
    u32x4 kreg[2], vreg[2];
#pragma unroll
    for (int i = 0; i < 2; ++i) { kreg[i] = *(const u32x4*)(kg[i]); vreg[i] = *(const u32x4*)(vg[i]); }
#pragma unroll 1
    for (int grp = 0; grp < 8; ++grp) {
        LAS unsigned char* buf = lds + ((grp & 1) ? 32768 : 0);
#pragma unroll
        for (int i = 0; i < 2; ++i) { *(LAS u32x4*)(buf + kdst[i]) = kreg[i]; *(LAS u32x4*)(buf + vdst[i]) = vreg[i]; }
        { const int ng = grp < 7 ? grp + 1 : 7;
#pragma unroll
          for (int i = 0; i < 2; ++i) { kreg[i] = *(const u32x4*)(kg[i] + (size_t)(32 * ng) * KM_LD); vreg[i] = *(const u32x4*)(vg[i] + 32 * ng); } }
        MEMFENCE();
        __syncthreads();
        bf16x8 kf[2][8];
#pragma unroll
        for (int sub = 0; sub < 2; ++sub)
#pragma unroll
            for (int s = 0; s < 8; ++s) kf[sub][s] = *(const LAS bf16x8*)(buf + ka[sub][s]);
        __builtin_amdgcn_sched_barrier(0);
        f32x4 sc[2];
        { const float nm = -mm; sc[0] = (f32x4){nm, nm, nm, nm}; sc[1] = (f32x4){nm, nm, nm, nm}; }
#pragma unroll
        for (int s = 0; s < 8; ++s) { sc[0] = mfma16(kf[0][s], qf[s], sc[0]); sc[1] = mfma16(kf[1][s], qf[s], sc[1]); }
        bf16x8 vf[16];
#pragma unroll
        for (int ds = 0; ds < 16; ++ds) vf[ds] = *(const LAS bf16x8*)(buf + va[ds]);
        __builtin_amdgcn_sched_barrier(0);
        const float mx = fmaxf(fmaxf(fmaxf(sc[0][0], sc[0][1]), fmaxf(sc[0][2], sc[0][3])), fmaxf(fmaxf(sc[1][0], sc[1][1]), fmaxf(sc[1][2], sc[1][3])));
        if (grp == 0 || __any(mx > SM_THR)) {
            const float t = xmax16_32(mx, lane), d = grp == 0 ? t : fmaxf(t, 0.f); mm += d;
            if (grp != 0) { const float a = __builtin_amdgcn_exp2f(-d);
#pragma unroll
                for (int i = 0; i < 16; ++i) o[i] *= a;
                ol *= a; }
#pragma unroll
            for (int sub = 0; sub < 2; ++sub)
#pragma unroll
                for (int i = 0; i < 4; ++i) sc[sub][i] -= d;
        }
#pragma unroll
        for (int sub = 0; sub < 2; ++sub)
#pragma unroll
            for (int i = 0; i < 4; ++i) sc[sub][i] = __builtin_amdgcn_exp2f(sc[sub][i]);
        const bf16x8 pf = pack8(sc[0], sc[1]);
#pragma unroll
        for (int ds = 0; ds < 16; ++ds) o[ds] = mfma16(vf[ds], pf, o[ds]);
        ol = mfma16(ones, pf, ol);
    }
    const float inv = __builtin_amdgcn_rcpf(ol[0]);
    bf16* orow = OM + (size_t)(t0 + qi) * D + h * 256 + 4 * g;
#pragma unroll
    for (int ds = 0; ds < 16; ++ds) { const f32x4 y = o[ds] * inv; u32x2 w; w.x = cvt_pk_bf16(y[0], y[1]); w.y = cvt_pk_bf16(y[2], y[3]); *(u32x2*)(orow + 16 * ds) = w; }
    __syncthreads();
}

constexpr int TK_SC = 0;
constexpr int TK_QL = 131072;
constexpr int TK_SEL = TK_QL + 16384;
constexpr int TK_HIST = TK_SEL + 4096;
constexpr int TK_CAND = TK_HIST + 8192;
constexpr int TK_MM = TK_CAND + 2048;
constexpr int TK_CAP = 32;
static_assert(TK_MM + 128 <= LDS_MISC, "sparse-attention LDS map");
#ifndef REP_S2X
#define REP_S2X 1
#endif
#ifndef REP_S3
#define REP_S3 1
#endif
#ifndef TOPK_SLOW
#define TOPK_SLOW 1
#endif
#ifndef TOPK_MODE
#define TOPK_MODE 0
#endif
typedef float f32x16v __attribute__((ext_vector_type(16)));
__device__ __forceinline__ unsigned f2ord(float f) { const unsigned u = __float_as_uint(f); return (u & 0x80000000u) ? ~u : (u | 0x80000000u); }
__device__ __forceinline__ float ord2f(unsigned k) { return __uint_as_float((k & 0x80000000u) ? (k & 0x7fffffffu) : ~k); }
__device__ __forceinline__ unsigned offb(unsigned row, unsigned ch) { return 256u * row + 16u * (ch ^ (((row & 3u) << 2) | ((row >> 2) & 3u))); }
__device__ __forceinline__ int wave_incl_scan(int v, int lane) {
    (void)lane;
    v += __builtin_amdgcn_update_dpp(0, v, 0x111, 0xf, 0xf, true);
    v += __builtin_amdgcn_update_dpp(0, v, 0x112, 0xf, 0xf, true);
    v += __builtin_amdgcn_update_dpp(0, v, 0x114, 0xf, 0xf, true);
    v += __builtin_amdgcn_update_dpp(0, v, 0x118, 0xf, 0xf, true);
    v += __builtin_amdgcn_update_dpp(0, v, 0x142, 0xa, 0xf, false);
    v += __builtin_amdgcn_update_dpp(0, v, 0x143, 0xc, 0xf, false);
    return v;
}
__device__ __forceinline__ void hist_cross(const LAS unsigned* hist, int target, int lane, int& tb, int& cabove, int& cnt) {
    const u32x4 c = *(const LAS u32x4*)(hist + 4 * lane);
    const int s4 = (int)(c.x + c.y + c.z + c.w), incl = wave_incl_scan(s4, lane), excl = incl - s4;
    const bool has = (excl < target) && (incl >= target);
    int cum = excl, b = 0, ca = excl, cn = (int)c.x;
    { const int c0 = (int)c.x, c1 = (int)c.y, c2 = (int)c.z, c3 = (int)c.w;
      if (cum + c0 >= target) { b = 0; ca = cum; cn = c0; }
      else if (cum + c0 + c1 >= target) { b = 1; ca = cum + c0; cn = c1; }
      else if (cum + c0 + c1 + c2 >= target) { b = 2; ca = cum + c0 + c1; cn = c2; }
      else { b = 3; ca = cum + c0 + c1 + c2; cn = c3; } }
    const unsigned long long m = __ballot(has);
    const int src = m ? (int)__builtin_ctzll(m) : 0;
    tb = __builtin_amdgcn_readlane(4 * lane + b, src); cabove = __builtin_amdgcn_readlane(ca, src); cnt = __builtin_amdgcn_readlane(cn, src);
}
#define TR_READ(dst, addr) asm volatile("ds_read_b64_tr_b16 %0, %1" : "=v"(dst) : "v"(addr) : "memory")
#define TR_READ_O(dst, addr, off) asm volatile("ds_read_b64_tr_b16 %0, %1 offset:%2" : "=v"(dst) : "v"(addr), "n"(off) : "memory")

__device__ __forceinline__ float tk_coord(float mx, float x, float scale) { return __fmul_rn(__fsub_rn(mx, x), scale); }
__device__ __forceinline__ int tk_sub(float t, int bin) { int sub = (int)__fmul_rn(__fsub_rn(t, (float)bin), 256.0f); return sub > 255 ? 255 : sub; }
__device__ __forceinline__ void topk_select(const LAS float* sc, LAS unsigned short* sel, LAS unsigned* hist, LAS float* cv, LAS unsigned* ci, float mx, float mn, int n, int lane) {
    const int nj = n >> 6;
    if (!(mx > mn)) {
        for (int i = lane; i < TOPK; i += 64) sel[i] = (unsigned short)i;
        return;
    }
    const float scale = 250.0f / (mx - mn);
    const unsigned long long ltmask = (1ull << lane) - 1ull;
    { unsigned zr; asm volatile("v_mov_b32 %0, 0" : "=v"(zr)); *(LAS u32x4*)(hist + 4 * lane) = (u32x4){zr, zr, zr, zr}; }
    LDS_WAIT();
    for (int j = 0; j < nj; j += 4) {
        float x4[4];
#pragma unroll
        for (int u = 0; u < 4; ++u) x4[u] = sc[lane + 64 * ((j + u) < nj ? (j + u) : j)];
#pragma unroll
        for (int u = 0; u < 4; ++u) { const int bin = (int)tk_coord(mx, x4[u], scale); if (j + u < nj) atomicAdd((unsigned*)(hist + bin), 1u); }
    }
    LDS_WAIT();
    int tb, cabove, cnt; hist_cross(hist, TOPK, lane, tb, cabove, cnt);
    int tcode = tb * 256; const bool l1 = cnt > TK_CAP;
    if (l1) {
        { unsigned zr; asm volatile("v_mov_b32 %0, 0" : "=v"(zr)); *(LAS u32x4*)(hist + 4 * lane) = (u32x4){zr, zr, zr, zr}; }
        LDS_WAIT();
#pragma unroll 4
        for (int j = 0; j < nj; ++j) { const float x = sc[lane + 64 * j]; const float t = tk_coord(mx, x, scale); const int bin = (int)t;
            if (bin == tb) { const int sub = tk_sub(t, bin); atomicAdd((unsigned*)(hist + sub), 1u); } }
        LDS_WAIT();
        int tb2, ca2, cnt2; hist_cross(hist, TOPK - cabove, lane, tb2, ca2, cnt2);
        tcode += tb2; cnt = cnt2;
    }
    int base = 0, cb = 0;
    for (int j0 = 0; j0 < nj; j0 += 4) {
        float x4[4];
#pragma unroll
        for (int u = 0; u < 4; ++u) x4[u] = sc[lane + 64 * ((j0 + u) < nj ? (j0 + u) : j0)];
#pragma unroll
        for (int u = 0; u < 4; ++u) {
            const int idx = lane + 64 * (j0 + u); const float x = x4[u]; const float t = tk_coord(mx, x, scale); const int bin = (int)t;
            int sub = 0; if (l1) sub = tk_sub(t, bin);
            const int code = (j0 + u < nj) ? bin * 256 + sub : 0x7fffffff;
            const unsigned long long sm = __ballot(code < tcode), cm = __ballot(code == tcode);
            if (code < tcode) sel[base + __popcll(sm & ltmask)] = (unsigned short)idx;
            if (code == tcode) { const int pos = cb + __popcll(cm & ltmask); if (pos < TK_CAP) { cv[pos] = x; ci[pos] = (unsigned)idx; } }
            base += __popcll(sm); cb += __popcll(cm);
        }
    }
    LDS_WAIT();
    const int r = TOPK - base;
    if (cb <= TK_CAP) {
        const float v = lane < cb ? cv[lane] : 0.f; int rank = 0;
        for (int j = 0; j < cb; ++j) { const float u = cv[j]; rank += (u > v || (u == v && j < lane)) ? 1 : 0; }
        const bool take = lane < cb && rank < r;
        const unsigned long long tm = __ballot(take);
        if (take) sel[base + __popcll(tm & ltmask)] = (unsigned short)ci[lane];
    } else {
        unsigned prefix = 0u; int rem = r;
#pragma unroll 1
        for (int pb = 3; pb >= 0; --pb) {
            { unsigned zr; asm volatile("v_mov_b32 %0, 0" : "=v"(zr)); *(LAS u32x4*)(hist + 4 * lane) = (u32x4){zr, zr, zr, zr}; }
            LDS_WAIT();
            for (int j = 0; j < nj; ++j) { const float x = sc[lane + 64 * j]; const float t = tk_coord(mx, x, scale); const int bin = (int)t;
                int sub = 0; if (l1) sub = tk_sub(t, bin);
                const unsigned k = f2ord(x);
                if ((bin * 256 + sub) == tcode && (pb == 3 || (k >> (8 * (pb + 1))) == prefix)) atomicAdd((unsigned*)(hist + (255 - (int)((k >> (8 * pb)) & 255u))), 1u); }
            LDS_WAIT();
            int tbp, cab, cn; hist_cross(hist, rem, lane, tbp, cab, cn);
            rem -= cab; prefix = (prefix << 8) | (unsigned)(255 - tbp);
        }
        int outp = base, eqtaken = 0;
        for (int j = 0; j < nj; ++j) {
            const int idx = lane + 64 * j; const float x = sc[idx]; const float t = tk_coord(mx, x, scale); const int bin = (int)t;
            int sub = 0; if (l1) sub = tk_sub(t, bin);
            const bool isc = (bin * 256 + sub) == tcode; const unsigned k = f2ord(x);
            const unsigned long long em = __ballot(isc && k == prefix);
            const bool takeeq = isc && k == prefix && (eqtaken + __popcll(em & ltmask)) < rem;
            const bool take = (isc && k > prefix) || takeeq;
            const unsigned long long tm = __ballot(take);
            if (take) sel[outp + __popcll(tm & ltmask)] = (unsigned short)idx;
            outp += __popcll(tm); eqtaken += __popcll(em);
        }
    }
}

__device__ __forceinline__ void dsa_attn_query(brsrc_t rC, const LAS unsigned short* sel, LAS unsigned char* tile, bf16* ql  , int b, int tq) {
    const int lane = lane_id();
    const int g = lane >> 4, hd = lane & 15, h8 = hd & 7;
    float c1 = 0.125f * LOG2E; asm volatile("" : "+v"(c1));
    const float nsl2 = -__builtin_amdgcn_exp2f(-(float)(h8 + 1)) * LOG2E;
    bf16x8 qb[4];
#pragma unroll
    for (int s = 0; s < 4; ++s) { const u32x4 r = *(const u32x4*)(ql + h8 * 128 + 32 * s + 8 * g); u32x4 w;
        w.x = cvt_pk_bf16(__uint_as_float(r.x << 16) * c1, __uint_as_float(r.x & 0xffff0000u) * c1); w.y = cvt_pk_bf16(__uint_as_float(r.y << 16) * c1, __uint_as_float(r.y & 0xffff0000u) * c1);
        w.z = cvt_pk_bf16(__uint_as_float(r.z << 16) * c1, __uint_as_float(r.z & 0xffff0000u) * c1); w.w = cvt_pk_bf16(__uint_as_float(r.w << 16) * c1, __uint_as_float(r.w & 0xffff0000u) * c1);
        qb[s] = __builtin_bit_cast(bf16x8, w); }
    unsigned one2 = 0x3f803f80u; asm volatile("" : "+v"(one2));
    const bf16x8 ones = __builtin_bit_cast(bf16x8, (u32x4){one2, one2, one2, one2});
    f32x4 o[8], ol;
    { float z = 0.f; asm volatile("" : "+v"(z));
#pragma unroll
      for (int c = 0; c < 8; ++c) o[c] = (f32x4){z, z, z, z};
      ol = (f32x4){z, z, z, z}; }
    float mm = 0.f; bool first = true;
    unsigned ra[4], ta[8];
#pragma unroll
    for (int s = 0; s < 4; ++s) ra[s] = offb((unsigned)hd, (unsigned)(4 * s + g));
    { const unsigned q = (unsigned)(hd >> 2), p = (unsigned)(lane & 3);
#pragma unroll
      for (int c = 0; c < 8; ++c) ta[c] = offb(4u * g + q, 2u * c + (p >> 1)) + 8u * (p & 1u); }
    u32x4 grA[8], grB[8];
#define DSA_GATHER(GR, t_) do { _Pragma("unroll") for (int i = 0; i < 8; ++i) { const unsigned key = sel[32 * (t_) + 4 * i + g]; \
        GR[i] = __builtin_amdgcn_raw_buffer_load_b128(rC, (int)(((unsigned)(b * SEQ) + key) * 256u + (unsigned)hd * 16u), 0, 0); } } while (0)
#define DSA_TILE(tl, GR) do { \
        LAS unsigned char* img = tile + ((tl) & 1) * 8192; \
        _Pragma("unroll") for (int i = 0; i < 8; ++i) *(LAS u32x4*)(img + offb((unsigned)(4 * i + g), (unsigned)hd)) = GR[i]; \
        { const int nt_ = (tl) < 6 ? (tl) + 2 : 7; DSA_GATHER(GR, nt_); } \
        MEMFENCE(); \
        bf16x8 af[2][4]; \
        _Pragma("unroll") for (int rb = 0; rb < 2; ++rb) _Pragma("unroll") for (int s = 0; s < 4; ++s) af[rb][s] = *(const LAS bf16x8*)(img + ra[s] + 4096 * rb); \
        u32x2 tr[2][8]; const unsigned ib = (unsigned)(size_t)img; \
        _Pragma("unroll") for (int c = 0; c < 8; ++c) { const unsigned ad = ib + ta[c]; TR_READ(tr[0][c], ad); TR_READ_O(tr[1][c], ad, 4096); } \
        f32x4 sc[2]; \
        _Pragma("unroll") for (int rb = 0; rb < 2; ++rb) { const u32x2 kk = *(const LAS u32x2*)(sel + 32 * (tl) + 16 * rb + 4 * g); \
            const unsigned k4[4] = {kk.x & 0xffffu, kk.x >> 16, kk.y & 0xffffu, kk.y >> 16}; \
            _Pragma("unroll") for (int i = 0; i < 4; ++i) sc[rb][i] = __builtin_fmaf(nsl2, fabsf((float)(tq - (int)k4[i])), -mm); } \
        _Pragma("unroll") for (int s = 0; s < 4; ++s) { sc[0] = mfma16(af[0][s], qb[s], sc[0]); sc[1] = mfma16(af[1][s], qb[s], sc[1]); } \
        const float mx = fmaxf(fmaxf(fmaxf(sc[0][0], sc[0][1]), fmaxf(sc[0][2], sc[0][3])), fmaxf(fmaxf(sc[1][0], sc[1][1]), fmaxf(sc[1][2], sc[1][3]))); \
        if (first || __any(mx > SM_THR)) { \
            const float t = xmax16_32(mx, lane), d = first ? t : fmaxf(t, 0.f); mm += d; \
            if (!first) { const float alpha = __builtin_amdgcn_exp2f(-d); f32x4 ar; \
                _Pragma("unroll") for (int i = 0; i < 4; ++i) ar[i] = __int_as_float(__builtin_amdgcn_ds_bpermute((4 * g + i) << 2, __float_as_int(alpha))); \
                _Pragma("unroll") for (int c = 0; c < 8; ++c) o[c] *= ar; \
                ol *= ar; } \
            _Pragma("unroll") for (int rb = 0; rb < 2; ++rb) _Pragma("unroll") for (int i = 0; i < 4; ++i) sc[rb][i] -= d; \
            first = false; } \
        _Pragma("unroll") for (int rb = 0; rb < 2; ++rb) _Pragma("unroll") for (int i = 0; i < 4; ++i) sc[rb][i] = __builtin_amdgcn_exp2f(sc[rb][i]); \
        const bf16x8 pf = pack8(sc[0], sc[1]); \
        asm volatile("s_waitcnt lgkmcnt(0)" : "+v"(tr[0][0]), "+v"(tr[0][1]), "+v"(tr[0][2]), "+v"(tr[0][3]), "+v"(tr[0][4]), "+v"(tr[0][5]), "+v"(tr[0][6]), "+v"(tr[0][7]), \
                                              "+v"(tr[1][0]), "+v"(tr[1][1]), "+v"(tr[1][2]), "+v"(tr[1][3]), "+v"(tr[1][4]), "+v"(tr[1][5]), "+v"(tr[1][6]), "+v"(tr[1][7]) :: "memory"); \
        _Pragma("unroll") for (int c = 0; c < 8; ++c) { u32x4 bw; bw.x = tr[0][c].x; bw.y = tr[0][c].y; bw.z = tr[1][c].x; bw.w = tr[1][c].y; \
            o[c] = mfma16(pf, __builtin_bit_cast(bf16x8, bw), o[c]); } \
        ol = mfma16(pf, ones, ol); \
    } while (0)
    DSA_GATHER(grA, 0); DSA_GATHER(grB, 1);
    MEMFENCE();
    const int ntp = (tq >> 6) < 3 ? (tq >> 6) + 1 : 4;
#pragma unroll 1
    for (int tp = 0; tp < ntp; ++tp) { DSA_TILE(2 * tp, grA); DSA_TILE(2 * tp + 1, grB); }
#undef DSA_TILE
#undef DSA_GATHER
    if (g < 2) {
        bf16* olat = ql;
        f32x4 ir;
#pragma unroll
        for (int i = 0; i < 4; ++i) ir[i] = __builtin_amdgcn_rcpf(ol[i]);
#pragma unroll
        for (int c = 0; c < 8; ++c) { const f32x4 y = o[c] * ir;
#pragma unroll
            for (int i = 0; i < 4; ++i) olat[(4 * g + i) * 128 + 16 * c + hd] = (bf16)(cvt_pk_bf16(y[i], y[i]) & 0xffffu); }
    }
}

__device__ const unsigned short c_diff_tab[1024] = {
    995,999,1003,1007,1011,1015,1019,1023,963,967,971,975,979,983,987,991,931,935,939,943,947,951,955,959,899,903,907,911,915,919,923,927,
    867,871,875,879,883,887,891,895,835,839,843,847,851,855,859,863,803,807,811,815,819,823,827,831,771,775,779,783,787,791,795,799,
    739,743,747,751,755,759,763,767,707,711,715,719,723,727,731,735,675,679,683,687,691,695,699,703,643,647,651,655,659,663,667,671,
    611,615,619,623,627,631,635,639,579,583,587,591,595,599,603,607,994,998,1002,1006,1010,1014,1018,1022,962,966,970,974,978,982,986,990,
    930,934,938,942,946,950,954,958,547,551,555,559,563,567,571,575,898,902,906,910,914,918,922,926,866,870,874,878,882,886,890,894,
    834,838,842,846,850,854,858,862,802,806,810,814,818,822,826,830,515,519,523,527,531,535,539,543,770,774,778,782,786,790,794,798,
    738,742,746,750,754,758,762,766,706,710,714,718,722,726,730,734,674,678,682,686,690,694,698,702,483,487,491,495,499,503,507,511,
    642,646,650,654,658,662,666,670,610,614,618,622,626,630,634,638,578,582,586,590,594,598,602,606,546,550,554,558,562,566,570,574,
    479,475,471,467,463,459,455,451,542,538,534,530,526,522,518,514,510,506,502,498,494,490,486,482,478,474,470,466,462,458,454,450,
    431,430,427,426,423,422,419,418,447,446,443,442,439,438,435,434,399,398,395,394,391,390,387,386,415,414,411,410,407,406,403,402,
    367,366,363,362,359,358,355,354,383,382,379,378,375,374,371,370,335,334,331,330,327,326,323,322,351,350,347,346,343,342,339,338,
    1021,1017,1013,1009,1005,1001,997,993,989,985,981,977,973,969,965,961,957,953,949,945,941,937,933,929,925,921,917,913,909,905,901,897,
    303,302,299,298,295,294,291,290,319,318,315,314,311,310,307,306,893,889,885,881,877,873,869,865,861,857,853,849,845,841,837,833,
    829,825,821,817,813,809,805,801,797,793,789,785,781,777,773,769,271,270,267,266,263,262,259,258,287,286,283,282,279,278,275,274,
    1020,1016,1012,1008,1004,1000,996,992,765,761,757,753,749,745,741,737,988,984,980,976,972,968,964,960,733,729,725,721,717,713,709,705,
    828,824,820,816,812,808,804,800,223,222,219,218,215,214,211,210,413,409,405,401,397,393,389,385,191,190,187,186,183,182,179,178,
    33,34,35,37,38,39,41,42,192,196,200,204,208,212,216,220,86,87,89,90,91,93,94,95,512,516,520,524,528,532,536,540,
    161,165,169,173,177,181,185,189,544,548,552,556,560,564,568,572,321,325,329,333,337,341,345,349,576,580,584,588,592,596,600,604,
    353,357,361,365,369,373,377,381,608,612,616,620,624,628,632,636,162,163,166,167,170,171,174,175,449,453,457,461,465,469,473,477,
    513,517,521,525,529,533,537,541,832,836,840,844,848,852,856,860,609,613,617,621,625,629,633,637,641,645,649,653,657,661,665,669,
    673,677,681,685,689,693,697,701,896,900,904,908,912,916,920,924,242,243,246,247,250,251,254,255,864,868,872,876,880,884,888,892,
    226,227,230,231,234,235,238,239,928,932,936,940,944,948,952,956,545,549,553,557,561,565,569,573,577,581,585,589,593,597,601,605,
    194,195,198,199,202,203,206,207,768,772,776,780,784,788,792,796,481,485,489,493,497,501,505,509,736,740,744,748,752,756,760,764,
    672,676,680,684,688,692,696,700,417,421,425,429,433,437,441,445,640,644,648,652,656,660,664,668,704,708,712,716,720,724,728,732,
    74,73,71,70,69,67,66,65,157,153,149,145,141,137,133,129,348,344,340,336,332,328,324,320,316,312,308,304,300,296,292,288,
    85,83,82,81,79,78,77,75,252,248,244,240,236,232,228,224,380,376,372,368,364,360,356,352,125,121,117,113,109,105,101,97,
    444,440,436,432,428,424,420,416,317,313,309,305,301,297,293,289,127,126,123,122,119,118,115,114,143,142,139,138,135,134,131,130,
    285,281,277,273,269,265,261,257,221,217,213,209,205,201,197,193,476,472,468,464,460,456,452,448,412,408,404,400,396,392,388,384,
    253,249,245,241,237,233,229,225,508,504,500,496,492,488,484,480,159,158,155,154,151,150,147,146,111,110,107,106,103,102,99,98,
    284,280,276,272,268,264,260,256,188,184,180,176,172,168,164,160,156,152,148,144,140,136,132,128,53,51,50,49,47,46,45,43,
    63,62,61,59,58,57,55,54,7,6,5,4,3,2,1,0,23,22,21,20,19,18,17,16,15,14,13,12,11,10,9,8,
    31,30,29,28,27,26,25,24,60,56,52,48,44,40,36,32,124,120,116,112,108,104,100,96,92,88,84,80,76,72,68,64,
};

__device__ const unsigned char c_diff_ub[128] = {
    31,30,29,28,27,26,25,24,23,22,21,20,19,18,17,16,15,14,13,12,11,10,9,8,7,6,5,4,3,2,1,0,
    0,1,2,3,4,5,6,7,8,9,10,11,12,13,14,15,16,17,18,19,20,21,22,23,24,25,26,27,28,29,30,31,
    13,12,11,10,9,8,7,6,5,4,3,2,1,0,14,15,16,17,18,19,20,21,22,23,24,25,26,27,28,29,30,31,
    0,1,3,4,6,7,9,10,12,13,15,18,21,24,2,5,8,11,14,16,17,19,20,22,23,25,26,27,28,29,30,31,
};

struct Args { const float* in[31]; float* out; unsigned char* ws; int ph_lo, ph_hi, l_lo, l_hi, c_lo, c_hi, use_bar, pad; };
enum Phase { P_PRO0 = 0, P_PRO1, P_CVT, P_WIN, P_CKVN, P_ATTN, P_DIFF, P_WO, P_LN1, P_WQ, P_MEMATT, P_WMO, P_LN2, P_RGEMM, P_ROUTE, P_GU, P_DN, P_COMB, P_NUM };

struct Frame {
    LAS unsigned char* lds;
    int wave, G, vcu;
};


constexpr int CVT_SCR_BYTES = 64 * 65 * 4;
__device__ __forceinline__ void transpose_item(const float* W, int ldw, int K, int nvalid, bf16* WT, LAS float* scr, int kb, int nb, int lane) {
    const int k0 = 64 * kb, n0 = 64 * nb, r4 = lane >> 4, c4 = lane & 15;
    const bool ok = (n0 + 4 * c4) < nvalid;
    f32x4 v[16];
    const float* src = W + (size_t)(k0 + r4) * ldw + n0 + 4 * c4;
#pragma unroll
    for (int i = 0; i < 16; ++i) v[i] = ok ? *(const f32x4*)(src + (size_t)(4 * i) * ldw) : (f32x4){0.f, 0.f, 0.f, 0.f};
#pragma unroll
    for (int i = 0; i < 16; ++i) { LAS float* d = scr + (4 * i + r4) * 65 + 4 * c4; d[0] = v[i][0]; d[1] = v[i][1]; d[2] = v[i][2]; d[3] = v[i][3]; }
    LDS_WAIT(); asm volatile("" ::: "memory");
    const int c = lane & 7;
#pragma unroll
    for (int j = 0; j < 8; ++j) { const int n = (lane >> 3) + 8 * j; const LAS float* sp = scr + (8 * c) * 65 + n;
        u32x4 o; o.x = cvt_pk_bf16(sp[0 * 65], sp[1 * 65]); o.y = cvt_pk_bf16(sp[2 * 65], sp[3 * 65]); o.z = cvt_pk_bf16(sp[4 * 65], sp[5 * 65]); o.w = cvt_pk_bf16(sp[6 * 65], sp[7 * 65]);
        *(u32x4*)(WT + (size_t)(n0 + n) * K + k0 + 8 * c) = o; }
    LDS_WAIT(); asm volatile("" ::: "memory");
}
__device__ __forceinline__ void cvt_job(const float* W, int ldw, int K, int ncols, int nvalid, bf16* WT, LAS float* scr, int item, int lane) {
    const int nblk = ncols / 64; transpose_item(W, ldw, K, nvalid, WT, scr, item / nblk, item % nblk, lane);
}

__device__ __forceinline__ void cvt_layer_item(const Args& a, int l, unsigned char* wb, LAS float* scr, int it, int lane) {
    const float* src; int ldw, K = D, ncols, nvalid; size_t dst;
    if (it < 640) { const int seg = it >> 7; const int srcc = (seg == 0) ? 0 : (seg == 1) ? 640 : (seg == 2) ? 1224 : (seg == 3) ? 1736 : 2248;
        src = a.in[4] + (size_t)l * D * WIN_COLS + srcc; ldw = WIN_COLS; ncols = 512; nvalid = 512; dst = WB_WIN + (size_t)(seg < 4 ? seg * 512 : 2304) * D * 2; it &= 127; }
    else if (it < 672) { src = a.in[4] + (size_t)l * D * WIN_COLS + 512; ldw = WIN_COLS; ncols = 128; nvalid = 128; dst = WB_WIN + (size_t)2048 * D * 2; it -= 640; }
    else if (it < 688) { src = a.in[4] + (size_t)l * D * WIN_COLS + 1152; ldw = WIN_COLS; ncols = 64; nvalid = 64; dst = WB_WIN + (size_t)2176 * D * 2; it -= 672; }
    else if (it < 704) { src = a.in[4] + (size_t)l * D * WIN_COLS + 1216; ldw = WIN_COLS; ncols = 64; nvalid = 8; dst = WB_WIN + (size_t)2240 * D * 2; it -= 688; }
    else if (it < 960) { src = a.in[13] + (size_t)l * D * D; ldw = D; ncols = D; nvalid = D; dst = WB_WO; it -= 704; }
    else if (it < 1216) { src = a.in[16] + (size_t)l * D * D; ldw = D; ncols = D; nvalid = D; dst = WB_WQ; it -= 960; }
    else if (it < 1472) { src = a.in[18] + (size_t)l * D * D; ldw = D; ncols = D; nvalid = D; dst = WB_WMO; it -= 1216; }
    else if (it < 1600) { it -= 1472; const int sub = it >> 5, up = sub & 1, t = sub >> 1;
        src = (up ? a.in[27] : a.in[26]) + (size_t)l * D * SH_DIM + 128 * t; ldw = SH_DIM; ncols = 128; nvalid = 128; dst = WB_SGU + (size_t)(256 * t + 128 * up) * D * 2; it &= 31; }
    else if (it < 1664) { src = a.in[28] + (size_t)l * SH_DIM * D; ldw = D; K = SH_DIM; ncols = D; nvalid = D; dst = WB_SD; it -= 1600; }
    else if (it < 1664 + 8192) { it -= 1664; const int e = it >> 7, sub = (it >> 5) & 3, up = sub & 1, t = sub >> 1;
        src = (up ? a.in[24] : a.in[23]) + ((size_t)l * N_EXP + e) * D * EXP_DIM + 128 * t; ldw = EXP_DIM; ncols = 128; nvalid = 128; dst = WB_GU + ((size_t)e * 512 + 256 * t + 128 * up) * D * 2; it &= 31; }
    else if (it < 1664 + 8192 + 4096) { it -= 1664 + 8192; const int e = it >> 6;
        src = a.in[25] + ((size_t)l * N_EXP + e) * EXP_DIM * D; ldw = D; K = EXP_DIM; ncols = D; nvalid = D; dst = WB_DN + (size_t)e * D * EXP_DIM * 2; it &= 63; }
    else if (it < 1664 + 8192 + 4096 + 16) { it -= 1664 + 8192 + 4096; const int hh = it >> 1;
        src = a.in[7] + ((size_t)l * A_HEADS + hh) * KV_LORA * 64; ldw = 64; K = KV_LORA; ncols = 64; nvalid = 64; dst = WB_UV + (size_t)hh * 64 * KV_LORA * 2; it &= 1; }
    else { it -= 1664 + 8192 + 4096 + 16;
        src = a.in[21] + (size_t)l * D * N_EXP; ldw = N_EXP; ncols = 256; nvalid = N_EXP; dst = WB_RW; }
    cvt_job(src, ldw, K, ncols, nvalid, (bf16*)(wb + dst), scr, it, lane);
}
constexpr int CVT_LAYER_ITEMS = 1664 + 8192 + 4096 + 16 + 64;

__device__ __forceinline__ void ln_row(const float* xrow, const float* g, const float* b, float* hrow, bf16* orow, int lane) {
    f32x4 v[4]; float s = 0.f;
#pragma unroll
    for (int j = 0; j < 4; ++j) { v[j] = *((const f32x4*)xrow + lane + 64 * j); s += (v[j][0] + v[j][1]) + (v[j][2] + v[j][3]); }
    const float mean = wsum(s, lane) * (1.f / D); float s2 = 0.f;
#pragma unroll
    for (int j = 0; j < 4; ++j) { v[j] = v[j] - mean; s2 += (v[j][0] * v[j][0] + v[j][1] * v[j][1]) + (v[j][2] * v[j][2] + v[j][3] * v[j][3]); }
    const float rstd = __builtin_amdgcn_rsqf(wsum(s2, lane) * (1.f / D) + LN_EPS);
#pragma unroll
    for (int j = 0; j < 4; ++j) { const f32x4 gg = *((const f32x4*)g + lane + 64 * j), bb = *((const f32x4*)b + lane + 64 * j);
        const f32x4 o = v[j] * rstd * gg + bb; if (hrow) *((f32x4*)hrow + lane + 64 * j) = o;
        u32x2 w; w.x = pk2(o[0], o[1]); w.y = pk2(o[2], o[3]); *((u32x2*)orow + lane + 64 * j) = w; }
}


__device__ __forceinline__ void add_bf16x4(f32x4& v, const u32x2 y) { v[0] += __uint_as_float(y.x << 16); v[1] += __uint_as_float(y.x & 0xffff0000u); v[2] += __uint_as_float(y.y << 16); v[3] += __uint_as_float(y.y & 0xffff0000u); }
__device__ __forceinline__ void acc_bf16x8(float (&v)[8], const u32x4 y, float sc) {
    v[0] += sc * __uint_as_float(y.x << 16); v[1] += sc * __uint_as_float(y.x & 0xffff0000u); v[2] += sc * __uint_as_float(y.y << 16); v[3] += sc * __uint_as_float(y.y & 0xffff0000u);
    v[4] += sc * __uint_as_float(y.z << 16); v[5] += sc * __uint_as_float(y.z & 0xffff0000u); v[6] += sc * __uint_as_float(y.w << 16); v[7] += sc * __uint_as_float(y.w & 0xffff0000u);
}
template <int NR, bool HAS_Y, bool HAS_X, bool HAS_SLOTS>
__device__ __forceinline__ void ln_res_rows(const bf16* hrow, size_t hstride, const bf16* yrow, size_t ystride, const bf16* xrow, size_t xstride, const bf16* slots, size_t sstride,
                                            float alpha, const float* g, const float* b, bf16* orow, size_t ostride, float* fout, size_t fstride, int lane) {
    u32x4 hv[NR][2], yv[NR][2], xv[NR][2], sv[NR][HAS_SLOTS ? 8 : 1][2];
#pragma unroll
    for (int r = 0; r < NR; ++r)
#pragma unroll
        for (int c = 0; c < 2; ++c) { const int e = 8 * lane + 512 * c;
            hv[r][c] = *(const u32x4*)(hrow + r * hstride + e);
            if (HAS_Y) yv[r][c] = *(const u32x4*)(yrow + r * ystride + e);
            if (HAS_X) xv[r][c] = *(const u32x4*)(xrow + r * xstride + e);
            if (HAS_SLOTS) {
#pragma unroll
                for (int k = 0; k < 8; ++k) sv[r][k][c] = *(const u32x4*)(slots + r * sstride + (size_t)k * D + e); } }
    MEMFENCE();
    float v[NR][2][8], mean[NR], rstd[NR];
#pragma unroll
    for (int r = 0; r < NR; ++r) { float s = 0.f;
#pragma unroll
        for (int c = 0; c < 2; ++c) {
#pragma unroll
            for (int i = 0; i < 8; ++i) v[r][c][i] = 0.f;
            acc_bf16x8(v[r][c], hv[r][c], alpha);
            if (HAS_Y) acc_bf16x8(v[r][c], yv[r][c], 1.0f);
            if (HAS_X) acc_bf16x8(v[r][c], xv[r][c], 1.0f);
            if (HAS_SLOTS) {
#pragma unroll
                for (int k = 0; k < 8; ++k) acc_bf16x8(v[r][c], sv[r][k][c], 1.0f); }
#pragma unroll
            for (int i = 0; i < 8; ++i) s += v[r][c][i]; }
        mean[r] = s; }
#pragma unroll
    for (int r = 0; r < NR; ++r) mean[r] = wave_total(mean[r]);
#pragma unroll
    for (int r = 0; r < NR; ++r) { mean[r] *= (1.f / D); float q = 0.f;
#pragma unroll
        for (int c = 0; c < 2; ++c)
#pragma unroll
            for (int i = 0; i < 8; ++i) { v[r][c][i] -= mean[r]; q += v[r][c][i] * v[r][c][i]; }
        rstd[r] = q; }
#pragma unroll
    for (int r = 0; r < NR; ++r) rstd[r] = wave_total(rstd[r]);
#pragma unroll
    for (int c = 0; c < 2; ++c) { const int e = 8 * lane + 512 * c;
        const f32x4 g0 = *(const f32x4*)(g + e), g1 = *(const f32x4*)(g + e + 4), b0 = *(const f32x4*)(b + e), b1 = *(const f32x4*)(b + e + 4);
#pragma unroll
        for (int r = 0; r < NR; ++r) { const float rs = __builtin_amdgcn_rsqf(rstd[r] * (1.f / D) + LN_EPS);
            f32x4 o0, o1;
#pragma unroll
            for (int i = 0; i < 4; ++i) { o0[i] = v[r][c][i] * rs * g0[i] + b0[i]; o1[i] = v[r][c][4 + i] * rs * g1[i] + b1[i]; }
            if (fout) { *(f32x4*)(fout + r * fstride + e) = o0; *(f32x4*)(fout + r * fstride + e + 4) = o1; }
            else { u32x4 w; w.x = cvt_pk_bf16(o0[0], o0[1]); w.y = cvt_pk_bf16(o0[2], o0[3]); w.z = cvt_pk_bf16(o1[0], o1[1]); w.w = cvt_pk_bf16(o1[2], o1[3]);
                *(u32x4*)(orow + r * ostride + e) = w; } } }
}

__global__ void __launch_bounds__(NTHR, 2) mk_fwd(Args a) {
    extern __shared__ __attribute__((aligned(16))) unsigned char lds_raw[];
    Frame F;
    F.lds = (LAS unsigned char*)lds_raw;
    F.wave = __builtin_amdgcn_readfirstlane(threadIdx.x >> 6);
    F.G = gridDim.x; { const int bx = blockIdx.x; F.vcu = (F.G % 8 == 0) ? (bx % 8) * (F.G / 8) + bx / 8 : bx; }
    volatile LAS unsigned* MISC = (volatile LAS unsigned*)(F.lds + LDS_MISC);
    if (threadIdx.x < 32) MISC[threadIdx.x] = 0u;
    __syncthreads();
    XcdBarrier bar; bar.bar = (unsigned*)(a.ws + WS_CTL) + CW_BAR; bar.x = 0; bar.st = MISC + 8;
    if (a.use_bar) bar = xcd_barrier_post((unsigned*)(a.ws + WS_CTL) + CW_BAR, MISC + 8);
#define GRID_BAR() do { if (a.use_bar) xcd_barrier(bar, F.wave); } while (0)
#define IN(k) (a.ph_lo <= (k) && (k) < a.ph_hi)
#define PHASE_BASES() GAS unsigned char* wsg_ = (GAS unsigned char*)a.ws; asm volatile("" : "+s"(wsg_)); unsigned char* ws = (unsigned char*)wsg_; GAS float* hg_ = (GAS float*)a.out; asm volatile("" : "+s"(hg_)); float* H = (float*)hg_; bf16* HB = (bf16*)(ws + WS_HB); (void)H; (void)HB
    const int gw = F.vcu * NWAVES + F.wave, NGW = F.G * NWAVES;
    LAS float* scr = (LAS float*)(F.lds + LDS_STAGE + F.wave * CVT_SCR_BYTES);

    if (IN(P_PRO0)) {
        PHASE_BASES();
        { const int lane = lane_id();
          f32x4 gg[4], bb[4];
#pragma unroll
          for (int j = 0; j < 4; ++j) { gg[j] = *((const f32x4*)a.in[2] + lane + 64 * j); bb[j] = *((const f32x4*)a.in[3] + lane + 64 * j); }
          for (int m = gw; m < NTOK; m += 2 * NGW) {
              f32x4 v[2][4]; float s[2];
#pragma unroll
              for (int u = 0; u < 2; ++u) { const int row = m + u * NGW < NTOK ? m + u * NGW : m; s[u] = 0.f;
#pragma unroll
                  for (int j = 0; j < 4; ++j) { v[u][j] = *((const f32x4*)(a.in[0] + (size_t)row * D) + lane + 64 * j); s[u] += (v[u][j][0] + v[u][j][1]) + (v[u][j][2] + v[u][j][3]); } }
#pragma unroll
              for (int u = 0; u < 2; ++u) { const float mean = wave_total(s[u]) * (1.f / D); float s2 = 0.f;
#pragma unroll
                  for (int j = 0; j < 4; ++j) { v[u][j] = v[u][j] - mean; s2 += (v[u][j][0] * v[u][j][0] + v[u][j][1] * v[u][j][1]) + (v[u][j][2] * v[u][j][2] + v[u][j][3] * v[u][j][3]); }
                  s[u] = s2; }
#pragma unroll
              for (int u = 0; u < 2; ++u) { const int row = m + u * NGW; const float rstd = __builtin_amdgcn_rsqf(wave_total(s[u]) * (1.f / D) + LN_EPS);
                  if (row < NTOK) {
#pragma unroll
                      for (int j = 0; j < 4; ++j) { const f32x4 o = v[u][j] * rstd * gg[j] + bb[j]; u32x2 w; w.x = pk2(o[0], o[1]); w.y = pk2(o[2], o[3]); *((u32x2*)(HB + (size_t)row * D) + lane + 64 * j) = w; } } }
          } }
        { bf16* MEMB = (bf16*)(ws + WS_MEMB); const float* mem = a.in[1];
          for (size_t i = ((size_t)blockIdx.x * NTHR + F.wave * 64 + lane_id()) * 4; i < (size_t)BATCH * MEM_TOK * D; i += (size_t)F.G * NTHR * 4) { const f32x4 v = *(const f32x4*)(mem + i); u32x2 w; w.x = pk2(v[0], v[1]); w.y = pk2(v[2], v[3]); *(u32x2*)(MEMB + i) = w; } }
        for (int it = gw; it < 1024; it += NGW) { const int l = it >> 9, v = (it >> 8) & 1, r = it & 255;
            cvt_job(a.in[17] + (size_t)l * D * 2048 + 1024 * v, 2048, D, D, D, (bf16*)(ws + (v ? WS_WVT : WS_WKT) + (size_t)l * 4 * MiB), scr, r, lane_id()); }
        GRID_BAR();
    }
#pragma unroll
    for (int l = 0; l < DEPTH; ++l) { if (l < a.l_lo || l >= a.l_hi) continue;
        if (IN(P_CVT)) {
            PHASE_BASES(); unsigned char* wb = ws + WS_WB;
            for (int it = gw; it < CVT_LAYER_ITEMS; it += NGW) cvt_layer_item(a, l, wb, scr, it, lane_id());
            { const float* wuk = a.in[6] + (size_t)l * A_HEADS * KV_LORA * 64; bf16* o = (bf16*)(wb + WB_UK);
              for (int i = (gw * 64 + lane_id()) * 4; i < A_HEADS * KV_LORA * 64; i += NGW * 64 * 4) { const f32x4 v = *(const f32x4*)(wuk + i); u32x2 w; w.x = pk2(v[0], v[1]); w.y = pk2(v[2], v[3]); *(u32x2*)(o + i) = w; } }
            GRID_BAR();
        }
        if (IN(P_WIN)) {
            PHASE_BASES(); unsigned char* wb = ws + WS_WB;
            pg8::Gemm g{HB, (const bf16*)(wb + WB_WIN), D, 0, 0}; pg8::DenseOrder S; S.init(NTOK, WIN_PAD, 1, F.G, (int)blockIdx.x);
            pg8::EpiProjMk E{(bf16*)(ws + WS_PROJ5), (bf16*)(ws + WS_MISC10), (float*)(ws + WS_WIDX), (bf16*)(ws + WS_SEL)};
            pg8::gemm_phase<pg8::EpiProjMk, pg8::DenseOrder, false>(F.lds + LDS_STAGE, g, S, E, nullptr, F.wave);
            { pg8::Gemm g2{(const bf16*)(wb + WB_WIN) + (size_t)2304 * D, HB, D, 0, 0}; pg8::DenseOrder S2; S2.init(512, NTOK, 1, F.G, (int)((blockIdx.x + 128) % F.G));
              pg8::EpiVT E2{(bf16*)(ws + WS_VTD), VTD_LD, 0};
              pg8::gemm_phase<pg8::EpiVT, pg8::DenseOrder, false>(F.lds + LDS_STAGE, g2, S2, E2, nullptr, F.wave); }
            if (l == 0) {
                { pg8::Gemm g3{(const bf16*)(ws + WS_MEMB), (const bf16*)(ws + WS_WKT), D, 0, (size_t)2 * MiB}; pg8::DenseOrder S3; S3.init(2048, 1024, DEPTH, F.G, (int)((blockIdx.x + F.G / 2) % F.G));
                  pg8::EpiBf16 E3{(bf16*)(ws + WS_KM), KM_LD, (size_t)2048 * KM_LD, 0, 0};
                  pg8::gemm_phase<pg8::EpiBf16, pg8::DenseOrder, false>(F.lds + LDS_STAGE, g3, S3, E3, nullptr, F.wave); }
                { pg8::Gemm g4{(const bf16*)(ws + WS_WVT), (const bf16*)(ws + WS_MEMB), D, (size_t)2 * MiB, 0}; pg8::DenseOrder S4; S4.init(1024, 2048, DEPTH, F.G, (int)((blockIdx.x + F.G / 4) % F.G));
                  pg8::EpiVT E4{(bf16*)(ws + WS_VTM), VTM_LD, (size_t)1024 * VTM_LD};
                  pg8::gemm_phase<pg8::EpiVT, pg8::DenseOrder, false>(F.lds + LDS_STAGE, g4, S4, E4, nullptr, F.wave); }
            }
            GRID_BAR();
        }
        if (IN(P_CKVN)) {
            PHASE_BASES();
            const int lane = lane_id();
            const bf16* MISCp = (const bf16*)(ws + WS_MISC10); bf16* CKVp = (bf16*)(ws + WS_CKV); const float* gn = a.in[5] + l * KV_LORA;
            const float g0 = gn[lane], g1 = gn[64 + lane];
            for (int row0 = gw; row0 < NTOK; row0 += 4 * NGW) {
                float x0[4], x1[4];
#pragma unroll
                for (int u = 0; u < 4; ++u) { const int row = row0 + u * NGW < NTOK ? row0 + u * NGW : row0; x0[u] = bf2f(MISCp[(size_t)row * 256 + lane]); x1[u] = bf2f(MISCp[(size_t)row * 256 + 64 + lane]); }
#pragma unroll
                for (int u = 0; u < 4; ++u) { const int row = row0 + u * NGW;
                    const float r = __builtin_amdgcn_rsqf(wsum(x0[u] * x0[u] + x1[u] * x1[u], lane) * (1.f / KV_LORA) + RMS_EPS);
                    if (row < NTOK) { CKVp[(size_t)row * 128 + lane] = (bf16)(pk2(x0[u] * r * g0, 0.f) & 0xffffu); CKVp[(size_t)row * 128 + 64 + lane] = (bf16)(pk2(x1[u] * r * g1, 0.f) & 0xffffu); } }
            }
            GRID_BAR();
        }
#pragma unroll 1
        for (int apass = 0; apass < 2; ++apass) { const int awhich = apass ^ (((int)blockIdx.x >> 3) & 1);
        if (awhich == 0 && IN(P_ATTN)) {
            PHASE_BASES(); unsigned char* wb = ws + WS_WB;
            const int w = F.wave;
            LAS float* SC = (LAS float*)(F.lds + TK_SC); LAS bf16* QL = (LAS bf16*)(F.lds + TK_QL); LAS unsigned short* SEL = (LAS unsigned short*)(F.lds + TK_SEL);
            LAS unsigned* HIST = (LAS unsigned*)(F.lds + TK_HIST); LAS unsigned* MM = (LAS unsigned*)(F.lds + TK_MM);
            const size_t PS = (size_t)NTOK * 512;
            const bf16* QA = (const bf16*)(ws + WS_PROJ5); const bf16* QIDX = QA + PS; const float* WIDXp = (const float*)(ws + WS_WIDX);
            const bf16* WUK = (const bf16*)(wb + WB_UK); const bf16* WUVT = (const bf16*)(wb + WB_UV);
            bf16* CATp = (bf16*)(ws + WS_CAT);
            const brsrc_t rM = make_rsrc(ws + WS_SEL, (unsigned)((size_t)NTOK * 128)), rC = make_rsrc(ws + WS_CKV, (unsigned)((size_t)NTOK * 256));
            const int NIT = (4096 + F.G - 1) / F.G;
            bf16* QLAT = (bf16*)(ws + WS_Y);
#define ATTN_UNIT_IDX(it_) ((it_) * F.G + (((it_) & 1) ? (F.G - 1 - (int)blockIdx.x) : (int)blockIdx.x))
            { const int lane = lane_id(), hd = lane & 15, g = lane >> 4;
              bf16x8 wkn[16];
#pragma unroll
              for (int nt = 0; nt < 8; ++nt) { const bf16* wr = WUK + (size_t)(w * 128 + 16 * nt + hd) * 64 + 8 * g; wkn[2 * nt] = *(const bf16x8*)wr; wkn[2 * nt + 1] = *(const bf16x8*)(wr + 32); }
#pragma unroll 1
              for (int ib = 0; ib < NIT; ib += 8) {
                  bf16x8 qa[8][2];
#pragma unroll
                  for (int u = 0; u < 8; ++u) { const int idxu = (ib + u) < NIT ? ATTN_UNIT_IDX(ib + u) : 4096; const int idc = idxu < 4096 ? idxu : 0;
                      const bf16* qrow = QA + (size_t)((idc & 7) * SEQ + 8 * (511 - (idc >> 3)) + (hd & 7)) * 512 + w * 64 + 8 * g; qa[u][0] = *(const bf16x8*)qrow; qa[u][1] = *(const bf16x8*)(qrow + 32); }
#pragma unroll
                  for (int u = 0; u < 8; ++u) { const int idxu = (ib + u) < NIT ? ATTN_UNIT_IDX(ib + u) : 4096;
                      if (idxu < 4096) { bf16* qo = QLAT + (size_t)((idxu & 7) * SEQ + 8 * (511 - (idxu >> 3)) + (hd & 7)) * D + w * 128 + 4 * g;
#pragma unroll
                          for (int nt = 0; nt < 8; ++nt) { f32x4 acc = mfma16(wkn[2 * nt], qa[u][0], (f32x4){0.f, 0.f, 0.f, 0.f}); acc = mfma16(wkn[2 * nt + 1], qa[u][1], acc);
                              if (hd < 8) { u32x2 pk; pk.x = pk2(acc[0], acc[1]); pk.y = pk2(acc[2], acc[3]); *(u32x2*)(qo + 16 * nt) = pk; } } } } }
              const int tidp = w * 64 + lane; if (tidp < 8) MM[tidp] = 0u; else if (tidp < 16) MM[tidp] = 0xFFFFFFFFu; }
            __syncthreads();
#pragma unroll 1
            for (int it = 0; it < NIT; ++it) {
                LAS unsigned* MMt = MM + 16 * (it & 1);
                const int idx = ATTN_UNIT_IDX(it);
                const bool do4 = idx < 4096;
                const int qt = 511 - (idx >> 3), bb = idx & 7, tq0 = 8 * qt, tok0 = bb * SEQ + tq0, n = ((tq0 >> 6) + 1) * 64;
                if (do4) {
#ifndef REP_S1
#define REP_S1 1
#endif
#pragma unroll 1
                for (int rep1 = 0; rep1 < REP_S1; ++rep1)
                if (n > TOPK) {
                    const int lane = lane_id();
                    const int r = lane & 31, hi = lane >> 5, qq = 2 * ((r >> 2) & 1) + (r >> 4), hh = 4 * ((r >> 3) & 1) + (r & 3);
                    bf16x8 af[2][4]; float wq[2][16];
#pragma unroll
                    for (int rt = 0; rt < 2; ++rt) { const bf16* ar = QIDX + (size_t)(tok0 + 4 * rt + qq) * 512 + hh * 64 + 8 * hi;
#pragma unroll
                        for (int s4 = 0; s4 < 4; ++s4) af[rt][s4] = *(const bf16x8*)(ar + 16 * s4);
#pragma unroll
                        for (int i = 0; i < 16; ++i) wq[rt][i] = WIDXp[(size_t)(tok0 + 4 * rt + 2 * hi + (i >> 3)) * 8 + 4 * ((i >> 2) & 1) + (i & 3)] * 0.125f; }
                    float vmax[2][2], vmin[2][2];
#pragma unroll
                    for (int rt = 0; rt < 2; ++rt)
#pragma unroll
                        for (int u = 0; u < 2; ++u) { vmax[rt][u] = -3.0e38f; vmin[rt][u] = 3.0e38f; }
                    const unsigned kvo = (unsigned)(lane * 16);
                    const int ntile = n >> 5;
                    bf16x8 bqA[4], bqB[4];
#define IDX_LOAD(BQ, kt_) do { const int nk_ = (kt_) < ntile ? (kt_) : w; const unsigned so_ = (unsigned)(bb * 128 + nk_) * 4096u; \
                        _Pragma("unroll") for (int s4 = 0; s4 < 4; ++s4) BQ[s4] = bld16(rM, kvo + 1024 * s4, so_); } while (0)
#define IDX_TILE(BQ, kt_) do { \
                        f32x16v acc0, acc1; \
                        _Pragma("unroll") for (int i = 0; i < 16; ++i) { acc0[i] = 0.f; acc1[i] = 0.f; } \
                        _Pragma("unroll") for (int s4 = 0; s4 < 4; ++s4) { acc0 = __builtin_amdgcn_mfma_f32_32x32x16_bf16(af[0][s4], BQ[s4], acc0, 0, 0, 0); acc1 = __builtin_amdgcn_mfma_f32_32x32x16_bf16(af[1][s4], BQ[s4], acc1, 0, 0, 0); } \
                        asm volatile("" : "+v"(acc0), "+v"(acc1) :: "memory");     \
                        IDX_LOAD(BQ, (kt_) + 2 * NWAVES); \
                        MEMFENCE(); \
                        float sc4[2][2] = {{0.f, 0.f}, {0.f, 0.f}}; \
                        _Pragma("unroll") for (int i = 0; i < 16; ++i) { sc4[0][i >> 3] = __builtin_fmaf(wq[0][i], relu_f(acc0[i]), sc4[0][i >> 3]); sc4[1][i >> 3] = __builtin_fmaf(wq[1][i], relu_f(acc1[i]), sc4[1][i >> 3]); } \
                        _Pragma("unroll") for (int rt = 0; rt < 2; ++rt) _Pragma("unroll") for (int u = 0; u < 2; ++u) { const float v = sc4[rt][u]; SC[(4 * rt + 2 * hi + u) * 4096 + 32 * (kt_) + r] = v; vmax[rt][u] = fmaxf(vmax[rt][u], v); vmin[rt][u] = fminf(vmin[rt][u], v); } \
                    } while (0)
                    IDX_LOAD(bqA, w); IDX_LOAD(bqB, w + NWAVES);
                    MEMFENCE();
                    int kt = w;
#pragma unroll 1
                    for (; kt + NWAVES < ntile; kt += 2 * NWAVES) { IDX_TILE(bqA, kt); IDX_TILE(bqB, kt + NWAVES); }
                    if (kt < ntile) IDX_TILE(bqA, kt);
#undef IDX_TILE
#undef IDX_LOAD
#pragma unroll
                    for (int rt = 0; rt < 2; ++rt)
#pragma unroll
                        for (int u = 0; u < 2; ++u) { float a = vmax[rt][u], c = vmin[rt][u];
#define DPX(x, ctrl) __int_as_float(__builtin_amdgcn_update_dpp(__float_as_int(x), __float_as_int(x), ctrl, 0xf, 0xf, false))
                            a = fmaxf(a, DPX(a, 0xB1)); c = fminf(c, DPX(c, 0xB1)); a = fmaxf(a, DPX(a, 0x4E)); c = fminf(c, DPX(c, 0x4E));
                            a = fmaxf(a, DPX(a, 0x141)); c = fminf(c, DPX(c, 0x141)); a = fmaxf(a, DPX(a, 0x140)); c = fminf(c, DPX(c, 0x140));
#undef DPX
                            if ((r & 15) == 0) { atomicMax((unsigned*)(MMt + 4 * rt + 2 * hi + u), f2ord(a)); atomicMin((unsigned*)(MMt + 8 + 4 * rt + 2 * hi + u), f2ord(c)); } }
                }
                __syncthreads();
                { const int lane = lane_id();
                if (n <= TOPK) { for (int i = lane; i < TOPK; i += 64) SEL[w * 256 + i] = i < n ? (unsigned short)i : (unsigned short)0xFFFFu; }
                else { topk_select(SC + w * 4096, SEL + w * 256, HIST + w * 256, (LAS float*)(F.lds + TK_CAND + w * 256), (LAS unsigned*)(F.lds + TK_CAND + w * 256 + 128), ord2f(MMt[w]), ord2f(MMt[8 + w]), n, lane);
#if REP_S2X > 1
                    topk_select(SC + w * 4096, SEL + w * 256, HIST + w * 256, (LAS float*)(F.lds + TK_CAND + w * 256), (LAS unsigned*)(F.lds + TK_CAND + w * 256 + 128), ord2f(MMt[w]), ord2f(MMt[8 + w]), n, lane);
                    topk_select(SC + w * 4096, SEL + w * 256, HIST + w * 256, (LAS float*)(F.lds + TK_CAND + w * 256), (LAS unsigned*)(F.lds + TK_CAND + w * 256 + 128), ord2f(MMt[w]), ord2f(MMt[8 + w]), n, lane);
#endif
                }
                }
                dsa_attn_query(rC, SEL + w * 256, F.lds + TK_SC + w * 16384, QLAT + (size_t)(tok0 + w) * D, bb, tq0 + w);
#if REP_S3 > 1
                dsa_attn_query(rC, SEL + w * 256, F.lds + TK_SC + w * 16384, QLAT + (size_t)(tok0 + w) * D, bb, tq0 + w);
#endif
                }
                { const int tidp = w * 64 + lane_id(); LAS unsigned* MMn = MM + 16 * ((it + 1) & 1); if (tidp < 8) MMn[tidp] = 0u; else if (tidp < 16) MMn[tidp] = 0xFFFFFFFFu; }
                __syncthreads();
            }
            { const int lane = lane_id(), hd = lane & 15, g = lane >> 4;
              const brsrc_t rQ = make_rsrc(ws + WS_Y, (unsigned)((size_t)NTOK * D * 2));
              bf16x8 wv[4][4];
#pragma unroll
              for (int nt = 0; nt < 4; ++nt) { const bf16* wr = WUVT + (size_t)(w * 64 + 16 * nt + hd) * 128 + 8 * g;
#pragma unroll
                  for (int s4 = 0; s4 < 4; ++s4) wv[nt][s4] = *(const bf16x8*)(wr + 32 * s4); }
#pragma unroll 1
              for (int ib = 0; ib < NIT; ib += 4) {
                  bf16x8 ol[4][4];
#pragma unroll
                  for (int u = 0; u < 4; ++u) { const int idxu = (ib + u) < NIT ? ATTN_UNIT_IDX(ib + u) : 4096; const int idc = idxu < 4096 ? idxu : 0;
                      const unsigned oo = (unsigned)(((idc & 7) * SEQ + 8 * (511 - (idc >> 3)) + (hd & 7)) * D + w * 128 + 8 * g) * 2u;
#pragma unroll
                      for (int s4 = 0; s4 < 4; ++s4) ol[u][s4] = __builtin_bit_cast(bf16x8, __builtin_amdgcn_raw_buffer_load_b128(rQ, (int)(oo + 64u * s4), 0, 17)); }
#pragma unroll
                  for (int u = 0; u < 4; ++u) { const int idxu = (ib + u) < NIT ? ATTN_UNIT_IDX(ib + u) : 4096;
                      if (idxu < 4096) { bf16* co = CATp + (size_t)((idxu & 7) * SEQ + 8 * (511 - (idxu >> 3)) + (hd & 7)) * D + w * 64 + 4 * g;
#pragma unroll
                          for (int nt = 0; nt < 4; ++nt) { f32x4 acc = (f32x4){0.f, 0.f, 0.f, 0.f};
#pragma unroll
                              for (int s4 = 0; s4 < 4; ++s4) acc = mfma16(wv[nt][s4], ol[u][s4], acc);
                              if (hd < 8) { u32x2 pk; pk.x = pk2(acc[0], acc[1]); pk.y = pk2(acc[2], acc[3]); *(u32x2*)(co + 16 * nt) = pk; } } } } } }
#undef ATTN_UNIT_IDX
            __syncthreads();
        }
        if (awhich == 1 && IN(P_DIFF)) {
            PHASE_BASES();
            const int lane = lane_id();
            const float lambda_init = 0.8f - 0.6f * __expf(-0.3f * (float)l);
            const float d1 = wsum(a.in[8][l * 64 + lane] * a.in[9][l * 64 + lane], lane), d2 = wsum(a.in[10][l * 64 + lane] * a.in[11][l * 64 + lane], lane);
            const float lam = __expf(d1) - __expf(d2) + lambda_init;
            const size_t PS = (size_t)NTOK * 512;
            const bf16* PROJ5 = (const bf16*)(ws + WS_PROJ5);
            const brsrc_t rK = make_rsrc(PROJ5 + 3 * PS, (unsigned)(PS * 2)), rV = make_rsrc(ws + WS_VTD, (unsigned)(512u * VTD_LD * 2u));
#pragma unroll 1
            for (int i = 0; i < (1024 + F.G - 1) / F.G; ++i) {
                const int idx = i * F.G + ((i & 1) ? (F.G - 1 - (int)blockIdx.x) : (int)blockIdx.x);
                if (idx < 1024) { const int uid = c_diff_tab[idx]; int ub = uid >> 5, bb = (uid & 31) >> 2, hh = uid & 3;
                    if (F.G == 256) { bb = (int)blockIdx.x & 7; hh = 3 - i; ub = c_diff_ub[i * 32 + ((int)blockIdx.x >> 3)]; }
#if DIFF_V2
                    diff_attn_unit(F.lds + LDS_STAGE, PROJ5 + 2 * PS, PROJ5 + 3 * PS, (const bf16*)(ws + WS_VTD), (bf16*)(ws + WS_CAT), bb, hh, ub, F.wave, lam, lambda_init, a.in[12] + l * 128);
#else
                    diff_attn_wave(PROJ5 + 2 * PS, rK, rV, (bf16*)(ws + WS_CAT), bb, hh, 128 * ub + 16 * F.wave, lam, lambda_init, a.in[12] + l * 128, lane);
#endif
                }
            }
            __syncthreads();
        }
        }
        if (IN(P_ATTN) || IN(P_DIFF)) GRID_BAR();
        if (IN(P_WO)) {
            PHASE_BASES(); unsigned char* wb = ws + WS_WB;
            pg8::Gemm g{(const bf16*)(ws + WS_CAT), (const bf16*)(wb + WB_WO), D, 0, 0}; pg8::DenseOrder S; S.init(NTOK, D, 1, F.G, (int)blockIdx.x);
            pg8::EpiBf16 E{(bf16*)(ws + WS_Y), D, 0, 0, 0};
            pg8::gemm_phase<pg8::EpiBf16, pg8::DenseOrder, false>(F.lds + LDS_STAGE, g, S, E, nullptr, F.wave);
            GRID_BAR();
        }
        if (IN(P_LN1)) {
            PHASE_BASES();
            const int lane = lane_id(); const bf16* Y = (const bf16*)(ws + WS_Y);
            for (int row = gw; row < NTOK; row += 2 * NGW) ln_res_rows<2, true, false, false>(HB + (size_t)row * D, (size_t)NGW * D, Y + (size_t)row * D, (size_t)NGW * D, nullptr, 0, nullptr, 0, ALPHA, a.in[14] + l * D, a.in[15] + l * D, HB + (size_t)row * D, (size_t)NGW * D, nullptr, 0, lane);
            GRID_BAR();
        }
        if (IN(P_WQ)) {
            PHASE_BASES(); unsigned char* wb = ws + WS_WB;
            pg8::Gemm g{HB, (const bf16*)(wb + WB_WQ), D, 0, 0}; pg8::DenseOrder S; S.init(NTOK, D, 1, F.G, (int)blockIdx.x);
            pg8::EpiBf16 E{(bf16*)(ws + WS_QM), D, 0, 0, 0};
            pg8::gemm_phase<pg8::EpiBf16, pg8::DenseOrder, false>(F.lds + LDS_STAGE, g, S, E, nullptr, F.wave);
            asm volatile("s_waitcnt vmcnt(0)" ::: "memory");
            __syncthreads();
#pragma unroll 1
            for (int i = 0; ; ++i) { pg8::Unit u; if (!S.next(i, u)) break;
#pragma unroll 1
                for (int hb = 0; hb < 2; ++hb)
                    mem_attn_unit(F.lds + LDS_STAGE, (const bf16*)(ws + WS_QM), (const bf16*)(ws + WS_KM) + (size_t)l * 2048 * KM_LD, (const bf16*)(ws + WS_VTM) + (size_t)l * 1024 * VTM_LD, (bf16*)(ws + WS_OM), (u.r0 >> 7) + hb, u.pn, F.wave); }
            GRID_BAR();
        }
        if (IN(P_WMO)) {
            PHASE_BASES(); unsigned char* wb = ws + WS_WB;
            pg8::Gemm g{(const bf16*)(ws + WS_OM), (const bf16*)(wb + WB_WMO), D, 0, 0}; pg8::DenseOrder S; S.init(NTOK, D, 1, F.G, (int)blockIdx.x);
            pg8::EpiBf16 E{(bf16*)(ws + WS_Y), D, 0, 0, 0};
            pg8::gemm_phase<pg8::EpiBf16, pg8::DenseOrder, false>(F.lds + LDS_STAGE, g, S, E, nullptr, F.wave);
            GRID_BAR();
        }
        if (IN(P_LN2)) {
            PHASE_BASES();
            const int lane = lane_id(); const bf16* Y = (const bf16*)(ws + WS_Y);
            for (int row = gw; row < NTOK; row += 2 * NGW) ln_res_rows<2, true, false, false>(HB + (size_t)row * D, (size_t)NGW * D, Y + (size_t)row * D, (size_t)NGW * D, nullptr, 0, nullptr, 0, ALPHA, a.in[19] + l * D, a.in[20] + l * D, HB + (size_t)row * D, (size_t)NGW * D, nullptr, 0, lane);
            GRID_BAR();
        }
        if (IN(P_RGEMM) && NTOK / F.G != 128) {
            PHASE_BASES(); unsigned char* wb = ws + WS_WB;
            pg8::Gemm g{HB, (const bf16*)(wb + WB_RW), D, 0, 0}; pg8::DenseOrder S; S.init(NTOK, 256, 1, F.G, (int)blockIdx.x);
            pg8::EpiLogit E{(float*)(ws + WS_LOGIT)};
            pg8::gemm_phase<pg8::EpiLogit, pg8::DenseOrder, false>(F.lds + LDS_STAGE, g, S, E, nullptr, F.wave);
            GRID_BAR();
        }
        if (IN(P_ROUTE)) {
            PHASE_BASES(); unsigned char* wb = ws + WS_WB;
            const int lane = lane_id(), w = F.wave, tidp = w * 64 + lane;
            const float* LOGIT = (const float*)(ws + WS_LOGIT); float* GATEw = (float*)(ws + WS_ROUTE + 1 * MiB); int* LISTE = (int*)(ws + WS_LISTE);
            LAS int* lcnt = (LAS int*)(F.lds + LDS_TAB);
            LAS int* lsel = lcnt + 64;
            const int T = NTOK / F.G, t0 = (int)blockIdx.x * T, chunk = t0 / MOE_TOK;
            int* gcnt = (int*)(ws + WS_CTL) + CW_MOE + (l * MOE_CHUNKS + chunk) * 256;
            LAS float* LG = (LAS float*)(F.lds + LDS_STAGE);
            const bool fusedlg = (T == 128);
            if (fusedlg) {
                LAS unsigned char* wl = F.lds + LDS_STAGE;
                { const bf16* RW = (const bf16*)(wb + WB_RW); u32x4 st[16];
#pragma unroll
                  for (int i = 0; i < 16; ++i) { const int p = tidp + 512 * i; st[i] = *(const u32x4*)(RW + (size_t)(p >> 7) * D + (p & 127) * 8); }
#pragma unroll
                  for (int i = 0; i < 16; ++i) { const int p = tidp + 512 * i, e = p >> 7, c = p & 127; *(LAS u32x4*)(wl + e * 2048 + ((c ^ (e & 15)) * 16)) = st[i]; } }
                const int n = lane & 15, kq = lane >> 4;
                const bf16* arow = HB + (size_t)(t0 + 16 * w + n) * D + 8 * kq;
                f32x4 acc[4];
#pragma unroll
                for (int nt = 0; nt < 4; ++nt) acc[nt] = (f32x4){0.f, 0.f, 0.f, 0.f};
                __syncthreads();
#pragma unroll 1
                for (int kb = 0; kb < 4; ++kb) { bf16x8 af[8];
#pragma unroll
                    for (int j = 0; j < 8; ++j) af[j] = *(const bf16x8*)(arow + 32 * (8 * kb + j));
#pragma unroll
                    for (int j = 0; j < 8; ++j) { const int c = 4 * (8 * kb + j) + kq;
#pragma unroll
                        for (int nt = 0; nt < 4; ++nt) acc[nt] = mfma16(af[j], *(const LAS bf16x8*)(wl + (16 * nt + n) * 2048 + ((c ^ n) * 16)), acc[nt]); } }
                __syncthreads();
#pragma unroll
                for (int nt = 0; nt < 4; ++nt)
#pragma unroll
                    for (int i = 0; i < 4; ++i) LG[(16 * w + 4 * kq + i) * 64 + 16 * nt + n] = acc[nt][i];
            }
            if (tidp < 64) lcnt[tidp] = 0;
            __syncthreads();
            const float bias = a.in[22][l * N_EXP + lane];
            for (int tt0 = w; tt0 < T; tt0 += 8 * NWAVES) {
                float sc[8], key[8], ssum[8], mys[8]; int mye[8];
#pragma unroll
                for (int u = 0; u < 8; ++u) { const int tt = tt0 + u * NWAVES, t = t0 + (tt < T ? tt : tt0);
                    const float lg = fusedlg ? LG[(tt < T ? tt : tt0) * 64 + lane] : LOGIT[(size_t)t * N_EXP + lane];
                    sc[u] = __builtin_amdgcn_rcpf(1.0f + __expf(-lg)); key[u] = sc[u] + bias; ssum[u] = 0.f; mys[u] = 0.f; mye[u] = 0; }
#pragma unroll 1
                for (int j = 0; j < TOP_E; ++j) {
                    float best[8]; int bi[8];
#pragma unroll
                    for (int u = 0; u < 8; ++u) { best[u] = key[u]; bi[u] = lane; }
#define ROUTE_STEP(GETF, GETI) do { float ob[8]; int oi[8]; \
                        _Pragma("unroll") for (int u = 0; u < 8; ++u) { ob[u] = GETF(best[u]); oi[u] = GETI(bi[u]); } \
                        _Pragma("unroll") for (int u = 0; u < 8; ++u) if (ob[u] > best[u] || (ob[u] == best[u] && oi[u] < bi[u])) { best[u] = ob[u]; bi[u] = oi[u]; } } while (0)
#define DPPF(ctrl) [&](float x) { return __int_as_float(__builtin_amdgcn_update_dpp(__float_as_int(x), __float_as_int(x), ctrl, 0xf, 0xf, false)); }
#define DPPI(ctrl) [&](int x) { return __builtin_amdgcn_update_dpp(x, x, ctrl, 0xf, 0xf, false); }
                    ROUTE_STEP(DPPF(0xB1), DPPI(0xB1));
                    ROUTE_STEP(DPPF(0x4E), DPPI(0x4E));
                    ROUTE_STEP(DPPF(0x141), DPPI(0x141));
                    ROUTE_STEP(DPPF(0x140), DPPI(0x140));
#pragma unroll
                    for (int o = 16; o < 64; o <<= 1) {
                        float ob[8]; int oi[8];
#pragma unroll
                        for (int u = 0; u < 8; ++u) { ob[u] = shx(best[u], lane, o); oi[u] = __builtin_amdgcn_ds_bpermute((lane ^ o) << 2, bi[u]); }
#pragma unroll
                        for (int u = 0; u < 8; ++u) if (ob[u] > best[u] || (ob[u] == best[u] && oi[u] < bi[u])) { best[u] = ob[u]; bi[u] = oi[u]; }
                    }
#undef ROUTE_STEP
#undef DPPF
#undef DPPI
#pragma unroll
                    for (int u = 0; u < 8; ++u) { const float ssel = __int_as_float(__builtin_amdgcn_ds_bpermute(bi[u] << 2, __float_as_int(sc[u])));
                        ssum[u] += ssel; if (lane == j) { mye[u] = bi[u]; mys[u] = ssel; } if (lane == bi[u]) key[u] = -INFINITY; }
                }
#pragma unroll
                for (int u = 0; u < 8; ++u) { const int tt = tt0 + u * NWAVES, t = t0 + tt;
                    if (tt < T && lane < TOP_E) { GATEw[(size_t)t * 8 + lane] = mys[u] * __builtin_amdgcn_rcpf(ssum[u]) * 2.5f; const int lp = atomicAdd((int*)(lcnt + mye[u]), 1); lsel[tt * 8 + lane] = (mye[u] << 16) | lp; } }
            }
            __syncthreads();
            if (tidp < 64) { const int nloc = lcnt[tidp]; lcnt[tidp] = nloc ? atomicAdd(gcnt + tidp, nloc) : 0; }
            __syncthreads();
            for (int i = tidp; i < T * 8; i += NTHR) { const int v = lsel[i], e = v >> 16, lp = v & 0xffff; const int aid = ((t0 - chunk * MOE_TOK) + (i >> 3)) * 8 + (i & 7);
                LISTE[((size_t)chunk * N_EXP + e) * LIST_CAP + lcnt[e] + lp] = aid; }
            GRID_BAR();
        }
#pragma unroll 1
        for (int c = a.c_lo; c < a.c_hi; ++c) {
            const int tok0 = c * MOE_TOK;
#define MOE_BASES() PHASE_BASES(); unsigned char* wb = ws + WS_WB; const int* rec = (const int*)(ws + WS_CTL) + CW_MOE + (l * MOE_CHUNKS + c) * 256; \
            const int* LIST = (const int*)(ws + WS_LISTE) + (size_t)c * N_EXP * LIST_CAP; const float* GATE = (const float*)(ws + WS_ROUTE + 1 * MiB) + (size_t)tok0 * 8; (void)rec; (void)LIST; (void)GATE; (void)wb
            if (IN(P_GU)) {
                MOE_BASES();
#if USE_MK_EXPERT
                LAS int* cum = (LAS int*)(F.lds + LDS_CUM); LAS int* offl = cum + 80; LAS int* tab = (LAS int*)(F.lds + LDS_TAB);
                const int tidm = F.wave * 64 + lane_id();
                if (F.wave == 0) { const int ln = tidm & 63, ce = rec[ln], nb = (ce + 255) >> 8;
                    const int ib = wave_incl_scan(nb, ln), io = wave_incl_scan(ce, ln);
                    cum[ln] = ib - nb; offl[ln] = io - ce; if (ln == 63) { cum[N_EXP] = ib; offl[N_EXP] = io; } }
                __syncthreads();
                LAS int* ut = (LAS int*)(F.lds + LDS_UT);
                pg8::GroupedOrder S{cum, offl, 2, F.G, (int)blockIdx.x, ut};
                if (F.wave == 0) S.fill_table(ut, tidm);
                __syncthreads();
                for (int i = F.wave; i < 8; i += NWAVES) { const int nvv = ut[8 * i + 2], lr = ut[8 * i + 4]; const int ln = tidm & 63;
#pragma unroll
                    for (int k = 0; k < 4; ++k) { const int r = ln + 64 * k; tab[i * 256 + r] = tok0 + ((r < nvv) ? (LIST[lr + r] >> 3) : 0); } }
                __syncthreads();
                { pg8::Gemm g{HB, (const bf16*)(wb + WB_GU), D, 0, (size_t)512 * D};
                  pg8::EpiSwiglu E{(bf16*)(ws + WS_HID)};
                  pg8::gemm_phase<pg8::EpiSwiglu, pg8::GroupedOrder, true>(F.lds + LDS_STAGE, g, S, E, tab, F.wave); }
#endif
                { pg8::Gemm g{HB + (size_t)tok0 * D, (const bf16*)(wb + WB_SGU), D, 0, 0}; pg8::DenseOrder S2;
#if USE_MK_EXPERT
                  const int sfirst = __builtin_amdgcn_readfirstlane((((const LAS int*)(F.lds + LDS_CUM))[N_EXP] * 2) % F.G);
#else
                  const int sfirst = 0;
#endif
                  S2.init(MOE_TOK, 512, 1, F.G, (int)((blockIdx.x + F.G - sfirst) % F.G));
                  pg8::EpiSwiglu E{(bf16*)(ws + WS_SHH)};
                  pg8::gemm_phase<pg8::EpiSwiglu, pg8::DenseOrder, false>(F.lds + LDS_STAGE, g, S2, E, nullptr, F.wave); }
                GRID_BAR();
            }
            if (IN(P_DN)) {
                MOE_BASES();
#if USE_MK_EXPERT
                LAS int* cum = (LAS int*)(F.lds + LDS_CUM); LAS int* offl = cum + 80;
                const int tidm = F.wave * 64 + lane_id();
                if (F.wave == 0) { const int ln = tidm & 63, ce = rec[ln], nb = (ce + 255) >> 8;
                    const int ib = wave_incl_scan(nb, ln), io = wave_incl_scan(ce, ln);
                    cum[ln] = ib - nb; offl[ln] = io - ce; if (ln == 63) { cum[N_EXP] = ib; offl[N_EXP] = io; } }
                __syncthreads();
                { LAS int* ut = (LAS int*)(F.lds + LDS_UT); LAS int* ag = (LAS int*)(F.lds + LDS_AG);
                  pg8::GroupedOrder S{cum, offl, 4, F.G, (int)blockIdx.x, ut};
                  if (F.wave == 0) S.fill_table(ut, tidm);
                  __syncthreads();
                  for (int i = F.wave; i < MOE_AGU; i += NWAVES) { const int nvv = ut[8 * i + 2], lr = ut[8 * i + 4]; const int ln = tidm & 63;
#pragma unroll
                      for (int k = 0; k < 4; ++k) { const int r = ln + 64 * k; if (r < nvv) { const int aid = LIST[lr + r]; *(LAS i32x2*)(ag + (i * 256 + r) * 2) = (i32x2){aid, __float_as_int(GATE[aid])}; } } }
                  __syncthreads();
                  pg8::Gemm g{(const bf16*)(ws + WS_HID), (const bf16*)(wb + WB_DN), EXP_DIM, 0, (size_t)D * EXP_DIM};
                  pg8::EpiSlot E{(bf16*)(ws + WS_SLOT), LIST, GATE, ag};
                  pg8::gemm_phase<pg8::EpiSlot, pg8::GroupedOrder, false>(F.lds + LDS_STAGE, g, S, E, nullptr, F.wave); }
#endif
                { pg8::Gemm g{(const bf16*)(ws + WS_SHH), (const bf16*)(wb + WB_SD), SH_DIM, 0, 0}; pg8::DenseOrder S2; S2.init(MOE_TOK, D, 1, F.G, (int)blockIdx.x);
                  pg8::EpiBf16 E{(bf16*)(ws + WS_SHY), D, 0, 0, 0};
                  pg8::gemm_phase<pg8::EpiBf16, pg8::DenseOrder, false>(F.lds + LDS_STAGE, g, S2, E, nullptr, F.wave); }
                GRID_BAR();
            }
            if (IN(P_COMB)) {
                PHASE_BASES();
                const int lane = lane_id(); const bf16* SLOTp = (const bf16*)(ws + WS_SLOT);
                const bool cblk = (MOE_TOK % NGW) == 0; const int cper = MOE_TOK / F.G;
                const int t_beg = cblk ? F.vcu * cper + F.wave : gw, t_end = cblk ? (F.vcu + 1) * cper : MOE_TOK, t_step = cblk ? NWAVES : NGW;
                for (int tl = t_beg; tl < t_end; tl += t_step) { const int row = tok0 + tl;
                    ln_res_rows<1, false, true, true>(HB + (size_t)row * D, 0, nullptr, 0, (const bf16*)(ws + WS_SHY) + (size_t)tl * D, 0, SLOTp + (size_t)tl * 8 * D, 0, ALPHA, a.in[29] + l * D, a.in[30] + l * D, HB + (size_t)row * D, 0, (l == DEPTH - 1) ? H + (size_t)row * D : nullptr, 0, lane); }
            }
        }
    }
#undef IN
#undef GRID_BAR
}

static Args g_args;
static int g_grid = 0;
#ifndef PROBE_MASK
#define PROBE_MASK 0u
#endif
static void launch_mk(hipStream_t stream, int ph, int l, int c) {
    const int reps = ((PROBE_MASK >> ph) & 1u) ? 3 : 1;
    for (int rr = 0; rr < reps; ++rr) {
    Args a = g_args; a.ph_lo = ph; a.ph_hi = ph + 1; a.l_lo = l; a.l_hi = l + 1; a.c_lo = c; a.c_hi = c + 1; a.use_bar = 0; a.pad = 0;
    hipLaunchKernelGGL(mk_fwd, dim3(g_grid), dim3(NTHR), LDS_BYTES, stream, a);
    }
}
extern "C" void kernel_launch(void* const* d_in, const int* in_sizes, int n_in, void* d_out, int out_size, void* d_ws, size_t ws_size, hipStream_t stream) {
    static int inited = 0;
    if (!inited) {
        inited = 1;
        if (n_in != 31 || out_size != NTOK * D || ws_size < WS_END) { fprintf(stderr, "kernel_launch: unexpected sizes n_in %d out %d ws %zu (need %zu)\n", n_in, out_size, ws_size, (size_t)WS_END); inited = -1; }
        if (hipFuncSetAttribute((const void*)mk_fwd, hipFuncAttributeMaxDynamicSharedMemorySize, LDS_BYTES) != hipSuccess) { fprintf(stderr, "kernel_launch: hipFuncSetAttribute(mk_fwd) failed\n"); inited = -1; }
        int dev = 0, cus = 0, per_cu = 0;
        (void)hipGetDevice(&dev); (void)hipDeviceGetAttribute(&cus, hipDeviceAttributeMultiprocessorCount, dev);
        (void)hipOccupancyMaxActiveBlocksPerMultiprocessor(&per_cu, (const void*)mk_fwd, NTHR, LDS_BYTES);
        if (per_cu < 1) fprintf(stderr, "kernel_launch: occupancy query says %d blocks per CU for mk_fwd\n", per_cu);
        (void)hipGetLastError();
        g_grid = cus > 0 ? cus : 256;
    }
    if (inited < 0) return;
    const float* ln1_g = (const float*)d_in[14]; const float* ln1_b = (const float*)d_in[15];
    const float* ln2_g = (const float*)d_in[19]; const float* ln2_b = (const float*)d_in[20];
    const float* ln3_g = (const float*)d_in[29]; const float* ln3_b = (const float*)d_in[30];
    const float* a_kv_norm = (const float*)d_in[5]; const float* a_w_uk = (const float*)d_in[6]; const float* a_w_uv = (const float*)d_in[7];
    const float* b_lq1 = (const float*)d_in[8]; const float* b_lk1 = (const float*)d_in[9]; const float* b_lq2 = (const float*)d_in[10]; const float* b_lk2 = (const float*)d_in[11];
    const float* b_subln = (const float*)d_in[12];
    const float* router_w = (const float*)d_in[21]; const float* router_bias = (const float*)d_in[22];
    const float* e_w_gate = (const float*)d_in[23]; const float* e_w_up = (const float*)d_in[24]; const float* e_w_down = (const float*)d_in[25];
    unsigned char* ws = (unsigned char*)d_ws;
    float* H = (float*)d_out;
    bf16* HB = (bf16*)(ws + WS_HB);
    bf16* PROJ5 = (bf16*)(ws + WS_PROJ5); bf16* MISC = (bf16*)(ws + WS_MISC10); float* WIDX = (float*)(ws + WS_WIDX); bf16* CKV = (bf16*)(ws + WS_CKV);
    int* SEL = (int*)(ws + WS_SEL); bf16* CAT = (bf16*)(ws + WS_CAT); bf16* Y = (bf16*)(ws + WS_Y);
    bf16* QM = (bf16*)(ws + WS_QM); bf16* OM = (bf16*)(ws + WS_OM);
    int* TOPE = (int*)(ws + WS_ROUTE); float* GATE = (float*)(ws + WS_ROUTE + 1 * MiB); int* LIST = (int*)(ws + WS_ROUTE + 2 * MiB);
    bf16* SLOT = (bf16*)(ws + WS_SLOT);
    int* CNT = (int*)(ws + WS_CTL) + CW_MOE;
    const size_t PS = (size_t)NTOK * 512;
    Args a{};
    for (int i = 0; i < 31; ++i) a.in[i] = (const float*)d_in[i];
    a.out = (float*)d_out; a.ws = ws;
    g_args = a;

    (void)hipMemsetAsync(ws + WS_CTL, 0, 128 * 1024, stream);
#if SINGLE_LAUNCH
    { Args b = g_args; b.ph_lo = 0; b.ph_hi = P_NUM; b.l_lo = 0; b.l_hi = DEPTH; b.c_lo = 0; b.c_hi = MOE_CHUNKS; b.use_bar = 1; b.pad = 0;
      hipLaunchKernelGGL(mk_fwd, dim3(g_grid), dim3(NTHR), LDS_BYTES, stream, b); }
#else
    launch_mk(stream, P_PRO0, 0, 0);
    launch_mk(stream, P_PRO1, 0, 0);
    for (int l = 0; l < DEPTH; ++l) {
        launch_mk(stream, P_CVT, l, 0);
        launch_mk(stream, P_WIN, l, 0);
        launch_mk(stream, P_CKVN, l, 0);
        launch_mk(stream, P_ATTN, l, 0);
        launch_mk(stream, P_DIFF, l, 0);
        launch_mk(stream, P_WO, l, 0);
        launch_mk(stream, P_LN1, l, 0);
        launch_mk(stream, P_WQ, l, 0);
        launch_mk(stream, P_MEMATT, l, 0);
        launch_mk(stream, P_WMO, l, 0);
        launch_mk(stream, P_LN2, l, 0);
        launch_mk(stream, P_RGEMM, l, 0);
        launch_mk(stream, P_ROUTE, l, 0);
        for (int c = 0; c < MOE_CHUNKS; ++c) {
            launch_mk(stream, P_GU, l, c);
            launch_mk(stream, P_DN, l, c);
            launch_mk(stream, P_COMB, l, c);
        }
    }
#endif
}
```
